# Optimizing an MI355X kernel written in HIP

```python
import math
import jax, jax.numpy as jnp
from jax import lax
import numpy as np

D_MODEL = 1024
BATCH = 16
SEQ = 2048
DEPTH = 2

CONV_CH = 512
CONV_GROUPS = 8
CONV_WIDTH = 31
ATT_HEADS = 8
ATT_HEAD_DIM = 64
IDX_HEADS = 8
IDX_HEAD_DIM = 64
IDX_TOPK = 256
Q_BLOCK = 128
GLA_HEADS = 4
GLA_DK = 128
GLA_DV = 256
GLA_GATE_RANK = 16
GLA_TAU = 16.0
GLA_CHUNK = 64
ROPE_THETA = 500000.0
ROPE_FRAC = 4
D_FF = -(-8 * D_MODEL // (3 * 256)) * 256
NORM_EPS = 1e-6

AB_SIZES = (2 * CONV_CH, ATT_HEADS * ATT_HEAD_DIM, ATT_HEAD_DIM, ATT_HEAD_DIM,
            IDX_HEADS * IDX_HEAD_DIM, IDX_HEAD_DIM, IDX_HEADS)
AB_IN = sum(AB_SIZES)
AB_OUT = CONV_CH + ATT_HEADS * ATT_HEAD_DIM
C_SIZES = (GLA_HEADS * GLA_DK, GLA_HEADS * GLA_DK, GLA_HEADS * GLA_DV,
           GLA_HEADS * GLA_DV, GLA_GATE_RANK)
C_IN = sum(C_SIZES)
C_OUT = GLA_HEADS * GLA_DV

kernel_name = "hybrid_conv_dsa_gla_trunk"


def split_cols(u, sizes):
    outs, off = [], 0
    for s in sizes:
        outs.append(u[..., off:off + s])
        off += s
    return outs


def rms_norm(x, g):
    xf = x.astype(jnp.float32)
    y = xf * lax.rsqrt(jnp.mean(xf * xf, axis=-1, keepdims=True) + NORM_EPS)
    return (y * g.astype(jnp.float32)).astype(x.dtype)


def rope_tables(seq, head_dim):
    rot = head_dim // ROPE_FRAC
    inv = ROPE_THETA ** (-jnp.arange(0, rot, 2, dtype=jnp.float32) / rot)
    ang = jnp.arange(seq, dtype=jnp.float32)[:, None] * inv[None, :]
    return jnp.cos(ang), jnp.sin(ang)


def apply_rope(x, cos, sin):
    r = cos.shape[-1]
    xf = x.astype(jnp.float32)
    x1, x2, xp = xf[..., :r], xf[..., r:2 * r], xf[..., 2 * r:]
    out = jnp.concatenate([x1 * cos - x2 * sin, x2 * cos + x1 * sin, xp], axis=-1)
    return out.astype(x.dtype)


def conv_module(u, conv_w, conv_b, ln_g, ln_b):
    a, gate = u[..., :CONV_CH], u[..., CONV_CH:]
    h = a * jax.nn.sigmoid(gate)
    h = lax.conv_general_dilated(h, conv_w, window_strides=(1,),
                                 padding=[(CONV_WIDTH - 1, 0)],
                                 dimension_numbers=("NWC", "WIO", "NWC"),
                                 feature_group_count=CONV_CH) + conv_b
    hf = h.astype(jnp.float32)
    mu = jnp.mean(hf, axis=-1, keepdims=True)
    var = jnp.mean(jnp.square(hf - mu), axis=-1, keepdims=True)
    hf = (hf - mu) * lax.rsqrt(var + NORM_EPS) * ln_g.astype(jnp.float32) + ln_b.astype(jnp.float32)
    return jax.nn.silu(hf).astype(u.dtype)


def dsa_attention(q, k, v, iq, ik, iw, cos, sin):
    b_, s_, h_, dh = q.shape
    n_sel = min(IDX_TOPK, s_ // 4)
    q = apply_rope(q, cos[:, None, :], sin[:, None, :])
    k = apply_rope(k, cos, sin)
    iq = apply_rope(iq, cos[:, None, :], sin[:, None, :])
    ik = apply_rope(ik, cos, sin)
    nb = s_ // Q_BLOCK

    def to_blocks(t):
        return jnp.moveaxis(t.reshape(b_, nb, Q_BLOCK, *t.shape[2:]), 1, 0)

    key_pos = jnp.arange(s_, dtype=jnp.int32)
    q_pos = key_pos.reshape(nb, Q_BLOCK)
    w_scale = (IDX_HEADS ** -0.5) * (IDX_HEAD_DIM ** -0.5)
    att_scale = dh ** -0.5

    def block(args):
        qb, iqb, iwb, tpos = args
        logits = jnp.einsum("bqhd,bsd->bqsh", iqb, ik, preferred_element_type=jnp.float32)
        score = jnp.einsum("bqsh,bqh->bqs", jax.nn.relu(logits),
                           iwb.astype(jnp.float32)) * w_scale
        causal = key_pos[None, :] <= tpos[:, None]
        score = jnp.where(causal[None], score, -jnp.inf)
        _, idx = lax.top_k(score, n_sel)
        valid = idx <= tpos[None, :, None]
        kg = jax.vmap(lambda kk, ii: kk[ii])(k, idx)
        vg = jax.vmap(lambda vv, ii: vv[ii])(v, idx)
        s = jnp.einsum("bqhd,bqkd->bhqk", qb, kg, preferred_element_type=jnp.float32) * att_scale
        s = jnp.where(valid[:, None], s, -jnp.inf)
        p = jax.nn.softmax(s, axis=-1)
        return jnp.einsum("bhqk,bqkd->bqhd", p.astype(vg.dtype), vg)

    out = lax.map(block, (to_blocks(q), to_blocks(iq), to_blocks(iw), q_pos))
    return jnp.moveaxis(out, 0, 1).reshape(b_, s_, h_ * dh)


def gla(q, k, v, r, gate_lr, g2_w, g2_b, onorm_g):
    b_, s_, h_, dk = q.shape
    dv = v.shape[-1]
    log_a = jax.nn.log_sigmoid((gate_lr @ g2_w + g2_b).astype(jnp.float32)) / GLA_TAU
    log_a = log_a.reshape(b_, s_, h_, dk)
    nc, c = s_ // GLA_CHUNK, GLA_CHUNK

    def chunks(t):
        return t.astype(jnp.float32).reshape(b_, nc, c, h_, t.shape[-1]).transpose(1, 0, 3, 2, 4)

    qc = chunks(q) * (dk ** -0.5)
    kc, vc, lc = chunks(k), chunks(v), chunks(log_a)
    bcum = jnp.cumsum(lc, axis=3)
    b_last = bcum[..., -1:, :]
    q_t = qc * jnp.exp(bcum)
    k_t = kc * jnp.exp(-bcum)
    k_s = kc * jnp.exp(b_last - bcum)
    mask = jnp.tril(jnp.ones((c, c), jnp.float32))
    att = jnp.einsum("nbhid,nbhjd->nbhij", q_t, k_t) * mask
    o_intra = jnp.einsum("nbhij,nbhjv->nbhiv", att, vc)

    def step(state, inp):
        q_n, k_n, v_n, decay = inp
        o = jnp.einsum("bhid,bhdv->bhiv", q_n, state)
        state = state * decay[:, :, 0, :, None] + jnp.einsum("bhjd,bhjv->bhdv", k_n, v_n)
        return state, o

    s0 = jnp.zeros((b_, h_, dk, dv), jnp.float32)
    _, o_inter = lax.scan(step, s0, (q_t, k_s, vc, jnp.exp(b_last)))
    o = (o_intra + o_inter).transpose(1, 0, 3, 2, 4).reshape(b_, s_, h_, dv)
    o = o * lax.rsqrt(jnp.mean(o * o, axis=-1, keepdims=True) + NORM_EPS) \
        * onorm_g.astype(jnp.float32).reshape(h_, dv)
    o = o.astype(r.dtype) * jax.nn.silu(r)
    return o.reshape(b_, s_, h_ * dv)


def setup_inputs(seed: int = 0) -> dict:
    key = jax.random.key(seed)
    ks = iter(jax.random.split(key, 32))
    n_even = (DEPTH + 1) // 2
    n_odd = DEPTH // 2

    def nrm(shape, scale):
        return jax.random.normal(next(ks), shape, jnp.float32) * scale

    def gain(shape):
        return 1.0 + nrm(shape, 0.02)

    res_scale = (2.0 * DEPTH) ** -0.5
    return {
        "x": nrm((BATCH, SEQ, D_MODEL), 1.0),
        "norm_mix_g": gain((DEPTH, D_MODEL)),
        "ab_w_in": nrm((n_even, D_MODEL, AB_IN), D_MODEL ** -0.5),
        "ab_conv_w": nrm((n_even, CONV_WIDTH, 1, CONV_CH), CONV_WIDTH ** -0.5),
        "ab_conv_b": nrm((n_even, CONV_CH), 0.02),
        "ab_ln_g": gain((n_even, CONV_CH)),
        "ab_ln_b": nrm((n_even, CONV_CH), 0.02),
        "ab_w_out": nrm((n_even, AB_OUT, D_MODEL), AB_OUT ** -0.5 * res_scale),
        "c_w_in": nrm((n_odd, D_MODEL, C_IN), D_MODEL ** -0.5),
        "c_gate_w": nrm((n_odd, GLA_GATE_RANK, GLA_HEADS * GLA_DK), GLA_GATE_RANK ** -0.5),
        "c_gate_b": nrm((n_odd, GLA_HEADS * GLA_DK), 0.02),
        "c_onorm_g": gain((n_odd, GLA_HEADS * GLA_DV)),
        "c_w_out": nrm((n_odd, C_OUT, D_MODEL), C_OUT ** -0.5 * res_scale),
        "norm_ffn_g": gain((DEPTH, D_MODEL)),
        "ffn_w_gate": nrm((DEPTH, D_MODEL, D_FF), D_MODEL ** -0.5),
        "ffn_w_up": nrm((DEPTH, D_MODEL, D_FF), D_MODEL ** -0.5),
        "ffn_w_down": nrm((DEPTH, D_FF, D_MODEL), D_FF ** -0.5 * res_scale),
        "final_norm_g": gain((D_MODEL,)),
    }


def reference(x, norm_mix_g, ab_w_in, ab_conv_w, ab_conv_b, ab_ln_g, ab_ln_b, ab_w_out,
              c_w_in, c_gate_w, c_gate_b, c_onorm_g, c_w_out,
              norm_ffn_g, ffn_w_gate, ffn_w_up, ffn_w_down, final_norm_g):
    b_, s_, _ = x.shape
    cos, sin = rope_tables(s_, ATT_HEAD_DIM)
    h = x
    for layer in range(DEPTH):
        hn = rms_norm(h, norm_mix_g[layer])
        if layer % 2 == 0:
            i = layer // 2
            u = hn @ ab_w_in[i]
            ua, q, k, v, iq, ik, iw = split_cols(u, AB_SIZES)
            ya = conv_module(ua, ab_conv_w[i], ab_conv_b[i], ab_ln_g[i], ab_ln_b[i])
            yb = dsa_attention(q.reshape(b_, s_, ATT_HEADS, ATT_HEAD_DIM), k, v,
                               iq.reshape(b_, s_, IDX_HEADS, IDX_HEAD_DIM), ik, iw, cos, sin)
            y = jnp.concatenate([ya, yb], axis=-1) @ ab_w_out[i]
        else:
            i = layer // 2
            u = hn @ c_w_in[i]
            q, k, v, r, glr = split_cols(u, C_SIZES)
            yc = gla(q.reshape(b_, s_, GLA_HEADS, GLA_DK), k.reshape(b_, s_, GLA_HEADS, GLA_DK),
                     v.reshape(b_, s_, GLA_HEADS, GLA_DV), r.reshape(b_, s_, GLA_HEADS, GLA_DV),
                     glr, c_gate_w[i], c_gate_b[i], c_onorm_g[i])
            y = yc @ c_w_out[i]
        h = h + y
        hn = rms_norm(h, norm_ffn_g[layer])
        h = h + (jax.nn.silu(hn @ ffn_w_gate[layer]) * (hn @ ffn_w_up[layer])) @ ffn_w_down[layer]
    return rms_norm(h, final_norm_g)
```

```cpp
#include <hip/hip_runtime.h>
#include <cstdio>
#include <cstdint>
#ifndef REP_IN
#define REP_IN 1
#endif
#ifndef REP_GU
#define REP_GU 1
#endif
#ifndef REP_DSA12
#define REP_DSA12 1
#endif
#ifndef REP_DSA3
#define REP_DSA3 1
#endif
#ifndef REP_DSA1
#define REP_DSA1 1
#endif
#ifndef REP_DSA2
#define REP_DSA2 1
#endif
#ifndef REP_OUT
#define REP_OUT 1
#endif
#ifndef REP_DN
#define REP_DN 1
#endif
#ifndef REP_G3
#define REP_G3 1
#endif
#ifndef PROBE_PMODE
#define PROBE_PMODE 0
#endif
#ifndef WGM_GU
#define WGM_GU 8
#endif
namespace pg8 {
#define PG8_LAS __attribute__((address_space(3)))
typedef unsigned short bf16_t;
typedef short bf16x8 __attribute__((ext_vector_type(8)));
typedef float f32x4 __attribute__((ext_vector_type(4)));
typedef unsigned u32x4 __attribute__((ext_vector_type(4)));
constexpr int BM = 256, BK = 64, HALF = 128, HTB = HALF * BK * 2  , STAGE_BYTES = 8 * HTB, NXCD = 8, WGM = 8;

__host__ __device__ __forceinline__ int lds_byte(int r, int c) { const int st = (r >> 4) * 2 + (c >> 5), rr = r & 15, cc = c & 31, ob = rr * 64 + cc * 2; return st * 1024 + (ob ^ (((ob >> 9) & 1) << 5)); }
__host__ __device__ __forceinline__ void stage_rc(int b, int& R, int& C) { const int st = b / 1024, sb = b % 1024, swz = sb ^ (((sb >> 9) & 1) << 5); R = (st >> 1) * 16 + swz / 64; C = (st & 1) * 32 + (swz % 64) / 2; }
__host__ __device__ __forceinline__ int perm32(int rho) { const int n = rho >> 4, i = rho & 15; return 8 * (i >> 2) + 4 * n + (i & 3); }

struct Unit { int pm, pn; };
struct Gemm { const bf16_t* A; const bf16_t* Bt; int M, N, K; };

struct StaticOrder {
    int nM, nN, nwg, G, c, wgm;
    __host__ __device__ void init(int M, int N, int G_, int c_, int wgm_ = WGM) { nM = M / BM; nN = N / BM; nwg = nM * nN; G = G_; c = c_; wgm = wgm_; }
    __host__ __device__ bool next(int i, Unit& u) const {
        const long L = (long)i * G + c; if (L >= nwg) return false;
        int wgid = (int)L; { const int q = nwg / NXCD, r = nwg % NXCD, xcd = wgid % NXCD, off = wgid / NXCD; wgid = (xcd < r ? xcd * (q + 1) : r * (q + 1) + (xcd - r) * q) + off; }
        const int nig = wgm * nN, gid = wgid / nig, fm = gid * wgm, gsz = (nM - fm) < wgm ? (nM - fm) : wgm;
        u.pm = fm + ((wgid % nig) % gsz); u.pn = (wgid % nig) / gsz; return true;
    }
    __device__ __forceinline__ void a_ready(const Unit&) const {}
    __device__ __forceinline__ void done(const Unit&) const {}
};

__device__ __forceinline__ unsigned cvt_pk_bf16(float lo, float hi) { unsigned r; asm volatile("v_cvt_pk_bf16_f32 %0, %1, %2" : "=v"(r) : "v"(lo), "v"(hi)); return r; }
typedef float f32x2 __attribute__((ext_vector_type(2)));
typedef unsigned u32x2 __attribute__((ext_vector_type(2)));
constexpr float RMS_EPS = 1e-6f;
struct EpiIn {
    static constexpr bool PERM = true, AFTER_DRAIN = false, PREF = true;
    bf16_t* O; int ldc; const float* ssq; const float* rope; int do_rope;
    __device__ __forceinline__ void pref(const Unit& u, int wr, int lane, float& p0, float& p1) const { const f32x4* s = (const f32x4*)(ssq + (size_t)(u.pm * BM + wr * 64 + lane) * 16);
        const f32x4 a0 = s[0], a1 = s[1], a2 = s[2], a3 = s[3], b0 = s[4 * HALF], b1 = s[4 * HALF + 1], b2 = s[4 * HALF + 2], b3 = s[4 * HALF + 3];
        const f32x4 sa = (a0 + a1) + (a2 + a3), sb = (b0 + b1) + (b2 + b3); p0 = (sa.x + sa.y) + (sa.z + sa.w); p1 = (sb.x + sb.y) + (sb.z + sb.w); }
    __device__ __forceinline__ void operator()(const f32x4 (&acc)[2][2][4][2], const Unit& u, int wr, int wc, int fr, int fq, float p0, float p1) const {
        const int row0 = u.pm * BM + wr * 64 + fr, cg0 = u.pn * BM + wc * 32;
#pragma unroll
        for (int ai = 0; ai < 2; ++ai)
#pragma unroll
            for (int m = 0; m < 4; ++m) {
                const int row = row0 + ai * HALF + m * 16;
                const float r = rsqrtf(__shfl(ai ? p1 : p0, fr + 16 * m) * (1.0f / 1024.0f) + RMS_EPS);
                bf16_t* rowp = O + (size_t)row * ldc + cg0 + 8 * fq;
                if (do_rope && u.pn < 4) {
                    float hh[8];
#pragma unroll
                    for (int n = 0; n < 2; ++n)
#pragma unroll
                        for (int e2 = 0; e2 < 4; ++e2) { const float a = acc[ai][0][m][n][e2] * r, g = acc[ai][1][m][n][e2] * r; hh[4 * n + e2] = a * __builtin_amdgcn_rcpf(1.0f + __expf(-g)); }
                    u32x4 w; w.x = cvt_pk_bf16(hh[0], hh[1]); w.y = cvt_pk_bf16(hh[2], hh[3]); w.z = cvt_pk_bf16(hh[4], hh[5]); w.w = cvt_pk_bf16(hh[6], hh[7]);
                    __builtin_nontemporal_store(w, (u32x4*)(O + (size_t)row * ldc + u.pn * HALF + wc * 32 + 8 * fq));
                    continue;
                }
#pragma unroll
                for (int bj = 0; bj < 2; ++bj) {
                    f32x4 v0 = acc[ai][bj][m][0] * r, v1 = acc[ai][bj][m][1] * r;
                    const int cg = cg0 + bj * HALF;
                    const bool rp = do_rope && ((cg & 63) == 0) && ((cg >= 1024 && cg < 1600) || (cg >= 1664 && cg < 2240));
                    if (rp) {
                        const float* cs = rope + (row & 2047) * 16;
                        const f32x4 c0 = *(const f32x4*)cs, c1 = *(const f32x4*)(cs + 4), s0 = *(const f32x4*)(cs + 8), s1 = *(const f32x4*)(cs + 12);
                        f32x4 p0, p1;
#pragma unroll
                        for (int e = 0; e < 4; ++e) { p0[e] = __shfl_xor(v0[e], 16); p1[e] = __shfl_xor(v1[e], 16); }
                        const float sg = (fq == 0) ? -1.0f : 1.0f;
                        if (fq < 2) { v0 = v0 * c0 + p0 * s0 * sg; v1 = v1 * c1 + p1 * s1 * sg; }
                    }
                    u32x4 w; w.x = cvt_pk_bf16(v0[0], v0[1]); w.y = cvt_pk_bf16(v0[2], v0[3]); w.z = cvt_pk_bf16(v1[0], v1[1]); w.w = cvt_pk_bf16(v1[2], v1[3]);
                    __builtin_nontemporal_store(w, (u32x4*)(rowp + bj * HALF));
                }
            }
    }
};
struct EpiRes {
    static constexpr bool PERM = true, AFTER_DRAIN = false, PREF = false;
    const bf16_t* hin; bf16_t* hb; float* ssq; int pmode;
    __device__ __forceinline__ void operator()(const f32x4 (&acc)[2][2][4][2], const Unit& u, int wr, int wc, int fr, int fq) const {
        const int row0 = u.pm * BM + wr * 64 + fr, col0 = u.pn * BM + wc * 32 + 8 * fq;
#pragma unroll
        for (int ai = 0; ai < 2; ++ai)
#pragma unroll
            for (int m = 0; m < 4; ++m) {
                const int row = row0 + ai * HALF + m * 16; const size_t ro = (size_t)row * 1024 + col0; float s = 0.f;
                u32x4 old[2];
#pragma unroll
                for (int bj = 0; bj < 2; ++bj) { if (pmode >= 1) old[bj] = (u32x4){0u, 0u, 0u, 0u}; else old[bj] = *(const u32x4*)(hin + ro + bj * HALF); }
#pragma unroll
                for (int bj = 0; bj < 2; ++bj) {
                    f32x4 v0 = acc[ai][bj][m][0], v1 = acc[ai][bj][m][1];
                    v0[0] += __builtin_bit_cast(float, old[bj].x << 16); v0[1] += __builtin_bit_cast(float, old[bj].x & 0xffff0000u);
                    v0[2] += __builtin_bit_cast(float, old[bj].y << 16); v0[3] += __builtin_bit_cast(float, old[bj].y & 0xffff0000u);
                    v1[0] += __builtin_bit_cast(float, old[bj].z << 16); v1[1] += __builtin_bit_cast(float, old[bj].z & 0xffff0000u);
                    v1[2] += __builtin_bit_cast(float, old[bj].w << 16); v1[3] += __builtin_bit_cast(float, old[bj].w & 0xffff0000u);
                    u32x4 w; w.x = cvt_pk_bf16(v0[0], v0[1]); w.y = cvt_pk_bf16(v0[2], v0[3]); w.z = cvt_pk_bf16(v1[0], v1[1]); w.w = cvt_pk_bf16(v1[2], v1[3]);
                    if (pmode < 3) __builtin_nontemporal_store(w, (u32x4*)(hb + ro + bj * HALF));
                    s += ((v0[0] * v0[0] + v0[1] * v0[1]) + (v0[2] * v0[2] + v0[3] * v0[3])) + ((v1[0] * v1[0] + v1[1] * v1[1]) + (v1[2] * v1[2] + v1[3] * v1[3]));
                }
                s += __shfl_xor(s, 16); s += __shfl_xor(s, 32);
                if (fq == 0 && pmode < 2) ssq[(size_t)row * 16 + u.pn * 4 + wc] = s;
                if (pmode >= 3 && s == 12345.678f) hb[ro] = 0;
                if (m & 1) asm volatile("" ::: "memory");
            }
    }
};
struct EpiGLU {
    static constexpr bool PERM = true, AFTER_DRAIN = false, PREF = true;
    bf16_t* O; const float* ssq; int pmode;
    __device__ __forceinline__ void pref(const Unit& u, int wr, int lane, float& p0, float& p1) const { const f32x4* s = (const f32x4*)(ssq + (size_t)(u.pm * BM + wr * 64 + lane) * 16);
        const f32x4 a0 = s[0], a1 = s[1], a2 = s[2], a3 = s[3], b0 = s[4 * HALF], b1 = s[4 * HALF + 1], b2 = s[4 * HALF + 2], b3 = s[4 * HALF + 3];
        const f32x4 sa = (a0 + a1) + (a2 + a3), sb = (b0 + b1) + (b2 + b3); p0 = (sa.x + sa.y) + (sa.z + sa.w); p1 = (sb.x + sb.y) + (sb.z + sb.w); }
    __device__ __forceinline__ void operator()(const f32x4 (&acc)[2][2][4][2], const Unit& u, int wr, int wc, int fr, int fq, float p0, float p1) const {
        const int row0 = u.pm * BM + wr * 64 + fr, col0 = u.pn * HALF + wc * 32 + 8 * fq;
#pragma unroll
        for (int ai = 0; ai < 2; ++ai)
#pragma unroll
            for (int m = 0; m < 4; ++m) {
                const int row = row0 + ai * HALF + m * 16;
                const float r = rsqrtf(__shfl(ai ? p1 : p0, fr + 16 * m) * (1.0f / 1024.0f) + RMS_EPS);
                float a[8];
#pragma unroll
                for (int n = 0; n < 2; ++n)
#pragma unroll
                    for (int e = 0; e < 4; ++e) { const float g = acc[ai][0][m][n][e] * r, up = acc[ai][1][m][n][e] * r;
                        a[4 * n + e] = (pmode >= 1) ? (g + up) : g * __builtin_amdgcn_rcpf(1.0f + __expf(-g)) * up; }
                u32x4 w; w.x = cvt_pk_bf16(a[0], a[1]); w.y = cvt_pk_bf16(a[2], a[3]); w.z = cvt_pk_bf16(a[4], a[5]); w.w = cvt_pk_bf16(a[6], a[7]);
                if (pmode < 2 || a[0] == 12345.678f) __builtin_nontemporal_store(w, (u32x4*)(O + (size_t)row * 2816 + col0));
            }
    }
};

template <class Epi, class Sched, bool ALIGN_EPI = false, bool SP2 = false>
__device__ __forceinline__ void gemm_phase(PG8_LAS unsigned char* lds, const Gemm g, const Sched& S, const Epi& E) {
    int tid_ = threadIdx.x; asm volatile("" : "+v"(tid_));
    const int tid = tid_, wid = __builtin_amdgcn_readfirstlane(tid >> 6), lane = tid & 63, wr = wid >> 2, wc = wid & 3, fr = lane & 15, fq = lane >> 4;
    const int K = g.K, nt = K / BK;
    unsigned voffA[2], voffB[2];
#pragma unroll
    for (int i = 0; i < 2; ++i) { int R, C; stage_rc(tid * 16 + i * 8192, R, C); const int Rb = Epi::PERM ? ((R & ~31) + perm32(R & 31)) : R;
        voffA[i] = (unsigned)(R * K + C) * 2u; voffB[i] = (unsigned)(Rb * K + C) * 2u; }
    const size_t kstep = (size_t)(BK * 2);
    const size_t hstep = (size_t)HALF * K * 2;
    const size_t tstep = 2 * hstep;
    const unsigned ldsw = (unsigned)wid * 1024u;
    const int aoff = lds_byte(wr * 64 + fr, fq * 8), boff = lds_byte(wc * 32 + fr, fq * 8);
#define PG8_SA(b, h) (((b) * 2 + (h)) * HTB)
#define PG8_SB(b, h) ((4 + (b) * 2 + (h)) * HTB)
#define PG8_STAGE(bufoff, gbase, voff) do { _Pragma("unroll") for (int _i = 0; _i < 2; ++_i) \
        __builtin_amdgcn_global_load_lds((const unsigned*)((const char*)(gbase) + (voff)[_i]), (PG8_LAS unsigned*)(lds + (bufoff) + ldsw + _i * 8192), 16, 0, 0); } while (0)
#define PG8_LDA(dst, b, h) do { _Pragma("unroll") for (int m = 0; m < 4; ++m) _Pragma("unroll") for (int k = 0; k < 2; ++k) dst[m][k] = *(const PG8_LAS bf16x8*)(lds + PG8_SA(b, h) + aoff + m * 2048 + k * 1024); } while (0)
#define PG8_LDB(dst, b, h) do { _Pragma("unroll") for (int n = 0; n < 2; ++n) _Pragma("unroll") for (int k = 0; k < 2; ++k) dst[n][k] = *(const PG8_LAS bf16x8*)(lds + PG8_SB(b, h) + boff + n * 2048 + k * 1024); } while (0)
#define PG8_MMA(ai, bj, At, Bt) do { __builtin_amdgcn_s_setprio(1); _Pragma("unroll") for (int m = 0; m < 4; ++m) _Pragma("unroll") for (int n = 0; n < 2; ++n) _Pragma("unroll") for (int k = 0; k < 2; ++k) \
        acc[ai][bj][m][n] = __builtin_amdgcn_mfma_f32_16x16x32_bf16(Bt[n][k], At[m][k], acc[ai][bj][m][n], 0, 0, 0); __builtin_amdgcn_s_setprio(0); } while (0)
#define PG8_WAIT_V(n) asm volatile("s_waitcnt vmcnt(" #n ")" ::: "memory")
#define PG8_WAIT_L(n) asm volatile("s_waitcnt lgkmcnt(" #n ")" ::: "memory")
#define PG8_BAR __builtin_amdgcn_s_barrier()
#define PG8_SCHED __builtin_amdgcn_sched_barrier(0)
    Unit cur, nxt; int ui = 0;
    if (!S.next(0, cur)) return;
    f32x4 acc[2][2][4][2];
#pragma unroll
    for (int a = 0; a < 2; ++a)
#pragma unroll
        for (int b = 0; b < 2; ++b)
#pragma unroll
            for (int m = 0; m < 4; ++m)
#pragma unroll
                for (int n = 0; n < 2; ++n) acc[a][b][m][n] = (f32x4){0.f, 0.f, 0.f, 0.f};
    bf16x8 At[4][2], B0[2][2], B1[2][2];
    const char* cA = (const char*)g.A + (size_t)cur.pm * tstep; const char* cB = (const char*)g.Bt + (size_t)cur.pn * tstep;
    float pf0 = 0.f, pf1 = 0.f;
    if constexpr (Epi::PREF) E.pref(cur, wr, lane, pf0, pf1);
    S.a_ready(cur);
    if constexpr (SP2) {
        PG8_STAGE(PG8_SB(0, 0), cB, voffB); PG8_STAGE(PG8_SB(0, 1), cB + hstep, voffB); PG8_STAGE(PG8_SA(0, 0), cA, voffA); PG8_STAGE(PG8_SA(0, 1), cA + hstep, voffA);
        if (wr == 1) PG8_BAR;
        PG8_WAIT_V(2); PG8_BAR;
        PG8_STAGE(PG8_SB(1, 0), cB + kstep, voffB); PG8_STAGE(PG8_SA(1, 0), cA + kstep, voffA); PG8_STAGE(PG8_SB(1, 1), cB + hstep + kstep, voffB);
        PG8_WAIT_V(6); PG8_BAR;
    } else {
        PG8_STAGE(PG8_SB(0, 0), cB, voffB); PG8_STAGE(PG8_SA(0, 0), cA, voffA); PG8_STAGE(PG8_SB(0, 1), cB + hstep, voffB); PG8_STAGE(PG8_SA(0, 1), cA + hstep, voffA);
        if (wr == 1) PG8_BAR;
        PG8_WAIT_V(4); PG8_BAR;
        PG8_STAGE(PG8_SB(1, 0), cB + kstep, voffB); PG8_STAGE(PG8_SA(1, 0), cA + kstep, voffA); PG8_STAGE(PG8_SB(1, 1), cB + hstep + kstep, voffB);
        PG8_WAIT_V(6); PG8_BAR;
    }
    for (;;) {
        const bool has_next = S.next(ui + 1, nxt);
        const char* nA = has_next ? (const char*)g.A + (size_t)nxt.pm * tstep : cA; const char* nB = has_next ? (const char*)g.Bt + (size_t)nxt.pn * tstep : cB;
        for (int t = 0; t < nt; t += 2) {
            const bool last = (t == nt - 2);
            const char* a1 = cA + (size_t)(t + 1) * kstep;
            const char* a2 = last ? nA : cA + (size_t)(t + 2) * kstep; const char* b2 = last ? nB : cB + (size_t)(t + 2) * kstep;
            const char* a3 = a2 + kstep; const char* b3 = b2 + kstep;
            if (last && has_next) S.a_ready(nxt);
            if constexpr (SP2) {
            PG8_LDB(B0, 0, 0); PG8_LDB(B1, 0, 1); PG8_SCHED; PG8_LDA(At, 0, 0); PG8_STAGE(PG8_SA(1, 1), a1 + hstep, voffA);
            PG8_WAIT_V(8); PG8_WAIT_L(0); PG8_BAR; PG8_MMA(0, 0, At, B0); PG8_MMA(0, 1, At, B1); PG8_BAR; PG8_SCHED;
            PG8_LDA(At, 0, 1); PG8_STAGE(PG8_SB(0, 0), b2, voffB); PG8_STAGE(PG8_SB(0, 1), b2 + hstep, voffB); PG8_STAGE(PG8_SA(0, 0), a2, voffA);
            PG8_WAIT_V(8); PG8_WAIT_L(0); PG8_BAR; PG8_MMA(1, 0, At, B0); PG8_MMA(1, 1, At, B1); PG8_BAR; PG8_SCHED;
            PG8_LDB(B0, 1, 0); PG8_LDB(B1, 1, 1); PG8_SCHED; PG8_LDA(At, 1, 0); PG8_STAGE(PG8_SA(0, 1), a2 + hstep, voffA);
            PG8_WAIT_V(8); PG8_WAIT_L(0); PG8_BAR; PG8_MMA(0, 0, At, B0); PG8_MMA(0, 1, At, B1); PG8_BAR; PG8_SCHED;
            PG8_LDA(At, 1, 1); PG8_STAGE(PG8_SB(1, 0), b3, voffB); PG8_STAGE(PG8_SB(1, 1), b3 + hstep, voffB); PG8_STAGE(PG8_SA(1, 0), a3, voffA);
            PG8_WAIT_V(8); PG8_WAIT_L(0); PG8_BAR; PG8_MMA(1, 0, At, B0); PG8_MMA(1, 1, At, B1); PG8_BAR; PG8_SCHED;
            } else {
            PG8_LDB(B0, 0, 0); PG8_SCHED; PG8_LDA(At, 0, 0); PG8_STAGE(PG8_SA(1, 1), a1 + hstep, voffA);
            PG8_WAIT_L(8); PG8_BAR; PG8_WAIT_L(0); PG8_MMA(0, 0, At, B0); PG8_BAR; PG8_SCHED;
            PG8_LDB(B1, 0, 1); PG8_STAGE(PG8_SB(0, 0), b2, voffB);
            PG8_BAR; PG8_WAIT_L(0); PG8_MMA(0, 1, At, B1); PG8_BAR;
            PG8_LDA(At, 0, 1); PG8_STAGE(PG8_SA(0, 0), a2, voffA);
            PG8_BAR; PG8_WAIT_L(0); PG8_MMA(1, 0, At, B0); PG8_BAR; PG8_SCHED;
            PG8_STAGE(PG8_SB(0, 1), b2 + hstep, voffB);
            PG8_WAIT_V(6); PG8_BAR; PG8_MMA(1, 1, At, B1); PG8_BAR;
            PG8_LDB(B0, 1, 0); PG8_SCHED; PG8_LDA(At, 1, 0); PG8_STAGE(PG8_SA(0, 1), a2 + hstep, voffA);
            PG8_WAIT_L(8); PG8_BAR; PG8_WAIT_L(0); PG8_MMA(0, 0, At, B0); PG8_BAR; PG8_SCHED;
            PG8_LDB(B1, 1, 1); PG8_STAGE(PG8_SB(1, 0), b3, voffB);
            PG8_BAR; PG8_WAIT_L(0); PG8_MMA(0, 1, At, B1); PG8_BAR;
            PG8_LDA(At, 1, 1); PG8_STAGE(PG8_SA(1, 0), a3, voffA);
            PG8_BAR; PG8_WAIT_L(0); PG8_MMA(1, 0, At, B0); PG8_BAR; PG8_SCHED;
            PG8_STAGE(PG8_SB(1, 1), b3 + hstep, voffB);
            PG8_WAIT_V(6); PG8_BAR; PG8_MMA(1, 1, At, B1); PG8_BAR;
            }
        }
        if constexpr (ALIGN_EPI) { if (wr == 0) PG8_BAR; }
        if constexpr (!Epi::AFTER_DRAIN) { if constexpr (Epi::PREF) { E(acc, cur, wr, wc, fr, fq, pf0, pf1); if (has_next) E.pref(nxt, wr, lane, pf0, pf1); } else E(acc, cur, wr, wc, fr, fq); S.done(cur); }
        if (!has_next) break;
#pragma unroll
        for (int a = 0; a < 2; ++a)
#pragma unroll
            for (int b = 0; b < 2; ++b)
#pragma unroll
                for (int m = 0; m < 4; ++m)
#pragma unroll
                    for (int n = 0; n < 2; ++n) acc[a][b][m][n] = (f32x4){0.f, 0.f, 0.f, 0.f};
        cur = nxt; cA = nA; cB = nB; ++ui;
        if constexpr (ALIGN_EPI) { if (wr == 1) PG8_BAR; }
    }
    PG8_WAIT_V(0);
    if constexpr (!ALIGN_EPI) { if (wr == 0) PG8_BAR; }
    PG8_BAR;
    if constexpr (Epi::AFTER_DRAIN) { E.fused(acc, cur, wr, wc, fr, fq, lds, wid, lane); S.done(cur); }
#undef PG8_SA
#undef PG8_SB
#undef PG8_STAGE
#undef PG8_LDA
#undef PG8_LDB
#undef PG8_MMA
#undef PG8_WAIT_V
#undef PG8_WAIT_L
#undef PG8_BAR
#undef PG8_SCHED
}
}
constexpr int NWAVES = 8;
constexpr int NB = 16, SEQ = 2048, DM = 1024, M = NB * SEQ;
constexpr int ABN = 2248, ABP = 2304, CN = 3088, CP = 3328, DFF = 2816, GU = 2 * DFF;
constexpr int AB_G = 512, AB_Q = 1024, AB_K = 1536, AB_V = 1600, AB_IQ = 1664, AB_IK = 2176, AB_IW = 2240;
constexpr int C_K = 512, C_V = 1024, C_R = 2048, C_GL = 3072;
constexpr float EPS = 1e-6f;
constexpr size_t MiB = 1u << 20;
constexpr size_t WS_CTL = 0, CTL_ZERO_BYTES = 1 * MiB;
constexpr size_t WS_ROPE = 5 * MiB / 2, WS_DEC = 3 * MiB;
constexpr size_t WS_WIN0 = 4 * MiB, WS_WIN1 = WS_WIN0 + (size_t)ABP * DM * 2, WS_WOUT0 = WS_WIN1 + (size_t)CP * DM * 2, WS_WOUT1 = WS_WOUT0 + 2 * MiB;
constexpr size_t WS_WGU0 = WS_WOUT1 + 2 * MiB, WS_WGU1 = WS_WGU0 + (size_t)GU * DM * 2, WS_WDN0 = WS_WGU1 + (size_t)GU * DM * 2, WS_WDN1 = WS_WDN0 + (size_t)DM * DFF * 2;
constexpr size_t WS_HB = 52 * MiB, WS_U = 116 * MiB, WS_YC = 324 * MiB, WS_QT = 388 * MiB, WS_KT = 420 * MiB, WS_KTT = 452 * MiB, WS_SSQ = 484 * MiB, WS_GSSQ = 496 * MiB, WS_END = 504 * MiB;
static_assert(WS_WDN1 + (size_t)DM * DFF * 2 <= WS_HB && WS_HB + (size_t)M * DM * 2 <= WS_U && WS_U + (size_t)M * CP * 2 <= WS_YC && WS_YC + (size_t)M * DM * 2 <= WS_QT && WS_QT + (size_t)M * 512 * 2 <= WS_KT && WS_KT + (size_t)M * 512 * 2 <= WS_KTT && WS_KTT + (size_t)M * 512 * 2 <= WS_SSQ && WS_SSQ + (size_t)6 * M * 64 <= WS_GSSQ && WS_GSSQ + (size_t)M * 256 <= WS_END, "d_ws map");
constexpr int CW_BAR = 4096;
constexpr int SC_STRIDE = 2064;
constexpr int LDS_BM = 16 * SC_STRIDE * 4;
constexpr int LDS_CTL = LDS_BM + 16384;
constexpr int LDS_BYTES = LDS_CTL + 1024;
#define GAS __attribute__((address_space(1)))
#define LAS __attribute__((address_space(3)))
typedef unsigned short bf16;
typedef unsigned v4u __attribute__((ext_vector_type(4)));
typedef unsigned v2u __attribute__((ext_vector_type(2)));
typedef float f32x4 __attribute__((ext_vector_type(4)));
typedef float f32x16 __attribute__((ext_vector_type(16)));
typedef short bf16x8 __attribute__((ext_vector_type(8)));
#define LDS_WAIT() asm volatile("s_waitcnt lgkmcnt(0)" ::: "memory")
#define LDS_BARRIER() do { asm volatile("s_waitcnt lgkmcnt(0)" ::: "memory"); __builtin_amdgcn_s_barrier(); asm volatile("" ::: "memory"); } while (0)
typedef __bf16 bf16pair_t __attribute__((ext_vector_type(2)));
__device__ __forceinline__ unsigned pk2(float lo, float hi) { bf16pair_t v; v.x = (__bf16)lo; v.y = (__bf16)hi; return __builtin_bit_cast(unsigned, v); }
__device__ __forceinline__ unsigned f2bf(float f) { return pk2(f, 0.f) & 0xffffu; }
__device__ __forceinline__ float fexp2(float x) { return __builtin_amdgcn_exp2f(x); }
__device__ __forceinline__ float fexp(float x) { return __builtin_amdgcn_exp2f(x * 1.44269504089f); }
__device__ __forceinline__ float frcp(float x) { return __builtin_amdgcn_rcpf(x); }
__device__ __forceinline__ float fsilu(float x) { return x * __builtin_amdgcn_rcpf(1.0f + __builtin_amdgcn_exp2f(-1.44269504089f * x)); }
__device__ __forceinline__ float bf2f(unsigned b) { return __builtin_bit_cast(float, b << 16); }
__device__ __forceinline__ float wave_sum(float v) {
#pragma unroll
    for (int o = 1; o < 64; o <<= 1) v += __shfl_xor(v, o);
    return v;
}
__device__ __forceinline__ int wave_isum(int v) {
    v += __builtin_amdgcn_update_dpp(0, v, 0xB1, 0xf, 0xf, false);
    v += __builtin_amdgcn_update_dpp(0, v, 0x4E, 0xf, 0xf, false);
    v += __builtin_amdgcn_update_dpp(0, v, 0x141, 0xf, 0xf, false);
    v += __builtin_amdgcn_update_dpp(0, v, 0x140, 0xf, 0xf, false);
    v += __builtin_amdgcn_update_dpp(0, v, 0x142, 0xa, 0xf, false);
    v += __builtin_amdgcn_update_dpp(0, v, 0x143, 0xc, 0xf, false);
    return __builtin_amdgcn_readlane(v, 63);
}
__device__ __forceinline__ f32x4 mfma16(bf16x8 a, bf16x8 b, f32x4 c) { return __builtin_amdgcn_mfma_f32_16x16x32_bf16(a, b, c, 0, 0, 0); }
__device__ __forceinline__ f32x16 mfma32(bf16x8 a, bf16x8 b, f32x16 c) { return __builtin_amdgcn_mfma_f32_32x32x16_bf16(a, b, c, 0, 0, 0); }
__device__ __forceinline__ bf16x8 mk8(v2u lo, v2u hi) { v4u t; t.x = lo.x; t.y = lo.y; t.z = hi.x; t.w = hi.y; return __builtin_bit_cast(bf16x8, t); }
__device__ __forceinline__ bf16x8 pack8(float a0, float a1, float a2, float a3, float a4, float a5, float a6, float a7) {
    v4u t; t.x = pk2(a0, a1); t.y = pk2(a2, a3); t.z = pk2(a4, a5); t.w = pk2(a6, a7); return __builtin_bit_cast(bf16x8, t); }

#define XB_TMO      128
#define XB_XCNT(j)  (256  + 64 * (j))
#define XB_XSUB(j)  (1280 + 64 * (j))
#define XB_XGEN(j)  (2304 + 64 * (j))
#define XB_TOP      3328
#define XB_TOPGEN   3392
#define XCD_BAR_WORDS 3456
#define XB_SPIN_CAP (1u << 18)

__device__ __forceinline__ unsigned xb_ld(unsigned* p)              { return __hip_atomic_load(p, __ATOMIC_RELAXED, __HIP_MEMORY_SCOPE_AGENT); }
__device__ __forceinline__ unsigned xb_add(unsigned* p, unsigned v) { return __hip_atomic_fetch_add(p, v, __ATOMIC_RELAXED, __HIP_MEMORY_SCOPE_AGENT); }
__device__ __forceinline__ unsigned xb_xcc_id() { return (unsigned)__builtin_amdgcn_s_getreg((3 << 11) | 20) & 0xFu; }
#define XB_SPIN(cond, bar) do { unsigned _sp = 0; while (cond) { __builtin_amdgcn_s_sleep(1); \
    if ((++_sp & 255u) == 0u) { if (xb_ld(&(bar)[XB_TMO])) break; if (_sp > XB_SPIN_CAP) { atomicAdd(&(bar)[XB_TMO], 1u); break; } } } } while (0)

struct XcdBarrier {
    unsigned* bar; unsigned x;
    volatile LAS unsigned* st;
};

__device__ __forceinline__ XcdBarrier xcd_barrier_post(unsigned* bar, volatile LAS unsigned* st) {
    XcdBarrier b; b.bar = bar; b.x = xb_xcc_id(); b.st = st;
    if (threadIdx.x == 0) (void)xb_add(&bar[XB_XCNT(b.x)], 1u);
    return b;
}
__device__ __forceinline__ void xcd_barrier_complete(unsigned* bar, unsigned x, unsigned& nloc, unsigned& nx) {
    const unsigned G = gridDim.x * gridDim.y * gridDim.z;
    unsigned sum, cnt, mine, sp = 0u;
    for (;;) {
        sum = 0u; cnt = 0u; mine = 0u;
#pragma unroll
        for (unsigned j = 0; j < 16; ++j) { const unsigned c = xb_ld(&bar[XB_XCNT(j)]); sum += c; cnt += (c > 0u) ? 1u : 0u; mine = (j == x) ? c : mine; }
        if (sum == G) break;
        __builtin_amdgcn_s_sleep(1);
        if ((++sp & 255u) == 0u) { if (xb_ld(&bar[XB_TMO])) break; if (sp > XB_SPIN_CAP) { atomicAdd(&bar[XB_TMO], 1u); break; } }
    }
    nloc = mine > 0u ? mine : 1u; nx = cnt > 0u ? cnt : 1u;
}

__device__ __forceinline__ void xcd_barrier(const XcdBarrier& b) {
    asm volatile("s_waitcnt vmcnt(0)" ::: "memory");
    __syncthreads();
    if (threadIdx.x == 0) {
        unsigned* bar = b.bar;
        __builtin_amdgcn_s_waitcnt(0);
        unsigned nloc = b.st[0], nx = b.st[1];
        if (nloc == 0u) { xcd_barrier_complete(bar, b.x, nloc, nx); b.st[0] = nloc; b.st[1] = nx; }
        const unsigned old = xb_add(&bar[XB_XSUB(b.x)], 1u);
        const unsigned gen = old / nloc;
        if (old + 1u == (gen + 1u) * nloc) {
            __builtin_amdgcn_fence(__ATOMIC_RELEASE, "agent");
            asm volatile("s_waitcnt vmcnt(0)" ::: "memory");
            const unsigned og = xb_add(&bar[XB_TOP], 1u);
            const unsigned tg = og / nx;
            if (og + 1u == (tg + 1u) * nx) xb_add(&bar[XB_TOPGEN], 1u);
            else XB_SPIN(xb_ld(&bar[XB_TOPGEN]) == tg, bar);
            __builtin_amdgcn_fence(__ATOMIC_ACQUIRE, "agent");
            xb_add(&bar[XB_XGEN(b.x)], 1u);
            asm volatile("s_waitcnt vmcnt(0)" ::: "memory");
        } else {
            XB_SPIN(xb_ld(&bar[XB_XGEN(b.x)]) == gen, bar);
            __builtin_amdgcn_fence(__ATOMIC_ACQUIRE, "agent");
            asm volatile("s_waitcnt vmcnt(0)" ::: "memory");
        }
    }
    __syncthreads();
}

struct Frame { LAS unsigned char* lds; int tid, lane, wave, vcu, G; };
#define LAUNDER_TID() int tid_l_ = threadIdx.x; asm volatile("" : "+v"(tid_l_)); const int tid = tid_l_, lane = tid & 63; (void)tid; (void)lane

__device__ __forceinline__ void p0_item(const float* W, int K, int N, const float* gain, bf16* WT, int drow0, int k0, int n0, LAS float* scr, int lane) {
    const int n_ = n0 + (lane & 31), nc_ = n_ < N ? n_ : N - 1; const float keep_ = n_ < N ? 1.f : 0.f;
#pragma unroll
    for (int i0 = 0; i0 < 32; i0 += 16) {
        float v[16];
#pragma unroll
        for (int i = 0; i < 16; ++i) v[i] = __builtin_nontemporal_load(W + (size_t)(k0 + 2 * (i0 + i) + (lane >> 5)) * N + nc_);
#pragma unroll
        for (int i = 0; i < 16; ++i) { const int kk = 2 * (i0 + i) + (lane >> 5); float x = v[i] * keep_; if (gain) x *= gain[k0 + kk]; scr[kk * 33 + (lane & 31)] = x; }
    }
    LDS_WAIT(); asm volatile("" ::: "memory");
    const int c = lane & 7;
#pragma unroll
    for (int j = 0; j < 4; ++j) { const int n = (lane >> 3) + 8 * j; const LAS float* s = scr + (8 * c) * 33 + n;
        v4u o; o.x = pk2(s[0 * 33], s[1 * 33]); o.y = pk2(s[2 * 33], s[3 * 33]); o.z = pk2(s[4 * 33], s[5 * 33]); o.w = pk2(s[6 * 33], s[7 * 33]);
        *(v4u*)(WT + (size_t)(drow0 + n) * K + k0 + 8 * c) = o; }
    LDS_WAIT(); asm volatile("" ::: "memory");
}
struct P0Args { const float *x, *mix_g, *ab_w_in, *ab_w_out, *c_w_in, *c_w_out, *ffn_g, *w_gate, *w_up, *w_down; unsigned char* ws; };
__device__ __forceinline__ void p0_weights(const Frame& F, const P0Args& A, int it_lo, int it_hi, int gw, int NGW) {
    LAUNDER_TID();
    LAS float* scr = (LAS float*)(F.lds + F.wave * 16384);
    bf16* const win0 = (bf16*)(A.ws + WS_WIN0); bf16* const win1 = (bf16*)(A.ws + WS_WIN1); bf16* const wout0 = (bf16*)(A.ws + WS_WOUT0); bf16* const wout1 = (bf16*)(A.ws + WS_WOUT1);
    bf16* const wgu0 = (bf16*)(A.ws + WS_WGU0); bf16* const wgu1 = (bf16*)(A.ws + WS_WGU1); bf16* const wdn0 = (bf16*)(A.ws + WS_WDN0); bf16* const wdn1 = (bf16*)(A.ws + WS_WDN1);
    constexpr int I_IN0 = 16 * (ABP / 32), I_IN1 = 16 * (CP / 32), I_OUT = 16 * 32, I_GU = 16 * (DFF / 32), I_DN = (DFF / 64) * 32;
    constexpr int NITEMS = I_IN0 + I_IN1 + 2 * I_OUT + 4 * I_GU + 2 * I_DN;
    for (int it = it_lo + gw; it < (it_hi < NITEMS ? it_hi : NITEMS); it += NGW) {
        int r = it; const float* W = nullptr; const float* gain = nullptr; bf16* WT = nullptr; int K = 0, N = 0, Np = 0, mode = 0; bool found = false;
#define P0_MAT(Wp, Kv, Nv, Npv, gp, WTp, md, cnt) { if (!found) { if (r < (cnt)) { W = (Wp); K = (Kv); N = (Nv); Np = (Npv); gain = (gp); WT = (WTp); mode = (md); found = true; } else r -= (cnt); } }
        P0_MAT(A.ab_w_in, DM, ABN, ABP, A.mix_g, win0, 3, I_IN0)
        P0_MAT(A.c_w_in, DM, CN, CP, A.mix_g + DM, win1, 0, I_IN1)
        P0_MAT(A.ab_w_out, DM, DM, DM, nullptr, wout0, 0, I_OUT)
        P0_MAT(A.c_w_out, DM, DM, DM, nullptr, wout1, 0, I_OUT)
        P0_MAT(A.w_gate, DM, DFF, DFF, A.ffn_g, wgu0, 1, I_GU)
        P0_MAT(A.w_up, DM, DFF, DFF, A.ffn_g, wgu0, 2, I_GU)
        P0_MAT(A.w_gate + (size_t)DM * DFF, DM, DFF, DFF, A.ffn_g + DM, wgu1, 1, I_GU)
        P0_MAT(A.w_up + (size_t)DM * DFF, DM, DFF, DFF, A.ffn_g + DM, wgu1, 2, I_GU)
        P0_MAT(A.w_down, DFF, DM, DM, nullptr, wdn0, 0, I_DN)
        P0_MAT(A.w_down + (size_t)DFF * DM, DFF, DM, DM, nullptr, wdn1, 0, I_DN)
#undef P0_MAT
        const int nblk = Np / 32, kb = r / nblk, nb = r % nblk, n0 = 32 * nb;
        int drow0 = n0; if (mode == 1 || mode == 2) drow0 = 256 * (n0 >> 7) + (n0 & 127) + (mode == 2 ? 128 : 0);
        if (mode == 3 && n0 < 1024) { const int nn = n0 & 511; drow0 = 256 * (nn >> 7) + (nn & 127) + (n0 >= 512 ? 128 : 0); }
        p0_item(W, K, N, gain, WT, drow0, 64 * kb, n0, scr, lane);
    }
}
constexpr int P0_I_IN0 = 16 * (ABP / 32);
__device__ __forceinline__ void p0_prologue(const Frame& F, const P0Args& A) {
    LAUNDER_TID();
    const int gw = F.vcu * NWAVES + F.wave, NGW = F.G * NWAVES;
    p0_weights(F, A, 0, 1 << 30, gw, NGW);
    bf16* HB = (bf16*)(A.ws + WS_HB); float* ssq0 = (float*)(A.ws + WS_SSQ);
    for (int m0 = gw * 4; m0 < M; m0 += NGW * 4) {
        f32x4 v[4][4];
#pragma unroll
        for (int q = 0; q < 4; ++q)
#pragma unroll
            for (int j = 0; j < 4; ++j) v[q][j] = __builtin_nontemporal_load((const f32x4*)(A.x + (size_t)(m0 + q) * DM) + lane + 64 * j);
#pragma unroll
        for (int q = 0; q < 4; ++q) { float s = 0.f;
#pragma unroll
            for (int j = 0; j < 4; ++j) s += (v[q][j].x * v[q][j].x + v[q][j].y * v[q][j].y) + (v[q][j].z * v[q][j].z + v[q][j].w * v[q][j].w);
            s = wave_sum(s); if (lane < 4) *((f32x4*)(ssq0 + (size_t)(m0 + q) * 16) + lane) = (f32x4){lane == 0 ? s : 0.f, 0.f, 0.f, 0.f};
            v2u* o8 = (v2u*)(HB + (size_t)(m0 + q) * DM) + lane;
#pragma unroll
            for (int j = 0; j < 4; ++j) { v2u w; w.x = pk2(v[q][j].x, v[q][j].y); w.y = pk2(v[q][j].z, v[q][j].w); o8[64 * j] = w; } }
    }
    float* rope = (float*)(A.ws + WS_ROPE);
    for (int e = F.vcu * 512 + tid; e < SEQ * 8; e += F.G * 512) { const int t = e >> 3, i = e & 7;
        const float inv = powf(500000.0f, -(float)i * 0.125f); const float ang = (float)t * inv;
        rope[t * 16 + i] = cosf(ang); rope[t * 16 + 8 + i] = sinf(ang); }
}

__device__ __forceinline__ unsigned ordkey(float f) { const unsigned u = __builtin_bit_cast(unsigned, f); return (u & 0x80000000u) ? ~u : (u | 0x80000000u); }
constexpr int KSTR = 72, VSTR = 72;
__device__ __forceinline__ void dsa_unit(const Frame& F, const bf16* U, bf16* YC, int b, int j) {
    LAUNDER_TID(); const int wave = F.wave;
    const size_t rb = (size_t)b * SEQ;
    LAS float* SC = (LAS float*)F.lds;
    LAS unsigned* BM = (LAS unsigned*)(F.lds + LDS_BM);
#pragma unroll 1
    for (int rep12_ = 0; rep12_ < REP_DSA12; ++rep12_)
    {
        const f32x4 ninf = {-__builtin_inff(), -__builtin_inff(), -__builtin_inff(), -__builtin_inff()};
        for (int e = tid; e < 16 * SC_STRIDE / 4; e += 512) ((LAS f32x4*)SC)[e] = ninf;
        LDS_BARRIER();
    }
    {
    bf16x8 nbq[8][2]; v4u niw;
    { const bf16* qrow = U + (rb + 64 * j + (lane & 15)) * ABP;
#pragma unroll
      for (int h = 0; h < 8; ++h)
#pragma unroll
        for (int ks = 0; ks < 2; ++ks) nbq[h][ks] = *(const bf16x8*)(qrow + AB_IQ + h * 64 + ks * 32 + (lane >> 4) * 8);
      niw = *(const v4u*)(qrow + AB_IW); }
#pragma unroll 1
    for (int s = 0; s < 4; ++s) {
        const int t0 = 64 * j + 16 * s, nkt = (t0 >> 4) + 1;
        {
            const int c = lane & 15, g = lane >> 4;
            bf16x8 bq[8][2];
#pragma unroll
            for (int h = 0; h < 8; ++h)
#pragma unroll
                for (int ks = 0; ks < 2; ++ks) bq[h][ks] = nbq[h][ks];
            float iwv[8];
            { const v4u raw = niw; const float ws = 0.04419417382f;
              iwv[0] = bf2f(raw.x & 0xffffu) * ws; iwv[1] = bf2f(raw.x >> 16) * ws; iwv[2] = bf2f(raw.y & 0xffffu) * ws; iwv[3] = bf2f(raw.y >> 16) * ws;
              iwv[4] = bf2f(raw.z & 0xffffu) * ws; iwv[5] = bf2f(raw.z >> 16) * ws; iwv[6] = bf2f(raw.w & 0xffffu) * ws; iwv[7] = bf2f(raw.w >> 16) * ws; }
            bf16x8 nak[4][2];
#pragma unroll
            for (int u = 0; u < 4; ++u) { const int kt = wave + 8 * u;
                if (kt < nkt) { const bf16* krow = U + (rb + 16 * kt + c) * ABP + AB_IK + g * 8; nak[u][0] = *(const bf16x8*)krow; nak[u][1] = *(const bf16x8*)(krow + 32); } }
            for (int kt0 = wave; kt0 < nkt; kt0 += 32) {
                bf16x8 ak[4][2];
#pragma unroll
                for (int u = 0; u < 4; ++u) { ak[u][0] = nak[u][0]; ak[u][1] = nak[u][1]; }
#pragma unroll
                for (int u = 0; u < 4; ++u) { const int kt = kt0 + 32 + 8 * u;
                    if (kt < nkt) { const bf16* krow = U + (rb + 16 * kt + c) * ABP + AB_IK + g * 8; nak[u][0] = *(const bf16x8*)krow; nak[u][1] = *(const bf16x8*)(krow + 32); } }
#pragma unroll
                for (int u = 0; u < 4; ++u) { const int kt = kt0 + 8 * u;
                    if (kt < nkt) {
                        f32x4 sc = {0.f, 0.f, 0.f, 0.f};
#pragma unroll
                        for (int h = 0; h < 8; ++h) { f32x4 acc = {0.f, 0.f, 0.f, 0.f}; acc = mfma16(ak[u][0], bq[h][0], acc); acc = mfma16(ak[u][1], bq[h][1], acc);
#pragma unroll
                            for (int i = 0; i < 4; ++i) sc[i] += fmaxf(acc[i], 0.f) * iwv[h]; }
#pragma unroll
                        for (int i = 0; i < 4; ++i) sc[i] = (16 * kt + 4 * g + i <= t0 + c) ? sc[i] : -__builtin_inff();
                        *(LAS f32x4*)(SC + c * SC_STRIDE + 16 * kt + 4 * g) = sc;
                    } }
            }
            if (s < 3) { const bf16* qrow = U + (rb + t0 + 16 + c) * ABP;
#pragma unroll
                for (int h = 0; h < 8; ++h)
#pragma unroll
                    for (int ks = 0; ks < 2; ++ks) nbq[h][ks] = *(const bf16x8*)(qrow + AB_IQ + h * 64 + ks * 32 + g * 8);
                niw = *(const v4u*)(qrow + AB_IW); }
        }
        LDS_BARRIER();
#pragma unroll 1
        for (int rep2_ = 0; rep2_ < REP_DSA2; ++rep2_)
        for (int qq = 0; qq < 2; ++qq) {
            const int q = 2 * wave + qq, t = t0 + q;
            float k[32];
#pragma unroll
            for (int i = 0; i < 32; ++i) k[i] = *(volatile LAS float*)(SC + q * SC_STRIDE + 64 * i + lane);
            unsigned mlo = 0u, mhi = 0u;
            if (t < 256) {
#pragma unroll
                for (int i = 0; i < 32; ++i) { const unsigned long long mm = __ballot((64 * i + lane) <= t); if (lane == i) { mlo = (unsigned)mm; mhi = (unsigned)(mm >> 32); } }
            } else {
                const int nblk = (t >> 9) + 1;
                {
#define DSA_CNT8(ca, cb, cfs, b) do { unsigned long long m0_, m1_, m2_, m3_; \
                    asm("v_cmp_le_f32_e64 %2, %6, %7\n\tv_cmp_le_f32_e64 %3, %6, %8\n\tv_cmp_le_f32_e64 %4, %6, %9\n\tv_cmp_le_f32_e64 %5, %6, %10\n\t" \
                        "v_addc_co_u32_e64 %0, %2, 0, %0, %2\n\tv_cmp_le_f32_e64 %2, %6, %11\n\tv_addc_co_u32_e64 %1, %3, 0, %1, %3\n\tv_cmp_le_f32_e64 %3, %6, %12\n\t" \
                        "v_addc_co_u32_e64 %0, %4, 0, %0, %4\n\tv_cmp_le_f32_e64 %4, %6, %13\n\tv_addc_co_u32_e64 %1, %5, 0, %1, %5\n\tv_cmp_le_f32_e64 %5, %6, %14\n\t" \
                        "v_addc_co_u32_e64 %0, %2, 0, %0, %2\n\tv_addc_co_u32_e64 %1, %3, 0, %1, %3\n\tv_addc_co_u32_e64 %0, %4, 0, %0, %4\n\tv_addc_co_u32_e64 %1, %5, 0, %1, %5" \
                        : "+v"(ca), "+v"(cb), "=&s"(m0_), "=&s"(m1_), "=&s"(m2_), "=&s"(m3_) : "s"(cfs), "v"(k[8 * (b) + 0]), "v"(k[8 * (b) + 1]), "v"(k[8 * (b) + 2]), "v"(k[8 * (b) + 3]), \
                          "v"(k[8 * (b) + 4]), "v"(k[8 * (b) + 5]), "v"(k[8 * (b) + 6]), "v"(k[8 * (b) + 7])); } while (0)
#define DSA_COUNT(cf, cntvar) do { int ca_ = 0, cb_ = 0; const float cfs_ = (cf); DSA_CNT8(ca_, cb_, cfs_, 0); if (nblk > 1) DSA_CNT8(ca_, cb_, cfs_, 1); if (nblk > 2) DSA_CNT8(ca_, cb_, cfs_, 2); if (nblk > 3) DSA_CNT8(ca_, cb_, cfs_, 3); \
                    cntvar = wave_isum(ca_ + cb_); } while (0)
                unsigned T = 0u; bool exact = false; int bit = 30, cnt;
                DSA_COUNT(0.0f, cnt);
                if (cnt >= 256) {
                    T = 0x80000000u;
                    if (cnt == 256) exact = true;
                    else {
                        float kmx = k[0];
#pragma unroll
                        for (int i = 1; i < 32; ++i) kmx = fmaxf(kmx, k[i]);
#pragma unroll
                        for (int o = 1; o < 64; o <<= 1) kmx = fmaxf(kmx, __shfl_xor(kmx, o));
                        int eb = (int)((__builtin_bit_cast(unsigned, kmx) >> 23) & 0xffu); eb = __builtin_amdgcn_readfirstlane(eb);
                        bit = 30;
                        for (int step = 0; step < 3 && eb >= 1; ++step, --eb) { const float cf = __builtin_bit_cast(float, (unsigned)eb << 23); DSA_COUNT(cf, cnt);
                            if (cnt >= 256) { T = 0x80000000u | ((unsigned)eb << 23); if (cnt == 256) exact = true; bit = 22; break; } }
                    }
                }
                for (; bit >= 0 && !exact; --bit) {
                    const unsigned cand = T | (1u << bit); const float cf = __builtin_bit_cast(float, (cand & 0x80000000u) ? (cand & 0x7fffffffu) : ~cand);
                    DSA_COUNT(cf, cnt);
                    if (cnt >= 256) { T = cand; if (cnt == 256) exact = true; }
                }
#undef DSA_COUNT
#undef DSA_CNT8
                const float Tf = __builtin_bit_cast(float, (T & 0x80000000u) ? (T & 0x7fffffffu) : ~T);
                if (exact) {
#pragma unroll
                    for (int i = 0; i < 32; ++i) { const unsigned long long mm = __ballot(k[i] >= Tf); if (lane == i) { mlo = (unsigned)mm; mhi = (unsigned)(mm >> 32); } }
                } else {
                    int cgt = 0;
#pragma unroll
                    for (int i = 0; i < 32; ++i) cgt += __popcll(__ballot(k[i] > Tf));
                    const int need = 256 - cgt; int base = 0;
#pragma unroll
                    for (int i = 0; i < 32; ++i) {
                        const bool eq = (k[i] == Tf); const unsigned long long me = __ballot(eq);
                        const int rank = base + (int)__builtin_amdgcn_mbcnt_hi((unsigned)(me >> 32), __builtin_amdgcn_mbcnt_lo((unsigned)me, 0u));
                        const bool sel = (k[i] > Tf) || (eq && rank < need);
                        const unsigned long long mm = __ballot(sel);
                        if (lane == i) { mlo = (unsigned)mm; mhi = (unsigned)(mm >> 32); }
                        base += __popcll(me);
                    }
                }
                if (lane < 32) { BM[(16 * s + q) * 64 + 2 * lane] = mlo; BM[(16 * s + q) * 64 + 2 * lane + 1] = mhi; }
                }
            }
            if (t < 256 && lane < 32) { BM[(16 * s + q) * 64 + 2 * lane] = mlo; BM[(16 * s + q) * 64 + 2 * lane + 1] = mhi; }
        }
        LDS_BARRIER();
    }
    }
    __syncthreads();
    LAS bf16* Ks = (LAS bf16*)F.lds;
    LAS bf16* Vt = (LAS bf16*)(F.lds + 2 * 64 * KSTR * 2);
    const int c = lane & 31, hi = lane >> 5;
#pragma unroll 1
    for (int rep3_ = 0; rep3_ < REP_DSA3; ++rep3_) {
    LAS bf16x8* QF = (LAS bf16x8*)(F.lds + 4 * 64 * KSTR * 2) + wave * 512;
#pragma unroll
    for (int nt = 0; nt < 2; ++nt)
#pragma unroll
        for (int ks = 0; ks < 4; ++ks) QF[(nt * 4 + ks) * 64 + lane] = *(const bf16x8*)(U + (rb + 64 * j + 32 * nt + c) * ABP + AB_Q + wave * 64 + 16 * ks + 8 * hi);
    f32x16 O[2][2];
#pragma unroll
    for (int dt = 0; dt < 2; ++dt)
#pragma unroll
        for (int nt = 0; nt < 2; ++nt)
#pragma unroll
            for (int i = 0; i < 16; ++i) O[dt][nt][i] = 0.f;
    float mrow[2] = {-1e30f, -1e30f}, lrow[2] = {0.f, 0.f};
    const float sc2 = 0.125f * 1.44269504089f;
    const int krow_s = tid >> 3, kch_s = tid & 7, vkey_s = tid & 63, vch_s = tid >> 6;
    v4u kreg = *(const v4u*)(U + (rb + krow_s) * ABP + AB_K + 8 * kch_s);
    v4u vreg = *(const v4u*)(U + (rb + vkey_s) * ABP + AB_V + 8 * vch_s);
    {
        *(LAS v4u*)(Ks + krow_s * KSTR + 8 * kch_s) = kreg;
        const unsigned ve[4] = {vreg.x, vreg.y, vreg.z, vreg.w};
#pragma unroll
        for (int e = 0; e < 4; ++e) { Vt[(8 * vch_s + 2 * e) * VSTR + vkey_s] = (bf16)(ve[e] & 0xffffu); Vt[(8 * vch_s + 2 * e + 1) * VSTR + vkey_s] = (bf16)(ve[e] >> 16); }
    }
    __syncthreads();
    for (int kt = 0; kt <= j; ++kt) {
        const int buf = kt & 1;
        if (kt < j) {
            kreg = *(const v4u*)(U + (rb + 64 * (kt + 1) + krow_s) * ABP + AB_K + 8 * kch_s);
            vreg = *(const v4u*)(U + (rb + 64 * (kt + 1) + vkey_s) * ABP + AB_V + 8 * vch_s);
        }
        const LAS bf16* Kb = Ks + buf * 64 * KSTR; const LAS bf16* Vb = Vt + buf * 64 * VSTR;
        bf16x8 va[2][4]; unsigned wm[2][2];
#pragma unroll
        for (int dt = 0; dt < 2; ++dt)
#pragma unroll
            for (int kk = 0; kk < 4; ++kk) { const LAS bf16* vp = Vb + (32 * dt + c) * VSTR + 16 * kk + 4 * hi; va[dt][kk] = mk8(*(const LAS v2u*)vp, *(const LAS v2u*)(vp + 8)); }
#pragma unroll
        for (int nt = 0; nt < 2; ++nt)
#pragma unroll
            for (int mt = 0; mt < 2; ++mt) wm[nt][mt] = BM[(32 * nt + c) * 64 + 2 * kt + mt] >> (4 * hi);
#pragma unroll
        for (int nt = 0; nt < 2; ++nt) {
            f32x16 S[2];
            {
                bf16x8 ka[2][4], bq[4];
#pragma unroll
                for (int ks = 0; ks < 4; ++ks) bq[ks] = QF[(nt * 4 + ks) * 64 + lane];
#pragma unroll
                for (int mt = 0; mt < 2; ++mt)
#pragma unroll
                    for (int ks = 0; ks < 4; ++ks) ka[mt][ks] = *(const LAS bf16x8*)(Kb + (32 * mt + c) * KSTR + 16 * ks + 8 * hi);
#pragma unroll
                for (int mt = 0; mt < 2; ++mt) {
#pragma unroll
                    for (int i = 0; i < 16; ++i) S[mt][i] = 0.f;
#pragma unroll
                    for (int ks = 0; ks < 4; ++ks) S[mt] = mfma32(ka[mt][ks], bq[ks], S[mt]);
                }
            }
            float mx = -1e30f;
#pragma unroll
            for (int mt = 0; mt < 2; ++mt)
#pragma unroll
                for (int i = 0; i < 16; ++i) mx = fmaxf(mx, S[mt][i]);
            mx = fmaxf(mx, __shfl_xor(mx, 32)) * sc2;
            if (!__all(mx <= mrow[nt] + 8.0f)) {
                const float mn = fmaxf(mrow[nt], mx), alpha = fexp2(mrow[nt] - mn);
                mrow[nt] = mn; lrow[nt] *= alpha;
#pragma unroll
                for (int dt = 0; dt < 2; ++dt)
#pragma unroll
                    for (int i = 0; i < 16; ++i) O[dt][nt][i] *= alpha;
            }
            const float mnew = mrow[nt];
#pragma unroll
            for (int mt = 0; mt < 2; ++mt) {
                const unsigned w = wm[nt][mt];
                float p[16];
#pragma unroll
                for (int i = 0; i < 16; ++i) { const int kl = (i & 3) + 8 * (i >> 2);
                    const float e = fexp2(S[mt][i] * sc2 - mnew); unsigned mk_; asm("v_bfe_i32 %0, %1, %2, 1" : "=v"(mk_) : "v"(w), "n"(kl));
                    p[i] = __builtin_bit_cast(float, __builtin_bit_cast(unsigned, e) & mk_); lrow[nt] += p[i]; }
#pragma unroll
                for (int half = 0; half < 2; ++half) {
                    const bf16x8 pb = pack8(p[8 * half + 0], p[8 * half + 1], p[8 * half + 2], p[8 * half + 3], p[8 * half + 4], p[8 * half + 5], p[8 * half + 6], p[8 * half + 7]);
#pragma unroll
                    for (int dt = 0; dt < 2; ++dt) O[dt][nt] = mfma32(va[dt][2 * mt + half], pb, O[dt][nt]);
                }
            }
            __builtin_amdgcn_sched_barrier(0);
        }
        if (kt < j) {
            const int nb = buf ^ 1;
            *(LAS v4u*)(Ks + nb * 64 * KSTR + krow_s * KSTR + 8 * kch_s) = kreg;
            const unsigned ve[4] = {vreg.x, vreg.y, vreg.z, vreg.w};
#pragma unroll
            for (int e = 0; e < 4; ++e) { Vt[nb * 64 * VSTR + (8 * vch_s + 2 * e) * VSTR + vkey_s] = (bf16)(ve[e] & 0xffffu); Vt[nb * 64 * VSTR + (8 * vch_s + 2 * e + 1) * VSTR + vkey_s] = (bf16)(ve[e] >> 16); }
        }
        __syncthreads();
    }
#pragma unroll
    for (int nt = 0; nt < 2; ++nt) {
        const float l = lrow[nt] + __shfl_xor(lrow[nt], 32); const float inv = 1.0f / l;
        bf16* orow = YC + (rb + 64 * j + 32 * nt + c) * DM + 512 + wave * 64;
#pragma unroll
        for (int dt = 0; dt < 2; ++dt)
#pragma unroll
            for (int g4 = 0; g4 < 4; ++g4) {
                v2u w; w.x = pk2(O[dt][nt][4 * g4 + 0] * inv, O[dt][nt][4 * g4 + 1] * inv); w.y = pk2(O[dt][nt][4 * g4 + 2] * inv, O[dt][nt][4 * g4 + 3] * inv);
                *(v2u*)(orow + 32 * dt + 8 * g4 + 4 * hi) = w;
            }
    }
    __syncthreads();
    }
}

__device__ __forceinline__ void conv_unit(const Frame& F, const bf16* U, bf16* YC, const float* conv_w, const float* conv_b, const float* ln_g, const float* ln_b, int tile) {
    LAUNDER_TID();
    const int b = tile >> 5, t0 = (tile & 31) * 64, c = tid;
    const size_t rb = (size_t)b * SEQ;
    LAS bf16* Hs = (LAS bf16*)F.lds;
    LAS float* O2 = (LAS float*)(F.lds + 94 * 512 * 2);
    LAS float* ST = (LAS float*)(F.lds + 94 * 512 * 2 + 8 * 512 * 4);
    {
        v4u tmp[12];
#pragma unroll
        for (int k = 0; k < 12; ++k) { const int e = tid + 512 * k, r = e >> 6, ch = e & 63; int t = t0 - 30 + r; t = t < 0 ? 0 : t; t = t > SEQ - 1 ? SEQ - 1 : t;
            tmp[k] = *(const v4u*)(U + (rb + t) * ABP + 8 * ch); }
#pragma unroll
        for (int k = 0; k < 12; ++k) { const int e = tid + 512 * k, r = e >> 6, ch = e & 63; const bool z = (t0 - 30 + r) < 0; v4u x = tmp[k]; if (z) { x.x = 0u; x.y = 0u; x.z = 0u; x.w = 0u; }
            if (r < 94) *(LAS v4u*)(Hs + r * 512 + 8 * ch) = x; }
    }
    float w[31];
#pragma unroll
    for (int jj = 0; jj < 31; ++jj) w[jj] = conv_w[jj * 512 + c];
    const float bias = conv_b[c], lg = ln_g[c], lb = ln_b[c];
    LDS_BARRIER();
    for (int grp = 0; grp < 8; ++grp) {
        float in[38];
#pragma unroll
        for (int r = 0; r < 38; ++r) in[r] = bf2f(Hs[(8 * grp + r) * 512 + c]);
        float o[8];
#pragma unroll
        for (int tl = 0; tl < 8; ++tl) { float acc = bias;
#pragma unroll
            for (int jj = 0; jj < 31; ++jj) acc += w[jj] * in[tl + jj];
            o[tl] = acc; O2[tl * 512 + c] = acc; }
        LDS_BARRIER();
        { float s = 0.f, s2 = 0.f;
#pragma unroll
          for (int e = 0; e < 8; ++e) { const float v = O2[F.wave * 512 + lane + 64 * e]; s += v; s2 += v * v; }
          s = wave_sum(s); s2 = wave_sum(s2);
          if (lane == 0) { const float mu = s * (1.0f / 512.0f), var = fmaxf(s2 * (1.0f / 512.0f) - mu * mu, 0.f); ST[2 * F.wave] = mu; ST[2 * F.wave + 1] = rsqrtf(var + EPS); } }
        LDS_BARRIER();
        f32x4 stv[4];
#pragma unroll
        for (int k4 = 0; k4 < 4; ++k4) stv[k4] = *(const LAS f32x4*)(ST + 4 * k4);
#pragma unroll
        for (int tl = 0; tl < 8; ++tl) { const float mu = (tl & 1) ? stv[tl >> 1].z : stv[tl >> 1].x, rs = (tl & 1) ? stv[tl >> 1].w : stv[tl >> 1].y; const float y = (o[tl] - mu) * rs * lg + lb; const float ya = fsilu(y);
            YC[(rb + t0 + 8 * grp + tl) * DM + c] = (bf16)f2bf(ya); }
    }
    LDS_BARRIER();
}

constexpr int XSTR = 520;
__device__ __forceinline__ void gla_prep_unit(const Frame& F, const bf16* U1, bf16* QT, bf16* KT, bf16* KTT, float* DEC, const float* g2_w, const float* g2_b, int unit) {
    LAUNDER_TID();
    const size_t r0 = (size_t)unit * 64; const int col = tid;
    LAS bf16* XQ = (LAS bf16*)F.lds;
    LAS bf16* XK = XQ + 64 * XSTR;
    LAS float* GL = (LAS float*)(F.lds + 2 * 64 * XSTR * 2);
    {
        v4u tmp[16];
#pragma unroll
        for (int k = 0; k < 16; ++k) { const int e = tid + 512 * k; tmp[k] = *(const v4u*)(U1 + (r0 + (e >> 7)) * CP + 8 * (e & 127)); }
#pragma unroll
        for (int k = 0; k < 16; ++k) { const int e = tid + 512 * k, row = e >> 7, ch = e & 127;
            LAS bf16* dst = (ch < 64) ? (XQ + row * XSTR + 8 * ch) : (XK + row * XSTR + 8 * (ch - 64)); *(LAS v4u*)dst = tmp[k]; }
    }
    for (int e = tid; e < 1024; e += 512) GL[e] = bf2f(U1[(r0 + (e >> 4)) * CP + C_GL + (e & 15)]);
    float w[16];
#pragma unroll
    for (int r = 0; r < 16; ++r) w[r] = g2_w[r * 512 + col];
    const float bias = g2_b[col];
    LDS_BARRIER();
    float bc = 0.f;
#pragma unroll 4
    for (int t = 0; t < 64; ++t) {
        float x = bias;
#pragma unroll
        for (int r4 = 0; r4 < 4; ++r4) { const f32x4 gvv = *(const LAS f32x4*)(GL + t * 16 + 4 * r4); x += gvv.x * w[4 * r4] + gvv.y * w[4 * r4 + 1] + gvv.z * w[4 * r4 + 2] + gvv.w * w[4 * r4 + 3]; }
        const float ls = fminf(x, 0.f) - 0.69314718056f * __builtin_amdgcn_logf(1.0f + fexp(-fabsf(x)));
        bc += ls * (1.0f / 16.0f);
        const float qv = bf2f(XQ[t * XSTR + col]), kv = bf2f(XK[t * XSTR + col]);
        XQ[t * XSTR + col] = (bf16)f2bf(qv * fexp(bc) * 0.08838834764f);
        XK[t * XSTR + col] = (bf16)f2bf(kv * fexp(-bc));
    }
    DEC[(size_t)unit * 512 + col] = fexp(bc);
    LDS_BARRIER();
#pragma unroll
    for (int k = 0; k < 8; ++k) { const int e = tid + 512 * k, row = e >> 6, ch = e & 63;
        *(v4u*)(QT + (r0 + row) * 512 + 8 * ch) = *(const LAS v4u*)(XQ + row * XSTR + 8 * ch);
        *(v4u*)(KT + (r0 + row) * 512 + 8 * ch) = *(const LAS v4u*)(XK + row * XSTR + 8 * ch); }
    {
        unsigned kp[32];
#pragma unroll
        for (int t2 = 0; t2 < 32; ++t2) kp[t2] = (unsigned)XK[(2 * t2) * XSTR + col] | ((unsigned)XK[(2 * t2 + 1) * XSTR + col] << 16);
        v4u* dst = (v4u*)(KTT + ((size_t)unit * 512 + col) * 64);
#pragma unroll
        for (int k = 0; k < 8; ++k) { v4u o; o.x = kp[4 * k]; o.y = kp[4 * k + 1]; o.z = kp[4 * k + 2]; o.w = kp[4 * k + 3]; dst[k] = o; }
    }
    LDS_BARRIER();
}
constexpr int QSTR = 136, TSTR = 72;
constexpr int VNSTR = 96;
constexpr int G2_QS = 0, G2_KS = 64 * QSTR * 2, G2_KT = 2 * 64 * QSTR * 2, G2_VT = G2_KT + 128 * TSTR * 2, G2_DS = G2_VT + 64 * VNSTR * 2, G2_BUF = G2_DS + 512;
constexpr int G2_AS = G2_BUF, G2_PO = G2_AS + 64 * TSTR * 2;
static_assert(G2_PO + 65536 <= LDS_CTL, "GLA scan LDS map");
__device__ __forceinline__ void g2_step_body(const Frame& F, LAS unsigned char* bp, LAS bf16* As, LAS float* PO, f32x16& S, const bf16* QT, bf16* OB, float* GSSQ, int b, int h, int vq, int ch, int tid, int lane) {
    const int wave = F.wave, c = lane & 31, hi = lane >> 5, vt = wave & 1, dt = wave >> 1; (void)tid; (void)QT;
        const size_t r0 = (size_t)b * SEQ + 64 * ch;
        const LAS bf16* Qs = (const LAS bf16*)(bp + G2_QS); const LAS bf16* Ks = (const LAS bf16*)(bp + G2_KS); const LAS bf16* KTs = (const LAS bf16*)(bp + G2_KT);
        const LAS float* Ds = (const LAS float*)(bp + G2_DS);
        for (int n = wave; n < 10; n += 8) {
            const int it = (n >= 6) ? 3 : (n >= 3) ? 2 : (n >= 1) ? 1 : 0, jt = n - (it * (it + 1)) / 2; const int r16 = lane & 15, g = lane >> 4;
            f32x4 acc = {0.f, 0.f, 0.f, 0.f};
#pragma unroll
            for (int ks = 0; ks < 4; ++ks) acc = mfma16(*(const LAS bf16x8*)(Ks + (16 * jt + r16) * QSTR + 32 * ks + 8 * g), *(const LAS bf16x8*)(Qs + (16 * it + r16) * QSTR + 32 * ks + 8 * g), acc);
            const int i = 16 * it + r16, j0 = 16 * jt + 4 * g;
            v2u w; w.x = pk2(j0 <= i ? acc[0] : 0.f, j0 + 1 <= i ? acc[1] : 0.f); w.y = pk2(j0 + 2 <= i ? acc[2] : 0.f, j0 + 3 <= i ? acc[3] : 0.f);
            *(LAS v2u*)(As + i * TSTR + j0) = w;
        }
        LDS_BARRIER();
        f32x16 OT[2];
#pragma unroll
        for (int it = 0; it < 2; ++it)
#pragma unroll
            for (int i = 0; i < 16; ++i) OT[it][i] = 0.f;
#pragma unroll
        for (int half = 0; half < 2; ++half) {
            const bf16x8 sa = pack8(S[8 * half + 0], S[8 * half + 1], S[8 * half + 2], S[8 * half + 3], S[8 * half + 4], S[8 * half + 5], S[8 * half + 6], S[8 * half + 7]);
#pragma unroll
            for (int it = 0; it < 2; ++it) { const LAS bf16* qp = Qs + (32 * it + c) * QSTR + 32 * dt + 16 * half + 4 * hi;
                OT[it] = mfma32(sa, mk8(*(const LAS v2u*)qp, *(const LAS v2u*)(qp + 8)), OT[it]); }
        }
        bf16x8 vf[4];
        {
            const unsigned va_ = (unsigned)(__UINTPTR_TYPE__)(bp + G2_VT) + (unsigned)((8 * hi + ((lane & 15) >> 2)) * (VNSTR * 2) + (32 * vt + 16 * ((lane >> 4) & 1) + 4 * (lane & 3)) * 2);
            v2u t0_, t1_, t2_, t3_, t4_, t5_, t6_, t7_;
            asm volatile("ds_read_b64_tr_b16 %0, %8\n\tds_read_b64_tr_b16 %1, %8 offset:768\n\tds_read_b64_tr_b16 %2, %8 offset:3072\n\tds_read_b64_tr_b16 %3, %8 offset:3840\n\t"
                         "ds_read_b64_tr_b16 %4, %8 offset:6144\n\tds_read_b64_tr_b16 %5, %8 offset:6912\n\tds_read_b64_tr_b16 %6, %8 offset:9216\n\tds_read_b64_tr_b16 %7, %8 offset:9984\n\t"
                         "s_waitcnt lgkmcnt(0)"
                         : "=&v"(t0_), "=&v"(t1_), "=&v"(t2_), "=&v"(t3_), "=&v"(t4_), "=&v"(t5_), "=&v"(t6_), "=&v"(t7_) : "v"(va_) : "memory");
            vf[0] = mk8(t0_, t1_); vf[1] = mk8(t2_, t3_); vf[2] = mk8(t4_, t5_); vf[3] = mk8(t6_, t7_);
        }
        {
            const bf16x8 va = (dt == 0) ? vf[0] : (dt == 1) ? vf[1] : (dt == 2) ? vf[2] : vf[3];
#pragma unroll
            for (int it = 0; it < 2; ++it) OT[it] = mfma32(va, *(const LAS bf16x8*)(As + (32 * it + c) * TSTR + 16 * dt + 8 * hi), OT[it]);
        }
#pragma unroll
        for (int it = 0; it < 2; ++it)
#pragma unroll
            for (int i = 0; i < 16; ++i) PO[(((dt * 2 + vt) * 2 + it) * 16 + i) * 64 + lane] = OT[it][i];
        LDS_BARRIER();
        {
            const int vt2 = wave & 1, it2 = (wave >> 1) & 1, q = wave >> 2;
            float o8[8];
#pragma unroll
            for (int jx = 0; jx < 8; ++jx) { float a = 0.f;
#pragma unroll
                for (int d4 = 0; d4 < 4; ++d4) a += PO[(((d4 * 2 + vt2) * 2 + it2) * 16 + 8 * q + jx) * 64 + lane];
                o8[jx] = a; }
            float ss = 0.f;
#pragma unroll
            for (int jx = 0; jx < 8; ++jx) ss += o8[jx] * o8[jx];
            ss += __shfl_xor(ss, 32);
            const size_t tok = r0 + 32 * it2 + c;
            bf16* orow = OB + tok * DM + h * 256 + 64 * vq + 32 * vt2 + 16 * q + 4 * hi;
            v2u w0, w1; w0.x = pk2(o8[0], o8[1]); w0.y = pk2(o8[2], o8[3]); w1.x = pk2(o8[4], o8[5]); w1.y = pk2(o8[6], o8[7]);
            *(v2u*)orow = w0; *(v2u*)(orow + 8) = w1;
            if (hi == 0) GSSQ[(tok * 4 + h) * 16 + vq * 4 + vt2 * 2 + q] = ss;
        }
#pragma unroll
        for (int kk = 0; kk < 4; ++kk) S = mfma32(*(const LAS bf16x8*)(KTs + (32 * dt + c) * TSTR + 16 * kk + 8 * hi), vf[kk], S);
#pragma unroll
        for (int g4 = 0; g4 < 4; ++g4) { const f32x4 dv = *(const LAS f32x4*)(Ds + 32 * dt + 8 * g4 + 4 * hi);
            S[4 * g4 + 0] *= dv.x; S[4 * g4 + 1] *= dv.y; S[4 * g4 + 2] *= dv.z; S[4 * g4 + 3] *= dv.w; }
}
__device__ __forceinline__ void gla_scan_unit(const Frame& F, const bf16* U1, const bf16* QT, const bf16* KT, const bf16* KTT, const float* DEC, bf16* OB, float* GSSQ, int b, int h, int vq) {
    LAUNDER_TID(); const int wave = F.wave, c = lane & 31, hi = lane >> 5, vt = wave & 1, dt = wave >> 1;
    LAS bf16* As = (LAS bf16*)(F.lds + G2_AS);
    LAS float* PO = (LAS float*)(F.lds + G2_PO);
    f32x16 S;
#pragma unroll
    for (int i = 0; i < 16; ++i) S[i] = 0.f;
    for (int e = tid; e < 64 * TSTR / 2; e += 512) ((LAS unsigned*)As)[e] = 0u;
    v4u pq0[2], pk0[2], pt0[2], pv0, pq1[2], pk1[2], pt1[2], pv1, pq2[2], pk2[2], pt2[2], pv2; f32x4 pd0 = {0.f, 0.f, 0.f, 0.f}, pd1 = pd0, pd2 = pd0;
    LAS unsigned char* const bp = F.lds;
#define G2_LOAD(cidx, X) do { const size_t r0_ = (size_t)b * SEQ + 64 * (cidx); const size_t u_ = (size_t)b * 32 + (cidx); \
        _Pragma("unroll") for (int k = 0; k < 2; ++k) { const int e = tid + 512 * k; \
            pq##X[k] = *(const v4u*)(QT + (r0_ + (e >> 4)) * 512 + h * 128 + 8 * (e & 15)); \
            pk##X[k] = *(const v4u*)(KT + (r0_ + (e >> 4)) * 512 + h * 128 + 8 * (e & 15)); \
            pt##X[k] = *(const v4u*)(KTT + (u_ * 512 + h * 128 + (e >> 3)) * 64 + 8 * (e & 7)); } \
        pv##X = *(const v4u*)(U1 + (r0_ + (tid >> 3)) * CP + C_V + h * 256 + 64 * vq + 8 * (tid & 7)); \
        if (tid < 32) pd##X = *(const f32x4*)(DEC + u_ * 512 + h * 128 + 4 * tid); } while (0)
#define G2_STORE(X) do { \
        _Pragma("unroll") for (int k = 0; k < 2; ++k) { const int e = tid + 512 * k; \
            *(LAS v4u*)((LAS bf16*)(bp + G2_QS) + (e >> 4) * QSTR + 8 * (e & 15)) = pq##X[k]; \
            *(LAS v4u*)((LAS bf16*)(bp + G2_KS) + (e >> 4) * QSTR + 8 * (e & 15)) = pk##X[k]; \
            *(LAS v4u*)((LAS bf16*)(bp + G2_KT) + (e >> 3) * TSTR + 8 * (e & 7)) = pt##X[k]; } \
        *(LAS v4u*)((LAS bf16*)(bp + G2_VT) + (tid >> 3) * VNSTR + 8 * (tid & 7)) = pv##X; \
        if (tid < 32) *(LAS f32x4*)((LAS float*)(bp + G2_DS) + 4 * tid) = pd##X; } while (0)
    G2_LOAD(0, 0); G2_LOAD(1, 1); G2_LOAD(2, 2);
    G2_STORE(0);
    __syncthreads();
#define G2_STEP(CH, LX, SX) do { const int ch = (CH); if (ch < 32) { \
        if (ch + 3 < 32) G2_LOAD(ch + 3, LX); \
        g2_step_body(F, bp, As, PO, S, QT, OB, GSSQ, b, h, vq, ch, tid, lane); \
        LDS_BARRIER(); \
        if (ch + 1 < 32) G2_STORE(SX); \
        LDS_BARRIER(); } } while (0)
#pragma unroll 1
    for (int ch0 = 0; ch0 < 33; ch0 += 3) { G2_STEP(ch0, 0, 1); G2_STEP(ch0 + 1, 1, 2); G2_STEP(ch0 + 2, 2, 0); }
#undef G2_STEP
#undef G2_LOAD
#undef G2_STORE
    __syncthreads();
}
__device__ __forceinline__ void gla_norm_gate(const Frame& F, const bf16* U1, bf16* YO, const bf16* OB, const float* GSSQ, const float* onorm_g) {
    LAUNDER_TID();
    const int gw = F.vcu * NWAVES + F.wave, NGW = F.G * NWAVES;
    f32x4 gv[2][2];
#pragma unroll
    for (int jx = 0; jx < 2; ++jx) { gv[jx][0] = *((const f32x4*)onorm_g + 2 * (lane + 64 * jx)); gv[jx][1] = *((const f32x4*)onorm_g + 2 * (lane + 64 * jx) + 1); }
    for (int m0 = gw * 4; m0 < M; m0 += NGW * 4) {
        v4u ov[4][2], rv[4][2]; float rs[4][2];
#pragma unroll
        for (int q = 0; q < 4; ++q)
#pragma unroll
            for (int jx = 0; jx < 2; ++jx) {
                ov[q][jx] = *((const v4u*)(OB + (size_t)(m0 + q) * DM) + lane + 64 * jx);
                rv[q][jx] = *((const v4u*)(U1 + (size_t)(m0 + q) * CP + C_R) + lane + 64 * jx);
                rs[q][jx] = 0.f;
            }
#pragma unroll
        for (int q = 0; q < 4; ++q) {
            float ps = GSSQ[(size_t)(m0 + q) * 64 + lane];
            ps += __shfl_xor(ps, 1); ps += __shfl_xor(ps, 2); ps += __shfl_xor(ps, 4); ps += __shfl_xor(ps, 8);
#pragma unroll
            for (int jx = 0; jx < 2; ++jx) rs[q][jx] = rsqrtf(__shfl(ps, 16 * ((lane + 64 * jx) >> 5)) * (1.0f / 256.0f) + EPS);
        }
#pragma unroll
        for (int q = 0; q < 4; ++q)
#pragma unroll
            for (int jx = 0; jx < 2; ++jx) {
                const unsigned ow[4] = {ov[q][jx].x, ov[q][jx].y, ov[q][jx].z, ov[q][jx].w}, rw[4] = {rv[q][jx].x, rv[q][jx].y, rv[q][jx].z, rv[q][jx].w};
                const float gg[8] = {gv[jx][0].x, gv[jx][0].y, gv[jx][0].z, gv[jx][0].w, gv[jx][1].x, gv[jx][1].y, gv[jx][1].z, gv[jx][1].w};
                unsigned yw[4];
#pragma unroll
                for (int e = 0; e < 4; ++e) { const float o0 = bf2f(ow[e] & 0xffffu), o1 = bf2f(ow[e] >> 16), r0v = bf2f(rw[e] & 0xffffu), r1v = bf2f(rw[e] >> 16);
                    yw[e] = pk2(o0 * rs[q][jx] * gg[2 * e] * fsilu(r0v), o1 * rs[q][jx] * gg[2 * e + 1] * fsilu(r1v)); }
                v4u y; y.x = yw[0]; y.y = yw[1]; y.z = yw[2]; y.w = yw[3];
                *((v4u*)(YO + (size_t)(m0 + q) * DM) + lane + 64 * jx) = y;
            }
    }
}

__device__ __forceinline__ void final_norm(const Frame& F, const bf16* hb, float* out, const float* ssq, const float* g) {
    LAUNDER_TID();
    const int gw = F.vcu * NWAVES + F.wave, NGW = F.G * NWAVES;
    f32x4 gv[2][2];
#pragma unroll
    for (int jx = 0; jx < 2; ++jx) { gv[jx][0] = *((const f32x4*)g + 2 * (lane + 64 * jx)); gv[jx][1] = *((const f32x4*)g + 2 * (lane + 64 * jx) + 1); }
    for (int m0 = gw * 4; m0 < M; m0 += NGW * 4) {
        v4u hv[4][2]; float r[4];
#pragma unroll
        for (int q = 0; q < 4; ++q) { float ps = (lane < 16) ? ssq[(size_t)(m0 + q) * 16 + lane] : 0.f; ps = wave_sum(ps); r[q] = rsqrtf(ps * (1.0f / 1024.0f) + EPS);
#pragma unroll
            for (int jx = 0; jx < 2; ++jx) hv[q][jx] = __builtin_nontemporal_load((const v4u*)(hb + (size_t)(m0 + q) * DM) + lane + 64 * jx); }
#pragma unroll
        for (int q = 0; q < 4; ++q)
#pragma unroll
            for (int jx = 0; jx < 2; ++jx) { const v4u w = hv[q][jx]; f32x4* o = (f32x4*)(out + (size_t)(m0 + q) * DM) + 2 * (lane + 64 * jx);
                f32x4 a, b; a.x = bf2f(w.x & 0xffffu); a.y = bf2f(w.x >> 16); a.z = bf2f(w.y & 0xffffu); a.w = bf2f(w.y >> 16); b.x = bf2f(w.z & 0xffffu); b.y = bf2f(w.z >> 16); b.z = bf2f(w.w & 0xffffu); b.w = bf2f(w.w >> 16);
                __builtin_nontemporal_store(a * r[q] * gv[jx][0], o); __builtin_nontemporal_store(b * r[q] * gv[jx][1], o + 1); }
    }
}

struct Args { const float* in[18]; float* out; unsigned char* ws; int ph_lo, ph_hi; };
constexpr int N_PHASES = 16;
#ifndef REP_P0
#define REP_P0 1
#endif
#ifndef REP_DSA
#define REP_DSA 1
#endif
#ifndef REP_CONV
#define REP_CONV 1
#endif
#ifndef REP_PREP
#define REP_PREP 1
#endif
#ifndef REP_SCAN
#define REP_SCAN 1
#endif
#ifndef MK_MULTI
#define MK_MULTI 0
#endif
__global__ void __launch_bounds__(NWAVES * 64, 2) fwd(Args args) {
    extern __shared__ __attribute__((aligned(16))) unsigned char lds_raw[];
    Frame F;
    F.lds = (LAS unsigned char*)lds_raw;
    F.tid = threadIdx.x; F.lane = F.tid & 63; F.wave = __builtin_amdgcn_readfirstlane(F.tid >> 6);
    F.G = gridDim.x; { const int bx = blockIdx.x; F.vcu = (F.G % 8 == 0) ? (bx % 8) * (F.G / 8) + bx / 8 : bx; }
    unsigned char* ws = args.ws;
    volatile LAS unsigned* MISC = (volatile LAS unsigned*)(F.lds + LDS_CTL);
    for (int u = F.tid; u < (LDS_BYTES - LDS_CTL) / 4; u += NWAVES * 64) ((LAS unsigned*)(F.lds + LDS_CTL))[u] = 0u;
    __syncthreads();
    unsigned* ctl = (unsigned*)(ws + WS_CTL);
    XcdBarrier bar = xcd_barrier_post(ctl + CW_BAR, MISC + 8);
    const int lo = args.ph_lo, hi = args.ph_hi;
#define IN(k) (lo <= (k) && (k) < hi)
#define SEAM(k) do { if (lo <= (k) && (k) + 1 < hi) xcd_barrier(bar); } while (0)
    float* ssq = (float*)(ws + WS_SSQ);
    const float* rope = (const float*)(ws + WS_ROPE);
    bf16* HB = (bf16*)(ws + WS_HB); bf16* UB = (bf16*)(ws + WS_U); bf16* YC = (bf16*)(ws + WS_YC); bf16* QT = (bf16*)(ws + WS_QT); bf16* KT = (bf16*)(ws + WS_KT); bf16* KTT = (bf16*)(ws + WS_KTT);
    float* DEC = (float*)(ws + WS_DEC); float* gssq = (float*)(ws + WS_GSSQ);

    P0Args A; A.x = args.in[0]; A.mix_g = args.in[1]; A.ab_w_in = args.in[2]; A.ab_w_out = args.in[7]; A.c_w_in = args.in[8]; A.c_w_out = args.in[12];
    A.ffn_g = args.in[13]; A.w_gate = args.in[14]; A.w_up = args.in[15]; A.w_down = args.in[16]; A.ws = ws;
    if (IN(0)) {
#pragma unroll 1
        for (int rep_ = 0; rep_ < REP_P0; ++rep_) p0_prologue(F, A);
    }
    SEAM(0);
#pragma unroll 1
    for (int L = 0; L < 2; ++L) {
        const int pb = 7 * L;
        if (IN(pb + 1)) {
            const int N = L ? CP : ABP;
            pg8::Gemm g{HB, (const bf16*)(ws + (L ? WS_WIN1 : WS_WIN0)), M, N, DM}; pg8::StaticOrder S; S.init(M, N, F.G, (int)blockIdx.x);
            pg8::EpiIn E{UB, N, ssq + (size_t)(2 * L) * M * 16, rope, L == 0 ? 1 : 0};
#pragma unroll 1
            for (int rep_ = 0; rep_ < REP_IN; ++rep_) pg8::gemm_phase<pg8::EpiIn, pg8::StaticOrder, true, true>(F.lds, g, S, E);
        }
        SEAM(pb + 1);
        if (L == 0) {
            if (IN(2)) {
#pragma unroll 1
                for (int pu = F.vcu; pu < 256; pu += F.G) {
                    const int b = pu >> 4, p = pu & 15;
#pragma unroll 1
                    for (int rep = 0; rep < 2 * REP_DSA; ++rep) dsa_unit(F, UB, YC, b, (rep & 1) ? p : 31 - p); }
#pragma unroll 1
                for (int rep_ = 0; rep_ < REP_CONV; ++rep_)
                for (int tile = F.vcu; tile < 512; tile += F.G) conv_unit(F, UB, YC, args.in[3], args.in[4], args.in[5], args.in[6], tile);
            }
            SEAM(2);
        } else {
            if (IN(9)) {
#pragma unroll 1
                for (int rep_ = 0; rep_ < REP_PREP; ++rep_)
                for (int unit = F.vcu; unit < 512; unit += F.G) gla_prep_unit(F, UB, QT, KT, KTT, DEC, args.in[9], args.in[10], unit); }
            SEAM(9);
            if (IN(10)) {
#pragma unroll 1
                for (int rep_ = 0; rep_ < REP_SCAN; ++rep_)
                for (int unit = F.vcu; unit < 256; unit += F.G) gla_scan_unit(F, UB, QT, KT, KTT, DEC, YC, rep_ + 1 < REP_SCAN ? (float*)args.out : gssq, unit >> 4, (unit >> 2) & 3, unit & 3);
            }
            SEAM(10);
            if (IN(11)) {
#pragma unroll 1
                for (int rep_ = 0; rep_ < REP_G3; ++rep_) gla_norm_gate(F, UB, rep_ + 1 < REP_G3 ? QT : YC, YC, gssq, args.in[11]); }
            SEAM(11);
        }
        if (IN(pb + 5)) {
            pg8::Gemm g{YC, (const bf16*)(ws + (L ? WS_WOUT1 : WS_WOUT0)), M, DM, DM}; pg8::StaticOrder S; S.init(M, DM, F.G, (int)blockIdx.x);
            pg8::EpiRes E{HB, HB, ssq + (size_t)(2 * L + 1) * M * 16, 0};
#if REP_OUT > 1
            { pg8::EpiRes EP{HB, QT, ssq + (size_t)5 * M * 16, PROBE_PMODE}; pg8::gemm_phase<pg8::EpiRes, pg8::StaticOrder, true, true>(F.lds, g, S, EP); }
#endif
            pg8::gemm_phase<pg8::EpiRes, pg8::StaticOrder, true, true>(F.lds, g, S, E);
        }
        SEAM(pb + 5);
        if (IN(pb + 6)) {
            pg8::Gemm g{HB, (const bf16*)(ws + (L ? WS_WGU1 : WS_WGU0)), M, GU, DM}; pg8::StaticOrder S; S.init(M, GU, F.G, (int)blockIdx.x, WGM_GU);
            pg8::EpiGLU E{UB, ssq + (size_t)(2 * L + 1) * M * 16, 0};
#if REP_GU > 1
            { pg8::EpiGLU EP{UB, ssq + (size_t)(2 * L + 1) * M * 16, PROBE_PMODE}; pg8::gemm_phase<pg8::EpiGLU, pg8::StaticOrder, true, true>(F.lds, g, S, EP); }
#endif
            pg8::gemm_phase<pg8::EpiGLU, pg8::StaticOrder, true, true>(F.lds, g, S, E);
        }
        SEAM(pb + 6);
        if (IN(pb + 7)) {
            pg8::Gemm g{UB, (const bf16*)(ws + (L ? WS_WDN1 : WS_WDN0)), M, DM, DFF}; pg8::StaticOrder S; S.init(M, DM, F.G, (int)blockIdx.x);
            pg8::EpiRes E{HB, HB, ssq + (size_t)(2 * L + 2) * M * 16, 0};
#if REP_DN > 1
            { pg8::EpiRes EP{HB, QT, ssq + (size_t)5 * M * 16, PROBE_PMODE}; pg8::gemm_phase<pg8::EpiRes, pg8::StaticOrder, true, true>(F.lds, g, S, EP); }
#endif
            pg8::gemm_phase<pg8::EpiRes, pg8::StaticOrder, true, true>(F.lds, g, S, E);
        }
        SEAM(pb + 7);
    }
    if (IN(15)) final_norm(F, HB, args.out, ssq + (size_t)4 * M * 16, args.in[17]);
#undef IN
#undef SEAM
}

extern "C" void kernel_launch(void* const* d_in, const int* in_sizes, int n_in, void* d_out, int out_size, void* d_ws, size_t ws_size, hipStream_t stream) {
    static int grid = 0;
    if (grid == 0) {
        if (n_in != 18 || in_sizes[0] != M * DM || out_size != M * DM || ws_size < WS_END) { fprintf(stderr, "kernel_launch: unexpected shapes (n_in %d, in0 %d, out %d, ws %zu); nothing launched\n", n_in, n_in > 0 ? in_sizes[0] : -1, out_size, ws_size); grid = -1; return; }
        int dev = 0, cus = 0, per_cu = 0;
        if (hipGetDevice(&dev) != hipSuccess || hipDeviceGetAttribute(&cus, hipDeviceAttributeMultiprocessorCount, dev) != hipSuccess) { grid = -1; return; }
        if (hipFuncSetAttribute((const void*)fwd, hipFuncAttributeMaxDynamicSharedMemorySize, LDS_BYTES) != hipSuccess) { fprintf(stderr, "kernel_launch: hipFuncSetAttribute failed\n"); grid = -1; return; }
        if (hipOccupancyMaxActiveBlocksPerMultiprocessor(&per_cu, (const void*)fwd, NWAVES * 64, LDS_BYTES) != hipSuccess || per_cu < 1) fprintf(stderr, "kernel_launch: occupancy query reports %d\n", per_cu);
        (void)hipGetLastError();
        grid = cus;
    }
    if (grid < 0) return;
    if (hipMemsetAsync((char*)d_ws + WS_CTL, 0, CTL_ZERO_BYTES, stream) != hipSuccess) return;
    Args a{};
    for (int i = 0; i < 18; ++i) a.in[i] = (const float*)d_in[i];
    a.out = (float*)d_out; a.ws = (unsigned char*)d_ws;
#if MK_MULTI
    for (int k = 0; k < N_PHASES; ++k) { if (k == 3 || k == 4) continue; a.ph_lo = k; a.ph_hi = k + 1; hipLaunchKernelGGL(fwd, dim3(grid), dim3(NWAVES * 64), LDS_BYTES, stream, a); }
#else
    a.ph_lo = 0; a.ph_hi = N_PHASES; hipLaunchKernelGGL(fwd, dim3(grid), dim3(NWAVES * 64), LDS_BYTES, stream, a);
#endif
}
```

```cpp
#include <hip/hip_runtime.h>
#include <cstdio>
#include <cstdint>
#ifndef REP_IN
#define REP_IN 1
#endif
#ifndef REP_GU
#define REP_GU 1
#endif
#ifndef REP_DSA12
#define REP_DSA12 1
#endif
#ifndef REP_DSA3
#define REP_DSA3 1
#endif
#ifndef REP_DSA1
#define REP_DSA1 1
#endif
#ifndef REP_DSA2
#define REP_DSA2 1
#endif
#ifndef REP_OUT
#define REP_OUT 1
#endif
#ifndef REP_DN
#define REP_DN 1
#endif
#ifndef REP_G3
#define REP_G3 1
#endif
#ifndef PROBE_PMODE
#define PROBE_PMODE 0
#endif
#ifndef WGM_GU
#define WGM_GU 8
#endif
namespace pg8 {
#define PG8_LAS __attribute__((address_space(3)))
typedef unsigned short bf16_t;
typedef short bf16x8 __attribute__((ext_vector_type(8)));
typedef float f32x4 __attribute__((ext_vector_type(4)));
typedef unsigned u32x4 __attribute__((ext_vector_type(4)));
constexpr int BM = 256, BK = 64, HALF = 128, HTB = HALF * BK * 2  , STAGE_BYTES = 8 * HTB, NXCD = 8, WGM = 8;

__host__ __device__ __forceinline__ int lds_byte(int r, int c) { const int st = (r >> 4) * 2 + (c >> 5), rr = r & 15, cc = c & 31, ob = rr * 64 + cc * 2; return st * 1024 + (ob ^ (((ob >> 9) & 1) << 5)); }
__host__ __device__ __forceinline__ void stage_rc(int b, int& R, int& C) { const int st = b / 1024, sb = b % 1024, swz = sb ^ (((sb >> 9) & 1) << 5); R = (st >> 1) * 16 + swz / 64; C = (st & 1) * 32 + (swz % 64) / 2; }
__host__ __device__ __forceinline__ int perm32(int rho) { const int n = rho >> 4, i = rho & 15; return 8 * (i >> 2) + 4 * n + (i & 3); }

struct Unit { int pm, pn; };
struct Gemm { const bf16_t* A; const bf16_t* Bt; int M, N, K; };

struct StaticOrder {
    int nM, nN, nwg, G, c, wgm;
    __host__ __device__ void init(int M, int N, int G_, int c_, int wgm_ = WGM) { nM = M / BM; nN = N / BM; nwg = nM * nN; G = G_; c = c_; wgm = wgm_; }
    __host__ __device__ bool next(int i, Unit& u) const {
        const long L = (long)i * G + c; if (L >= nwg) return false;
        int wgid = (int)L; { const int q = nwg / NXCD, r = nwg % NXCD, xcd = wgid % NXCD, off = wgid / NXCD; wgid = (xcd < r ? xcd * (q + 1) : r * (q + 1) + (xcd - r) * q) + off; }
        const int nig = wgm * nN, gid = wgid / nig, fm = gid * wgm, gsz = (nM - fm) < wgm ? (nM - fm) : wgm;
        u.pm = fm + ((wgid % nig) % gsz); u.pn = (wgid % nig) / gsz; return true;
    }
    __device__ __forceinline__ void a_ready(const Unit&) const {}
    __device__ __forceinline__ void done(const Unit&) const {}
};

__device__ __forceinline__ unsigned cvt_pk_bf16(float lo, float hi) { unsigned r; asm volatile("v_cvt_pk_bf16_f32 %0, %1, %2" : "=v"(r) : "v"(lo), "v"(hi)); return r; }
typedef float f32x2 __attribute__((ext_vector_type(2)));
typedef unsigned u32x2 __attribute__((ext_vector_type(2)));
constexpr float RMS_EPS = 1e-6f;
struct EpiIn {
    static constexpr bool PERM = true, AFTER_DRAIN = false, PREF = true;
    bf16_t* O; int ldc; const float* ssq; const float* rope; int do_rope;
    __device__ __forceinline__ void pref(const Unit& u, int wr, int lane, float& p0, float& p1) const { const f32x4* s = (const f32x4*)(ssq + (size_t)(u.pm * BM + wr * 64 + lane) * 16);
        const f32x4 a0 = s[0], a1 = s[1], a2 = s[2], a3 = s[3], b0 = s[4 * HALF], b1 = s[4 * HALF + 1], b2 = s[4 * HALF + 2], b3 = s[4 * HALF + 3];
        const f32x4 sa = (a0 + a1) + (a2 + a3), sb = (b0 + b1) + (b2 + b3); p0 = (sa.x + sa.y) + (sa.z + sa.w); p1 = (sb.x + sb.y) + (sb.z + sb.w); }
    __device__ __forceinline__ void operator()(const f32x4 (&acc)[2][2][4][2], const Unit& u, int wr, int wc, int fr, int fq, float p0, float p1) const {
        const int row0 = u.pm * BM + wr * 64 + fr, cg0 = u.pn * BM + wc * 32;
#pragma unroll
        for (int ai = 0; ai < 2; ++ai)
#pragma unroll
            for (int m = 0; m < 4; ++m) {
                const int row = row0 + ai * HALF + m * 16;
                const float r = rsqrtf(__shfl(ai ? p1 : p0, fr + 16 * m) * (1.0f / 1024.0f) + RMS_EPS);
                bf16_t* rowp = O + (size_t)row * ldc + cg0 + 8 * fq;
                if (do_rope && u.pn < 4) {
                    float hh[8];
#pragma unroll
                    for (int n = 0; n < 2; ++n)
#pragma unroll
                        for (int e2 = 0; e2 < 4; ++e2) { const float a = acc[ai][0][m][n][e2] * r, g = acc[ai][1][m][n][e2] * r; hh[4 * n + e2] = a * __builtin_amdgcn_rcpf(1.0f + __expf(-g)); }
                    u32x4 w; w.x = cvt_pk_bf16(hh[0], hh[1]); w.y = cvt_pk_bf16(hh[2], hh[3]); w.z = cvt_pk_bf16(hh[4], hh[5]); w.w = cvt_pk_bf16(hh[6], hh[7]);
                    __builtin_nontemporal_store(w, (u32x4*)(O + (size_t)row * ldc + u.pn * HALF + wc * 32 + 8 * fq));
                    continue;
                }
#pragma unroll
                for (int bj = 0; bj < 2; ++bj) {
                    f32x4 v0 = acc[ai][bj][m][0] * r, v1 = acc[ai][bj][m][1] * r;
                    const int cg = cg0 + bj * HALF;
                    const bool rp = do_rope && ((cg & 63) == 0) && ((cg >= 1024 && cg < 1600) || (cg >= 1664 && cg < 2240));
                    if (rp) {
                        const float* cs = rope + (row & 2047) * 16;
                        const f32x4 c0 = *(const f32x4*)cs, c1 = *(const f32x4*)(cs + 4), s0 = *(const f32x4*)(cs + 8), s1 = *(const f32x4*)(cs + 12);
                        f32x4 p0, p1;
#pragma unroll
                        for (int e = 0; e < 4; ++e) { p0[e] = __shfl_xor(v0[e], 16); p1[e] = __shfl_xor(v1[e], 16); }
                        const float sg = (fq == 0) ? -1.0f : 1.0f;
                        if (fq < 2) { v0 = v0 * c0 + p0 * s0 * sg; v1 = v1 * c1 + p1 * s1 * sg; }
                    }
                    u32x4 w; w.x = cvt_pk_bf16(v0[0], v0[1]); w.y = cvt_pk_bf16(v0[2], v0[3]); w.z = cvt_pk_bf16(v1[0], v1[1]); w.w = cvt_pk_bf16(v1[2], v1[3]);
                    __builtin_nontemporal_store(w, (u32x4*)(rowp + bj * HALF));
                }
            }
    }
};
struct EpiRes {
    static constexpr bool PERM = true, AFTER_DRAIN = false, PREF = false;
    const bf16_t* hin; bf16_t* hb; float* ssq; int pmode;
    __device__ __forceinline__ void operator()(const f32x4 (&acc)[2][2][4][2], const Unit& u, int wr, int wc, int fr, int fq) const {
        const int row0 = u.pm * BM + wr * 64 + fr, col0 = u.pn * BM + wc * 32 + 8 * fq;
#pragma unroll
        for (int ai = 0; ai < 2; ++ai)
#pragma unroll
            for (int m = 0; m < 4; ++m) {
                const int row = row0 + ai * HALF + m * 16; const size_t ro = (size_t)row * 1024 + col0; float s = 0.f;
                u32x4 old[2];
#pragma unroll
                for (int bj = 0; bj < 2; ++bj) { if (pmode >= 1) old[bj] = (u32x4){0u, 0u, 0u, 0u}; else old[bj] = *(const u32x4*)(hin + ro + bj * HALF); }
#pragma unroll
                for (int bj = 0; bj < 2; ++bj) {
                    f32x4 v0 = acc[ai][bj][m][0], v1 = acc[ai][bj][m][1];
                    v0[0] += __builtin_bit_cast(float, old[bj].x << 16); v0[1] += __builtin_bit_cast(float, old[bj].x & 0xffff0000u);
                    v0[2] += __builtin_bit_cast(float, old[bj].y << 16); v0[3] += __builtin_bit_cast(float, old[bj].y & 0xffff0000u);
                    v1[0] += __builtin_bit_cast(float, old[bj].z << 16); v1[1] += __builtin_bit_cast(float, old[bj].z & 0xffff0000u);
                    v1[2] += __builtin_bit_cast(float, old[bj].w << 16); v1[3] += __builtin_bit_cast(float, old[bj].w & 0xffff0000u);
                    u32x4 w; w.x = cvt_pk_bf16(v0[0], v0[1]); w.y = cvt_pk_bf16(v0[2], v0[3]); w.z = cvt_pk_bf16(v1[0], v1[1]); w.w = cvt_pk_bf16(v1[2], v1[3]);
                    if (pmode < 3) __builtin_nontemporal_store(w, (u32x4*)(hb + ro + bj * HALF));
                    s += ((v0[0] * v0[0] + v0[1] * v0[1]) + (v0[2] * v0[2] + v0[3] * v0[3])) + ((v1[0] * v1[0] + v1[1] * v1[1]) + (v1[2] * v1[2] + v1[3] * v1[3]));
                }
                s += __shfl_xor(s, 16); s += __shfl_xor(s, 32);
                if (fq == 0 && pmode < 2) ssq[(size_t)row * 16 + u.pn * 4 + wc] = s;
                if (pmode >= 3 && s == 12345.678f) hb[ro] = 0;
                if (m & 1) asm volatile("" ::: "memory");
            }
    }
};
struct EpiGLU {
    static constexpr bool PERM = true, AFTER_DRAIN = false, PREF = true;
    bf16_t* O; const float* ssq; int pmode;
    __device__ __forceinline__ void pref(const Unit& u, int wr, int lane, float& p0, float& p1) const { const f32x4* s = (const f32x4*)(ssq + (size_t)(u.pm * BM + wr * 64 + lane) * 16);
        const f32x4 a0 = s[0], a1 = s[1], a2 = s[2], a3 = s[3], b0 = s[4 * HALF], b1 = s[4 * HALF + 1], b2 = s[4 * HALF + 2], b3 = s[4 * HALF + 3];
        const f32x4 sa = (a0 + a1) + (a2 + a3), sb = (b0 + b1) + (b2 + b3); p0 = (sa.x + sa.y) + (sa.z + sa.w); p1 = (sb.x + sb.y) + (sb.z + sb.w); }
    __device__ __forceinline__ void operator()(const f32x4 (&acc)[2][2][4][2], const Unit& u, int wr, int wc, int fr, int fq, float p0, float p1) const {
        const int row0 = u.pm * BM + wr * 64 + fr, col0 = u.pn * HALF + wc * 32 + 8 * fq;
#pragma unroll
        for (int ai = 0; ai < 2; ++ai)
#pragma unroll
            for (int m = 0; m < 4; ++m) {
                const int row = row0 + ai * HALF + m * 16;
                const float r = rsqrtf(__shfl(ai ? p1 : p0, fr + 16 * m) * (1.0f / 1024.0f) + RMS_EPS);
                float a[8];
#pragma unroll
                for (int n = 0; n < 2; ++n)
#pragma unroll
                    for (int e = 0; e < 4; ++e) { const float g = acc[ai][0][m][n][e] * r, up = acc[ai][1][m][n][e] * r;
                        a[4 * n + e] = (pmode >= 1) ? (g + up) : g * __builtin_amdgcn_rcpf(1.0f + __expf(-g)) * up; }
                u32x4 w; w.x = cvt_pk_bf16(a[0], a[1]); w.y = cvt_pk_bf16(a[2], a[3]); w.z = cvt_pk_bf16(a[4], a[5]); w.w = cvt_pk_bf16(a[6], a[7]);
                if (pmode < 2 || a[0] == 12345.678f) __builtin_nontemporal_store(w, (u32x4*)(O + (size_t)row * 2816 + col0));
            }
    }
};

template <class Epi, class Sched, bool ALIGN_EPI = false, bool SP2 = false>
__device__ __forceinline__ void gemm_phase(PG8_LAS unsigned char* lds, const Gemm g, const Sched& S, const Epi& E) {
    int tid_ = threadIdx.x; asm volatile("" : "+v"(tid_));
    const int tid = tid_, wid = __builtin_amdgcn_readfirstlane(tid >> 6), lane = tid & 63, wr = wid >> 2, wc = wid & 3, fr = lane & 15, fq = lane >> 4;
    const int K = g.K, nt = K / BK;
    unsigned voffA[2], voffB[2];
#pragma unroll
    for (int i = 0; i < 2; ++i) { int R, C; stage_rc(tid * 16 + i * 8192, R, C); const int Rb = Epi::PERM ? ((R & ~31) + perm32(R & 31)) : R;
        voffA[i] = (unsigned)(R * K + C) * 2u; voffB[i] = (unsigned)(Rb * K + C) * 2u; }
    const size_t kstep = (size_t)(BK * 2);
    const size_t hstep = (size_t)HALF * K * 2;
    const size_t tstep = 2 * hstep;
    const unsigned ldsw = (unsigned)wid * 1024u;
    const int aoff = lds_byte(wr * 64 + fr, fq * 8), boff = lds_byte(wc * 32 + fr, fq * 8);
#define PG8_SA(b, h) (((b) * 2 + (h)) * HTB)
#define PG8_SB(b, h) ((4 + (b) * 2 + (h)) * HTB)
#define PG8_STAGE(bufoff, gbase, voff) do { _Pragma("unroll") for (int _i = 0; _i < 2; ++_i) \
        __builtin_amdgcn_global_load_lds((const unsigned*)((const char*)(gbase) + (voff)[_i]), (PG8_LAS unsigned*)(lds + (bufoff) + ldsw + _i * 8192), 16, 0, 0); } while (0)
#define PG8_LDA(dst, b, h) do { _Pragma("unroll") for (int m = 0; m < 4; ++m) _Pragma("unroll") for (int k = 0; k < 2; ++k) dst[m][k] = *(const PG8_LAS bf16x8*)(lds + PG8_SA(b, h) + aoff + m * 2048 + k * 1024); } while (0)
#define PG8_LDB(dst, b, h) do { _Pragma("unroll") for (int n = 0; n < 2; ++n) _Pragma("unroll") for (int k = 0; k < 2; ++k) dst[n][k] = *(const PG8_LAS bf16x8*)(lds + PG8_SB(b, h) + boff + n * 2048 + k * 1024); } while (0)
#define PG8_MMA(ai, bj, At, Bt) do { __builtin_amdgcn_s_setprio(1); _Pragma("unroll") for (int m = 0; m < 4; ++m) _Pragma("unroll") for (int n = 0; n < 2; ++n) _Pragma("unroll") for (int k = 0; k < 2; ++k) \
        acc[ai][bj][m][n] = __builtin_amdgcn_mfma_f32_16x16x32_bf16(Bt[n][k], At[m][k], acc[ai][bj][m][n], 0, 0, 0); __builtin_amdgcn_s_setprio(0); } while (0)
#define PG8_WAIT_V(n) asm volatile("s_waitcnt vmcnt(" #n ")" ::: "memory")
#define PG8_WAIT_L(n) asm volatile("s_waitcnt lgkmcnt(" #n ")" ::: "memory")
#define PG8_BAR __builtin_amdgcn_s_barrier()
#define PG8_SCHED __builtin_amdgcn_sched_barrier(0)
    Unit cur, nxt; int ui = 0;
    if (!S.next(0, cur)) return;
    f32x4 acc[2][2][4][2];
#pragma unroll
    for (int a = 0; a < 2; ++a)
#pragma unroll
        for (int b = 0; b < 2; ++b)
#pragma unroll
            for (int m = 0; m < 4; ++m)
#pragma unroll
                for (int n = 0; n < 2; ++n) acc[a][b][m][n] = (f32x4){0.f, 0.f, 0.f, 0.f};
    bf16x8 At[4][2], B0[2][2], B1[2][2];
    const char* cA = (const char*)g.A + (size_t)cur.pm * tstep; const char* cB = (const char*)g.Bt + (size_t)cur.pn * tstep;
    float pf0 = 0.f, pf1 = 0.f;
    if constexpr (Epi::PREF) E.pref(cur, wr, lane, pf0, pf1);
    S.a_ready(cur);
    if constexpr (SP2) {
        PG8_STAGE(PG8_SB(0, 0), cB, voffB); PG8_STAGE(PG8_SB(0, 1), cB + hstep, voffB); PG8_STAGE(PG8_SA(0, 0), cA, voffA); PG8_STAGE(PG8_SA(0, 1), cA + hstep, voffA);
        if (wr == 1) PG8_BAR;
        PG8_WAIT_V(2); PG8_BAR;
        PG8_STAGE(PG8_SB(1, 0), cB + kstep, voffB); PG8_STAGE(PG8_SA(1, 0), cA + kstep, voffA); PG8_STAGE(PG8_SB(1, 1), cB + hstep + kstep, voffB);
        PG8_WAIT_V(6); PG8_BAR;
    } else {
        PG8_STAGE(PG8_SB(0, 0), cB, voffB); PG8_STAGE(PG8_SA(0, 0), cA, voffA); PG8_STAGE(PG8_SB(0, 1), cB + hstep, voffB); PG8_STAGE(PG8_SA(0, 1), cA + hstep, voffA);
        if (wr == 1) PG8_BAR;
        PG8_WAIT_V(4); PG8_BAR;
        PG8_STAGE(PG8_SB(1, 0), cB + kstep, voffB); PG8_STAGE(PG8_SA(1, 0), cA + kstep, voffA); PG8_STAGE(PG8_SB(1, 1), cB + hstep + kstep, voffB);
        PG8_WAIT_V(6); PG8_BAR;
    }
    for (;;) {
        const bool has_next = S.next(ui + 1, nxt);
        const char* nA = has_next ? (const char*)g.A + (size_t)nxt.pm * tstep : cA; const char* nB = has_next ? (const char*)g.Bt + (size_t)nxt.pn * tstep : cB;
        for (int t = 0; t < nt; t += 2) {
            const bool last = (t == nt - 2);
            const char* a1 = cA + (size_t)(t + 1) * kstep;
            const char* a2 = last ? nA : cA + (size_t)(t + 2) * kstep; const char* b2 = last ? nB : cB + (size_t)(t + 2) * kstep;
            const char* a3 = a2 + kstep; const char* b3 = b2 + kstep;
            if (last && has_next) S.a_ready(nxt);
            if constexpr (SP2) {
            PG8_LDB(B0, 0, 0); PG8_LDB(B1, 0, 1); PG8_SCHED; PG8_LDA(At, 0, 0); PG8_STAGE(PG8_SA(1, 1), a1 + hstep, voffA);
            PG8_WAIT_V(8); PG8_WAIT_L(0); PG8_BAR; PG8_MMA(0, 0, At, B0); PG8_MMA(0, 1, At, B1); PG8_BAR; PG8_SCHED;
            PG8_LDA(At, 0, 1); PG8_STAGE(PG8_SB(0, 0), b2, voffB); PG8_STAGE(PG8_SB(0, 1), b2 + hstep, voffB); PG8_STAGE(PG8_SA(0, 0), a2, voffA);
            PG8_WAIT_V(8); PG8_WAIT_L(0); PG8_BAR; PG8_MMA(1, 0, At, B0); PG8_MMA(1, 1, At, B1); PG8_BAR; PG8_SCHED;
            PG8_LDB(B0, 1, 0); PG8_LDB(B1, 1, 1); PG8_SCHED; PG8_LDA(At, 1, 0); PG8_STAGE(PG8_SA(0, 1), a2 + hstep, voffA);
            PG8_WAIT_V(8); PG8_WAIT_L(0); PG8_BAR; PG8_MMA(0, 0, At, B0); PG8_MMA(0, 1, At, B1); PG8_BAR; PG8_SCHED;
            PG8_LDA(At, 1, 1); PG8_STAGE(PG8_SB(1, 0), b3, voffB); PG8_STAGE(PG8_SB(1, 1), b3 + hstep, voffB); PG8_STAGE(PG8_SA(1, 0), a3, voffA);
            PG8_WAIT_V(8); PG8_WAIT_L(0); PG8_BAR; PG8_MMA(1, 0, At, B0); PG8_MMA(1, 1, At, B1); PG8_BAR; PG8_SCHED;
            } else {
            PG8_LDB(B0, 0, 0); PG8_SCHED; PG8_LDA(At, 0, 0); PG8_STAGE(PG8_SA(1, 1), a1 + hstep, voffA);
            PG8_WAIT_L(8); PG8_BAR; PG8_WAIT_L(0); PG8_MMA(0, 0, At, B0); PG8_BAR; PG8_SCHED;
            PG8_LDB(B1, 0, 1); PG8_STAGE(PG8_SB(0, 0), b2, voffB);
            PG8_BAR; PG8_WAIT_L(0); PG8_MMA(0, 1, At, B1); PG8_BAR;
            PG8_LDA(At, 0, 1); PG8_STAGE(PG8_SA(0, 0), a2, voffA);
            PG8_BAR; PG8_WAIT_L(0); PG8_MMA(1, 0, At, B0); PG8_BAR; PG8_SCHED;
            PG8_STAGE(PG8_SB(0, 1), b2 + hstep, voffB);
            PG8_WAIT_V(6); PG8_BAR; PG8_MMA(1, 1, At, B1); PG8_BAR;
            PG8_LDB(B0, 1, 0); PG8_SCHED; PG8_LDA(At, 1, 0); PG8_STAGE(PG8_SA(0, 1), a2 + hstep, voffA);
            PG8_WAIT_L(8); PG8_BAR; PG8_WAIT_L(0); PG8_MMA(0, 0, At, B0); PG8_BAR; PG8_SCHED;
            PG8_LDB(B1, 1, 1); PG8_STAGE(PG8_SB(1, 0), b3, voffB);
            PG8_BAR; PG8_WAIT_L(0); PG8_MMA(0, 1, At, B1); PG8_BAR;
            PG8_LDA(At, 1, 1); PG8_STAGE(PG8_SA(1, 0), a3, voffA);
            PG8_BAR; PG8_WAIT_L(0); PG8_MMA(1, 0, At, B0); PG8_BAR; PG8_SCHED;
            PG8_STAGE(PG8_SB(1, 1), b3 + hstep, voffB);
            PG8_WAIT_V(6); PG8_BAR; PG8_MMA(1, 1, At, B1); PG8_BAR;
            }
        }
        if constexpr (ALIGN_EPI) { if (wr == 0) PG8_BAR; }
        if constexpr (!Epi::AFTER_DRAIN) { if constexpr (Epi::PREF) { E(acc, cur, wr, wc, fr, fq, pf0, pf1); if (has_next) E.pref(nxt, wr, lane, pf0, pf1); } else E(acc, cur, wr, wc, fr, fq); S.done(cur); }
        if (!has_next) break;
#pragma unroll
        for (int a = 0; a < 2; ++a)
#pragma unroll
            for (int b = 0; b < 2; ++b)
#pragma unroll
                for (int m = 0; m < 4; ++m)
#pragma unroll
                    for (int n = 0; n < 2; ++n) acc[a][b][m][n] = (f32x4){0.f, 0.f, 0.f, 0.f};
        cur = nxt; cA = nA; cB = nB; ++ui;
        if constexpr (ALIGN_EPI) { if (wr == 1) PG8_BAR; }
    }
    PG8_WAIT_V(0);
    if constexpr (!ALIGN_EPI) { if (wr == 0) PG8_BAR; }
    PG8_BAR;
    if constexpr (Epi::AFTER_DRAIN) { E.fused(acc, cur, wr, wc, fr, fq, lds, wid, lane); S.done(cur); }
#undef PG8_SA
#undef PG8_SB
#undef PG8_STAGE
#undef PG8_LDA
#undef PG8_LDB
#undef PG8_MMA
#undef PG8_WAIT_V
#undef PG8_WAIT_L
#undef PG8_BAR
#undef PG8_SCHED
}
}
constexpr int NWAVES = 8;
constexpr int NB = 16, SEQ = 2048, DM = 1024, M = NB * SEQ;
constexpr int ABN = 2248, ABP = 2304, CN = 3088, CP = 3328, DFF = 2816, GU = 2 * DFF;
constexpr int AB_G = 512, AB_Q = 1024, AB_K = 1536, AB_V = 1600, AB_IQ = 1664, AB_IK = 2176, AB_IW = 2240;
constexpr int C_K = 512, C_V = 1024, C_R = 2048, C_GL = 3072;
constexpr float EPS = 1e-6f;
constexpr size_t MiB = 1u << 20;
constexpr size_t WS_CTL = 0, CTL_ZERO_BYTES = 1 * MiB;
constexpr size_t WS_ROPE = 5 * MiB / 2, WS_DEC = 3 * MiB;
constexpr size_t WS_WIN0 = 4 * MiB, WS_WIN1 = WS_WIN0 + (size_t)ABP * DM * 2, WS_WOUT0 = WS_WIN1 + (size_t)CP * DM * 2, WS_WOUT1 = WS_WOUT0 + 2 * MiB;
constexpr size_t WS_WGU0 = WS_WOUT1 + 2 * MiB, WS_WGU1 = WS_WGU0 + (size_t)GU * DM * 2, WS_WDN0 = WS_WGU1 + (size_t)GU * DM * 2, WS_WDN1 = WS_WDN0 + (size_t)DM * DFF * 2;
constexpr size_t WS_HB = 52 * MiB, WS_U = 116 * MiB, WS_YC = 324 * MiB, WS_QT = 388 * MiB, WS_KT = 420 * MiB, WS_KTT = 452 * MiB, WS_SSQ = 484 * MiB, WS_GSSQ = 496 * MiB, WS_END = 504 * MiB;
static_assert(WS_WDN1 + (size_t)DM * DFF * 2 <= WS_HB && WS_HB + (size_t)M * DM * 2 <= WS_U && WS_U + (size_t)M * CP * 2 <= WS_YC && WS_YC + (size_t)M * DM * 2 <= WS_QT && WS_QT + (size_t)M * 512 * 2 <= WS_KT && WS_KT + (size_t)M * 512 * 2 <= WS_KTT && WS_KTT + (size_t)M * 512 * 2 <= WS_SSQ && WS_SSQ + (size_t)6 * M * 64 <= WS_GSSQ && WS_GSSQ + (size_t)M * 256 <= WS_END, "d_ws map");
constexpr int CW_BAR = 4096;
constexpr int SC_STRIDE = 2064;
constexpr int LDS_BM = 16 * SC_STRIDE * 4;
constexpr int LDS_CTL = LDS_BM + 16384;
constexpr int LDS_BYTES = LDS_CTL + 1024;
#define GAS __attribute__((address_space(1)))
#define LAS __attribute__((address_space(3)))
typedef unsigned short bf16;
typedef unsigned v4u __attribute__((ext_vector_type(4)));
typedef unsigned v2u __attribute__((ext_vector_type(2)));
typedef float f32x4 __attribute__((ext_vector_type(4)));
typedef float f32x16 __attribute__((ext_vector_type(16)));
typedef short bf16x8 __attribute__((ext_vector_type(8)));
#define LDS_WAIT() asm volatile("s_waitcnt lgkmcnt(0)" ::: "memory")
#define LDS_BARRIER() do { asm volatile("s_waitcnt lgkmcnt(0)" ::: "memory"); __builtin_amdgcn_s_barrier(); asm volatile("" ::: "memory"); } while (0)
typedef __bf16 bf16pair_t __attribute__((ext_vector_type(2)));
__device__ __forceinline__ unsigned pk2(float lo, float hi) { bf16pair_t v; v.x = (__bf16)lo; v.y = (__bf16)hi; return __builtin_bit_cast(unsigned, v); }
__device__ __forceinline__ unsigned f2bf(float f) { return pk2(f, 0.f) & 0xffffu; }
__device__ __forceinline__ float fexp2(float x) { return __builtin_amdgcn_exp2f(x); }
__device__ __forceinline__ float fexp(float x) { return __builtin_amdgcn_exp2f(x * 1.44269504089f); }
__device__ __forceinline__ float frcp(float x) { return __builtin_amdgcn_rcpf(x); }
__device__ __forceinline__ float fsilu(float x) { return x * __builtin_amdgcn_rcpf(1.0f + __builtin_amdgcn_exp2f(-1.44269504089f * x)); }
__device__ __forceinline__ float bf2f(unsigned b) { return __builtin_bit_cast(float, b << 16); }
__device__ __forceinline__ float wave_sum(float v) {
#pragma unroll
    for (int o = 1; o < 64; o <<= 1) v += __shfl_xor(v, o);
    return v;
}
__device__ __forceinline__ int wave_isum(int v) {
    v += __builtin_amdgcn_update_dpp(0, v, 0xB1, 0xf, 0xf, false);
    v += __builtin_amdgcn_update_dpp(0, v, 0x4E, 0xf, 0xf, false);
    v += __builtin_amdgcn_update_dpp(0, v, 0x141, 0xf, 0xf, false);
    v += __builtin_amdgcn_update_dpp(0, v, 0x140, 0xf, 0xf, false);
    v += __builtin_amdgcn_update_dpp(0, v, 0x142, 0xa, 0xf, false);
    v += __builtin_amdgcn_update_dpp(0, v, 0x143, 0xc, 0xf, false);
    return __builtin_amdgcn_readlane(v, 63);
}
#define DPPF(v, ctl, rmask) __builtin_bit_cast(float, __builtin_amdgcn_update_dpp(__builtin_bit_cast(int, v), __builtin_bit_cast(int, v), ctl, rmask, 0xf, false))
__device__ __forceinline__ float wave_fmax(float v) {
    v = fmaxf(v, DPPF(v, 0xB1, 0xf)); v = fmaxf(v, DPPF(v, 0x4E, 0xf)); v = fmaxf(v, DPPF(v, 0x141, 0xf)); v = fmaxf(v, DPPF(v, 0x140, 0xf));
    v = fmaxf(v, DPPF(v, 0x142, 0xa)); v = fmaxf(v, DPPF(v, 0x143, 0xc));
    return __builtin_bit_cast(float, __builtin_amdgcn_readlane(__builtin_bit_cast(int, v), 63));
}
__device__ __forceinline__ f32x4 mfma16(bf16x8 a, bf16x8 b, f32x4 c) { return __builtin_amdgcn_mfma_f32_16x16x32_bf16(a, b, c, 0, 0, 0); }
__device__ __forceinline__ f32x16 mfma32(bf16x8 a, bf16x8 b, f32x16 c) { return __builtin_amdgcn_mfma_f32_32x32x16_bf16(a, b, c, 0, 0, 0); }
__device__ __forceinline__ bf16x8 mk8(v2u lo, v2u hi) { v4u t; t.x = lo.x; t.y = lo.y; t.z = hi.x; t.w = hi.y; return __builtin_bit_cast(bf16x8, t); }
__device__ __forceinline__ bf16x8 pack8(float a0, float a1, float a2, float a3, float a4, float a5, float a6, float a7) {
    v4u t; t.x = pk2(a0, a1); t.y = pk2(a2, a3); t.z = pk2(a4, a5); t.w = pk2(a6, a7); return __builtin_bit_cast(bf16x8, t); }

#define XB_TMO      128
#define XB_XCNT(j)  (256  + 64 * (j))
#define XB_XSUB(j)  (1280 + 64 * (j))
#define XB_XGEN(j)  (2304 + 64 * (j))
#define XB_TOP      3328
#define XB_TOPGEN   3392
#define XCD_BAR_WORDS 3456
#define XB_SPIN_CAP (1u << 18)

__device__ __forceinline__ unsigned xb_ld(unsigned* p)              { return __hip_atomic_load(p, __ATOMIC_RELAXED, __HIP_MEMORY_SCOPE_AGENT); }
__device__ __forceinline__ unsigned xb_add(unsigned* p, unsigned v) { return __hip_atomic_fetch_add(p, v, __ATOMIC_RELAXED, __HIP_MEMORY_SCOPE_AGENT); }
__device__ __forceinline__ unsigned xb_xcc_id() { return (unsigned)__builtin_amdgcn_s_getreg((3 << 11) | 20) & 0xFu; }
#define XB_SPIN(cond, bar) do { unsigned _sp = 0; while (cond) { __builtin_amdgcn_s_sleep(1); \
    if ((++_sp & 255u) == 0u) { if (xb_ld(&(bar)[XB_TMO])) break; if (_sp > XB_SPIN_CAP) { atomicAdd(&(bar)[XB_TMO], 1u); break; } } } } while (0)

struct XcdBarrier {
    unsigned* bar; unsigned x;
    volatile LAS unsigned* st;
};

__device__ __forceinline__ XcdBarrier xcd_barrier_post(unsigned* bar, volatile LAS unsigned* st) {
    XcdBarrier b; b.bar = bar; b.x = xb_xcc_id(); b.st = st;
    if (threadIdx.x == 0) (void)xb_add(&bar[XB_XCNT(b.x)], 1u);
    return b;
}
__device__ __forceinline__ void xcd_barrier_complete(unsigned* bar, unsigned x, unsigned& nloc, unsigned& nx) {
    const unsigned G = gridDim.x * gridDim.y * gridDim.z;
    unsigned sum, cnt, mine, sp = 0u;
    for (;;) {
        sum = 0u; cnt = 0u; mine = 0u;
#pragma unroll
        for (unsigned j = 0; j < 16; ++j) { const unsigned c = xb_ld(&bar[XB_XCNT(j)]); sum += c; cnt += (c > 0u) ? 1u : 0u; mine = (j == x) ? c : mine; }
        if (sum == G) break;
        __builtin_amdgcn_s_sleep(1);
        if ((++sp & 255u) == 0u) { if (xb_ld(&bar[XB_TMO])) break; if (sp > XB_SPIN_CAP) { atomicAdd(&bar[XB_TMO], 1u); break; } }
    }
    nloc = mine > 0u ? mine : 1u; nx = cnt > 0u ? cnt : 1u;
}

__device__ __forceinline__ void xcd_barrier(const XcdBarrier& b) {
    asm volatile("s_waitcnt vmcnt(0)" ::: "memory");
    __syncthreads();
    if (threadIdx.x == 0) {
        unsigned* bar = b.bar;
        __builtin_amdgcn_s_waitcnt(0);
        unsigned nloc = b.st[0], nx = b.st[1];
        if (nloc == 0u) { xcd_barrier_complete(bar, b.x, nloc, nx); b.st[0] = nloc; b.st[1] = nx; }
        const unsigned old = xb_add(&bar[XB_XSUB(b.x)], 1u);
        const unsigned gen = old / nloc;
        if (old + 1u == (gen + 1u) * nloc) {
            __builtin_amdgcn_fence(__ATOMIC_RELEASE, "agent");
            asm volatile("s_waitcnt vmcnt(0)" ::: "memory");
            const unsigned og = xb_add(&bar[XB_TOP], 1u);
            const unsigned tg = og / nx;
            if (og + 1u == (tg + 1u) * nx) xb_add(&bar[XB_TOPGEN], 1u);
            else XB_SPIN(xb_ld(&bar[XB_TOPGEN]) == tg, bar);
            __builtin_amdgcn_fence(__ATOMIC_ACQUIRE, "agent");
            xb_add(&bar[XB_XGEN(b.x)], 1u);
            asm volatile("s_waitcnt vmcnt(0)" ::: "memory");
        } else {
            XB_SPIN(xb_ld(&bar[XB_XGEN(b.x)]) == gen, bar);
            __builtin_amdgcn_fence(__ATOMIC_ACQUIRE, "agent");
            asm volatile("s_waitcnt vmcnt(0)" ::: "memory");
        }
    }
    __syncthreads();
}

struct Frame { LAS unsigned char* lds; int tid, lane, wave, vcu, G; };
#define LAUNDER_TID() int tid_l_ = threadIdx.x; asm volatile("" : "+v"(tid_l_)); const int tid = tid_l_, lane = tid & 63; (void)tid; (void)lane

__device__ __forceinline__ void p0_item(const float* W, int K, int N, const float* gain, bf16* WT, int drow0, int k0, int n0, LAS float* scr, int lane) {
    const int n_ = n0 + (lane & 31), nc_ = n_ < N ? n_ : N - 1; const float keep_ = n_ < N ? 1.f : 0.f;
#pragma unroll
    for (int i0 = 0; i0 < 32; i0 += 16) {
        float v[16];
#pragma unroll
        for (int i = 0; i < 16; ++i) v[i] = __builtin_nontemporal_load(W + (size_t)(k0 + 2 * (i0 + i) + (lane >> 5)) * N + nc_);
#pragma unroll
        for (int i = 0; i < 16; ++i) { const int kk = 2 * (i0 + i) + (lane >> 5); float x = v[i] * keep_; if (gain) x *= gain[k0 + kk]; scr[kk * 33 + (lane & 31)] = x; }
    }
    LDS_WAIT(); asm volatile("" ::: "memory");
    const int c = lane & 7;
#pragma unroll
    for (int j = 0; j < 4; ++j) { const int n = (lane >> 3) + 8 * j; const LAS float* s = scr + (8 * c) * 33 + n;
        v4u o; o.x = pk2(s[0 * 33], s[1 * 33]); o.y = pk2(s[2 * 33], s[3 * 33]); o.z = pk2(s[4 * 33], s[5 * 33]); o.w = pk2(s[6 * 33], s[7 * 33]);
        *(v4u*)(WT + (size_t)(drow0 + n) * K + k0 + 8 * c) = o; }
    LDS_WAIT(); asm volatile("" ::: "memory");
}
struct P0Args { const float *x, *mix_g, *ab_w_in, *ab_w_out, *c_w_in, *c_w_out, *ffn_g, *w_gate, *w_up, *w_down; unsigned char* ws; };
__device__ __forceinline__ void p0_weights(const Frame& F, const P0Args& A, int it_lo, int it_hi, int gw, int NGW) {
    LAUNDER_TID();
    LAS float* scr = (LAS float*)(F.lds + F.wave * 16384);
    bf16* const win0 = (bf16*)(A.ws + WS_WIN0); bf16* const win1 = (bf16*)(A.ws + WS_WIN1); bf16* const wout0 = (bf16*)(A.ws + WS_WOUT0); bf16* const wout1 = (bf16*)(A.ws + WS_WOUT1);
    bf16* const wgu0 = (bf16*)(A.ws + WS_WGU0); bf16* const wgu1 = (bf16*)(A.ws + WS_WGU1); bf16* const wdn0 = (bf16*)(A.ws + WS_WDN0); bf16* const wdn1 = (bf16*)(A.ws + WS_WDN1);
    constexpr int I_IN0 = 16 * (ABP / 32), I_IN1 = 16 * (CP / 32), I_OUT = 16 * 32, I_GU = 16 * (DFF / 32), I_DN = (DFF / 64) * 32;
    constexpr int NITEMS = I_IN0 + I_IN1 + 2 * I_OUT + 4 * I_GU + 2 * I_DN;
    for (int it = it_lo + gw; it < (it_hi < NITEMS ? it_hi : NITEMS); it += NGW) {
        int r = it; const float* W = nullptr; const float* gain = nullptr; bf16* WT = nullptr; int K = 0, N = 0, Np = 0, mode = 0; bool found = false;
#define P0_MAT(Wp, Kv, Nv, Npv, gp, WTp, md, cnt) { if (!found) { if (r < (cnt)) { W = (Wp); K = (Kv); N = (Nv); Np = (Npv); gain = (gp); WT = (WTp); mode = (md); found = true; } else r -= (cnt); } }
        P0_MAT(A.ab_w_in, DM, ABN, ABP, A.mix_g, win0, 3, I_IN0)
        P0_MAT(A.c_w_in, DM, CN, CP, A.mix_g + DM, win1, 0, I_IN1)
        P0_MAT(A.ab_w_out, DM, DM, DM, nullptr, wout0, 0, I_OUT)
        P0_MAT(A.c_w_out, DM, DM, DM, nullptr, wout1, 0, I_OUT)
        P0_MAT(A.w_gate, DM, DFF, DFF, A.ffn_g, wgu0, 1, I_GU)
        P0_MAT(A.w_up, DM, DFF, DFF, A.ffn_g, wgu0, 2, I_GU)
        P0_MAT(A.w_gate + (size_t)DM * DFF, DM, DFF, DFF, A.ffn_g + DM, wgu1, 1, I_GU)
        P0_MAT(A.w_up + (size_t)DM * DFF, DM, DFF, DFF, A.ffn_g + DM, wgu1, 2, I_GU)
        P0_MAT(A.w_down, DFF, DM, DM, nullptr, wdn0, 0, I_DN)
        P0_MAT(A.w_down + (size_t)DFF * DM, DFF, DM, DM, nullptr, wdn1, 0, I_DN)
#undef P0_MAT
        const int nblk = Np / 32, kb = r / nblk, nb = r % nblk, n0 = 32 * nb;
        int drow0 = n0; if (mode == 1 || mode == 2) drow0 = 256 * (n0 >> 7) + (n0 & 127) + (mode == 2 ? 128 : 0);
        if (mode == 3 && n0 < 1024) { const int nn = n0 & 511; drow0 = 256 * (nn >> 7) + (nn & 127) + (n0 >= 512 ? 128 : 0); }
        p0_item(W, K, N, gain, WT, drow0, 64 * kb, n0, scr, lane);
    }
}
constexpr int P0_I_IN0 = 16 * (ABP / 32);
__device__ __forceinline__ void p0_prologue(const Frame& F, const P0Args& A) {
    LAUNDER_TID();
    const int gw = F.vcu * NWAVES + F.wave, NGW = F.G * NWAVES;
    p0_weights(F, A, 0, 1 << 30, gw, NGW);
    bf16* HB = (bf16*)(A.ws + WS_HB); float* ssq0 = (float*)(A.ws + WS_SSQ);
    for (int m0 = gw * 4; m0 < M; m0 += NGW * 4) {
        f32x4 v[4][4];
#pragma unroll
        for (int q = 0; q < 4; ++q)
#pragma unroll
            for (int j = 0; j < 4; ++j) v[q][j] = __builtin_nontemporal_load((const f32x4*)(A.x + (size_t)(m0 + q) * DM) + lane + 64 * j);
#pragma unroll
        for (int q = 0; q < 4; ++q) { float s = 0.f;
#pragma unroll
            for (int j = 0; j < 4; ++j) s += (v[q][j].x * v[q][j].x + v[q][j].y * v[q][j].y) + (v[q][j].z * v[q][j].z + v[q][j].w * v[q][j].w);
            s = wave_sum(s); if (lane < 4) *((f32x4*)(ssq0 + (size_t)(m0 + q) * 16) + lane) = (f32x4){lane == 0 ? s : 0.f, 0.f, 0.f, 0.f};
            v2u* o8 = (v2u*)(HB + (size_t)(m0 + q) * DM) + lane;
#pragma unroll
            for (int j = 0; j < 4; ++j) { v2u w; w.x = pk2(v[q][j].x, v[q][j].y); w.y = pk2(v[q][j].z, v[q][j].w); o8[64 * j] = w; } }
    }
    float* rope = (float*)(A.ws + WS_ROPE);
    for (int e = F.vcu * 512 + tid; e < SEQ * 8; e += F.G * 512) { const int t = e >> 3, i = e & 7;
        const float inv = powf(500000.0f, -(float)i * 0.125f); const float ang = (float)t * inv;
        rope[t * 16 + i] = cosf(ang); rope[t * 16 + 8 + i] = sinf(ang); }
}

__device__ __forceinline__ unsigned ordkey(float f) { const unsigned u = __builtin_bit_cast(unsigned, f); return (u & 0x80000000u) ? ~u : (u | 0x80000000u); }
#ifndef DSA_VALU_COUNT
#define DSA_VALU_COUNT 1
#endif
#define DSA_CNT8(ca, cb, cfs, b) do { unsigned long long m0_, m1_, m2_, m3_; \
    asm("v_cmp_le_f32_e64 %2, %6, %7\n\tv_cmp_le_f32_e64 %3, %6, %8\n\tv_cmp_le_f32_e64 %4, %6, %9\n\tv_cmp_le_f32_e64 %5, %6, %10\n\t" \
        "v_addc_co_u32_e64 %0, %2, 0, %0, %2\n\tv_cmp_le_f32_e64 %2, %6, %11\n\tv_addc_co_u32_e64 %1, %3, 0, %1, %3\n\tv_cmp_le_f32_e64 %3, %6, %12\n\t" \
        "v_addc_co_u32_e64 %0, %4, 0, %0, %4\n\tv_cmp_le_f32_e64 %4, %6, %13\n\tv_addc_co_u32_e64 %1, %5, 0, %1, %5\n\tv_cmp_le_f32_e64 %5, %6, %14\n\t" \
        "v_addc_co_u32_e64 %0, %2, 0, %0, %2\n\tv_addc_co_u32_e64 %1, %3, 0, %1, %3\n\tv_addc_co_u32_e64 %0, %4, 0, %0, %4\n\tv_addc_co_u32_e64 %1, %5, 0, %1, %5" \
        : "+v"(ca), "+v"(cb), "=&s"(m0_), "=&s"(m1_), "=&s"(m2_), "=&s"(m3_) : "s"(cfs), "v"(k[8 * (b) + 0]), "v"(k[8 * (b) + 1]), "v"(k[8 * (b) + 2]), "v"(k[8 * (b) + 3]), \
          "v"(k[8 * (b) + 4]), "v"(k[8 * (b) + 5]), "v"(k[8 * (b) + 6]), "v"(k[8 * (b) + 7])); } while (0)
template <int NB> __device__ __forceinline__ int dsa_count(const float (&k)[32], float cf) {
#if DSA_VALU_COUNT
    int ca = 0, cb = 0;
    DSA_CNT8(ca, cb, cf, 0);
    if (NB > 1) DSA_CNT8(ca, cb, cf, 1);
    if (NB > 2) DSA_CNT8(ca, cb, cf, 2);
    if (NB > 3) DSA_CNT8(ca, cb, cf, 3);
    return wave_isum(ca + cb);
#else
    int cnt = 0;
#pragma unroll
    for (int blk = 0; blk < NB; ++blk) { unsigned long long mm_[8];
#pragma unroll
        for (int i = 0; i < 8; ++i) mm_[i] = __ballot(k[8 * blk + i] >= cf);
        __builtin_amdgcn_sched_barrier(0);
#pragma unroll
        for (int i = 0; i < 8; ++i) cnt += __popcll(mm_[i]); }
    return cnt;
#endif
}
#undef DSA_CNT8
template <int NB> __device__ __forceinline__ void dsa_select(const float (&k)[32], int lane, unsigned& mlo, unsigned& mhi) {
    unsigned T = 0u; bool exact = false; int bit = 30;
    int cnt = dsa_count<NB>(k, 0.0f);
    if (cnt >= 256) {
        T = 0x80000000u;
        if (cnt == 256) exact = true;
        else {
            float kmx = k[0];
#pragma unroll
            for (int i = 1; i < 8 * NB; ++i) kmx = fmaxf(kmx, k[i]);
            kmx = wave_fmax(kmx);
            int eb = (int)((__builtin_bit_cast(unsigned, kmx) >> 23) & 0xffu);
            bit = 30;
            for (int step = 0; step < 3 && eb >= 1; ++step, --eb) { const float cf = __builtin_bit_cast(float, (unsigned)eb << 23); cnt = dsa_count<NB>(k, cf);
                if (cnt >= 256) { T = 0x80000000u | ((unsigned)eb << 23); if (cnt == 256) exact = true; bit = 22; break; } }
        }
    }
    for (; bit >= 0 && !exact; --bit) {
        const unsigned cand = T | (1u << bit); const float cf = __builtin_bit_cast(float, (cand & 0x80000000u) ? (cand & 0x7fffffffu) : ~cand);
        cnt = dsa_count<NB>(k, cf);
        if (cnt >= 256) { T = cand; if (cnt == 256) exact = true; }
    }
    const float Tf = __builtin_bit_cast(float, (T & 0x80000000u) ? (T & 0x7fffffffu) : ~T);
    if (exact) {
#pragma unroll
        for (int i = 0; i < 8 * NB; ++i) { const unsigned long long mm = __ballot(k[i] >= Tf); if (lane == i) { mlo = (unsigned)mm; mhi = (unsigned)(mm >> 32); } }
    } else {
        int cgt = 0;
#pragma unroll
        for (int i = 0; i < 8 * NB; ++i) cgt += __popcll(__ballot(k[i] > Tf));
        const int need = 256 - cgt; int base = 0;
#pragma unroll
        for (int i = 0; i < 8 * NB; ++i) {
            const bool eq = (k[i] == Tf); const unsigned long long me = __ballot(eq);
            const int rank = base + (int)__builtin_amdgcn_mbcnt_hi((unsigned)(me >> 32), __builtin_amdgcn_mbcnt_lo((unsigned)me, 0u));
            const bool sel = (k[i] > Tf) || (eq && rank < need);
            const unsigned long long mm = __ballot(sel);
            if (lane == i) { mlo = (unsigned)mm; mhi = (unsigned)(mm >> 32); }
            base += __popcll(me);
        }
    }
}
constexpr int KSTR = 72, VSTR = 72;
__device__ __forceinline__ void dsa_unit(const Frame& F, const bf16* U, bf16* YC, int b, int j) {
    LAUNDER_TID(); const int wave = F.wave;
    const size_t rb = (size_t)b * SEQ;
    LAS float* SC = (LAS float*)F.lds;
    LAS unsigned* BM = (LAS unsigned*)(F.lds + LDS_BM);
#pragma unroll 1
    for (int rep12_ = 0; rep12_ < REP_DSA12; ++rep12_)
    {
        const f32x4 ninf = {-__builtin_inff(), -__builtin_inff(), -__builtin_inff(), -__builtin_inff()};
        for (int e = tid; e < 16 * SC_STRIDE / 4; e += 512) ((LAS f32x4*)SC)[e] = ninf;
        LDS_BARRIER();
    }
    {
    bf16x8 nbq[8][2]; v4u niw;
    { const bf16* qrow = U + (rb + 64 * j + (lane & 15)) * ABP;
#pragma unroll
      for (int h = 0; h < 8; ++h)
#pragma unroll
        for (int ks = 0; ks < 2; ++ks) nbq[h][ks] = *(const bf16x8*)(qrow + AB_IQ + h * 64 + ks * 32 + (lane >> 4) * 8);
      niw = *(const v4u*)(qrow + AB_IW); }
#pragma unroll 1
    for (int s = 0; s < 4; ++s) {
        const int t0 = 64 * j + 16 * s, nkt = (t0 >> 4) + 1;
        {
            const int c = lane & 15, g = lane >> 4;
            bf16x8 bq[8][2];
#pragma unroll
            for (int h = 0; h < 8; ++h)
#pragma unroll
                for (int ks = 0; ks < 2; ++ks) bq[h][ks] = nbq[h][ks];
            float iwv[8];
            { const v4u raw = niw; const float ws = 0.04419417382f;
              iwv[0] = bf2f(raw.x & 0xffffu) * ws; iwv[1] = bf2f(raw.x >> 16) * ws; iwv[2] = bf2f(raw.y & 0xffffu) * ws; iwv[3] = bf2f(raw.y >> 16) * ws;
              iwv[4] = bf2f(raw.z & 0xffffu) * ws; iwv[5] = bf2f(raw.z >> 16) * ws; iwv[6] = bf2f(raw.w & 0xffffu) * ws; iwv[7] = bf2f(raw.w >> 16) * ws; }
            bf16x8 nak[4][2];
#pragma unroll
            for (int u = 0; u < 4; ++u) { const int kt = wave + 8 * u;
                if (kt < nkt) { const bf16* krow = U + (rb + 16 * kt + c) * ABP + AB_IK + g * 8; nak[u][0] = *(const bf16x8*)krow; nak[u][1] = *(const bf16x8*)(krow + 32); } }
            for (int kt0 = wave; kt0 < nkt; kt0 += 32) {
                bf16x8 ak[4][2];
#pragma unroll
                for (int u = 0; u < 4; ++u) { ak[u][0] = nak[u][0]; ak[u][1] = nak[u][1]; }
#pragma unroll
                for (int u = 0; u < 4; ++u) { const int kt = kt0 + 32 + 8 * u;
                    if (kt < nkt) { const bf16* krow = U + (rb + 16 * kt + c) * ABP + AB_IK + g * 8; nak[u][0] = *(const bf16x8*)krow; nak[u][1] = *(const bf16x8*)(krow + 32); } }
#pragma unroll
                for (int u = 0; u < 4; ++u) { const int kt = kt0 + 8 * u;
                    if (kt < nkt) {
                        f32x4 sc = {0.f, 0.f, 0.f, 0.f};
#pragma unroll
                        for (int h = 0; h < 8; ++h) { f32x4 acc = {0.f, 0.f, 0.f, 0.f}; acc = mfma16(ak[u][0], bq[h][0], acc); acc = mfma16(ak[u][1], bq[h][1], acc);
#pragma unroll
                            for (int i = 0; i < 4; ++i) sc[i] += fmaxf(acc[i], 0.f) * iwv[h]; }
#pragma unroll
                        for (int i = 0; i < 4; ++i) sc[i] = (16 * kt + 4 * g + i <= t0 + c) ? sc[i] : -__builtin_inff();
                        *(LAS f32x4*)(SC + c * SC_STRIDE + 16 * kt + 4 * g) = sc;
                    } }
            }
            if (s < 3) { const bf16* qrow = U + (rb + t0 + 16 + c) * ABP;
#pragma unroll
                for (int h = 0; h < 8; ++h)
#pragma unroll
                    for (int ks = 0; ks < 2; ++ks) nbq[h][ks] = *(const bf16x8*)(qrow + AB_IQ + h * 64 + ks * 32 + g * 8);
                niw = *(const v4u*)(qrow + AB_IW); }
        }
        LDS_BARRIER();
#pragma unroll 1
        for (int rep2_ = 0; rep2_ < REP_DSA2; ++rep2_)
        for (int qq = 0; qq < 2; ++qq) {
            const int q = 2 * wave + qq, t = t0 + q;
            float k[32];
#pragma unroll
            for (int i = 0; i < 32; ++i) k[i] = *(volatile LAS float*)(SC + q * SC_STRIDE + 64 * i + lane);
            unsigned mlo = 0u, mhi = 0u;
            if (t < 256) {
#pragma unroll
                for (int i = 0; i < 4; ++i) { const unsigned long long mm = __ballot((64 * i + lane) <= t); if (lane == i) { mlo = (unsigned)mm; mhi = (unsigned)(mm >> 32); } }
            } else if (t < 512) dsa_select<1>(k, lane, mlo, mhi);
            else if (t < 1024) dsa_select<2>(k, lane, mlo, mhi);
            else if (t < 1536) dsa_select<3>(k, lane, mlo, mhi);
            else dsa_select<4>(k, lane, mlo, mhi);
            if (lane < 32) { BM[(16 * s + q) * 64 + 2 * lane] = mlo; BM[(16 * s + q) * 64 + 2 * lane + 1] = mhi; }
        }
        LDS_BARRIER();
    }
    }
    __syncthreads();
    LAS bf16* Ks = (LAS bf16*)F.lds;
    LAS bf16* Vt = (LAS bf16*)(F.lds + 2 * 64 * KSTR * 2);
    const int c = lane & 31, hi = lane >> 5;
#pragma unroll 1
    for (int rep3_ = 0; rep3_ < REP_DSA3; ++rep3_) {
    LAS bf16x8* QF = (LAS bf16x8*)(F.lds + 4 * 64 * KSTR * 2) + wave * 512;
#pragma unroll
    for (int nt = 0; nt < 2; ++nt)
#pragma unroll
        for (int ks = 0; ks < 4; ++ks) QF[(nt * 4 + ks) * 64 + lane] = *(const bf16x8*)(U + (rb + 64 * j + 32 * nt + c) * ABP + AB_Q + wave * 64 + 16 * ks + 8 * hi);
    f32x16 O[2][2];
#pragma unroll
    for (int dt = 0; dt < 2; ++dt)
#pragma unroll
        for (int nt = 0; nt < 2; ++nt)
#pragma unroll
            for (int i = 0; i < 16; ++i) O[dt][nt][i] = 0.f;
    float mrow[2] = {-1e30f, -1e30f}, lrow[2] = {0.f, 0.f};
    const float sc2 = 0.125f * 1.44269504089f;
    const int krow_s = tid >> 3, kch_s = tid & 7, vkey_s = tid & 63, vch_s = tid >> 6;
    v4u kreg = *(const v4u*)(U + (rb + krow_s) * ABP + AB_K + 8 * kch_s);
    v4u vreg = *(const v4u*)(U + (rb + vkey_s) * ABP + AB_V + 8 * vch_s);
    {
        *(LAS v4u*)(Ks + krow_s * KSTR + 8 * kch_s) = kreg;
        const unsigned ve[4] = {vreg.x, vreg.y, vreg.z, vreg.w};
#pragma unroll
        for (int e = 0; e < 4; ++e) { Vt[(8 * vch_s + 2 * e) * VSTR + vkey_s] = (bf16)(ve[e] & 0xffffu); Vt[(8 * vch_s + 2 * e + 1) * VSTR + vkey_s] = (bf16)(ve[e] >> 16); }
    }
    __syncthreads();
    for (int kt = 0; kt <= j; ++kt) {
        const int buf = kt & 1;
        if (kt < j) {
            kreg = *(const v4u*)(U + (rb + 64 * (kt + 1) + krow_s) * ABP + AB_K + 8 * kch_s);
            vreg = *(const v4u*)(U + (rb + 64 * (kt + 1) + vkey_s) * ABP + AB_V + 8 * vch_s);
        }
        const LAS bf16* Kb = Ks + buf * 64 * KSTR; const LAS bf16* Vb = Vt + buf * 64 * VSTR;
        bf16x8 va[2][4]; unsigned wm[2][2];
#pragma unroll
        for (int dt = 0; dt < 2; ++dt)
#pragma unroll
            for (int kk = 0; kk < 4; ++kk) { const LAS bf16* vp = Vb + (32 * dt + c) * VSTR + 16 * kk + 4 * hi; va[dt][kk] = mk8(*(const LAS v2u*)vp, *(const LAS v2u*)(vp + 8)); }
#pragma unroll
        for (int nt = 0; nt < 2; ++nt)
#pragma unroll
            for (int mt = 0; mt < 2; ++mt) wm[nt][mt] = BM[(32 * nt + c) * 64 + 2 * kt + mt] >> (4 * hi);
#pragma unroll
        for (int nt = 0; nt < 2; ++nt) {
            f32x16 S[2];
            {
                bf16x8 ka[2][4], bq[4];
#pragma unroll
                for (int ks = 0; ks < 4; ++ks) bq[ks] = QF[(nt * 4 + ks) * 64 + lane];
#pragma unroll
                for (int mt = 0; mt < 2; ++mt)
#pragma unroll
                    for (int ks = 0; ks < 4; ++ks) ka[mt][ks] = *(const LAS bf16x8*)(Kb + (32 * mt + c) * KSTR + 16 * ks + 8 * hi);
#pragma unroll
                for (int mt = 0; mt < 2; ++mt) {
#pragma unroll
                    for (int i = 0; i < 16; ++i) S[mt][i] = 0.f;
#pragma unroll
                    for (int ks = 0; ks < 4; ++ks) S[mt] = mfma32(ka[mt][ks], bq[ks], S[mt]);
                }
            }
            float mx = -1e30f;
#pragma unroll
            for (int mt = 0; mt < 2; ++mt)
#pragma unroll
                for (int i = 0; i < 16; ++i) mx = fmaxf(mx, S[mt][i]);
            mx = fmaxf(mx, __shfl_xor(mx, 32)) * sc2;
            if (!__all(mx <= mrow[nt] + 8.0f)) {
                const float mn = fmaxf(mrow[nt], mx), alpha = fexp2(mrow[nt] - mn);
                mrow[nt] = mn; lrow[nt] *= alpha;
#pragma unroll
                for (int dt = 0; dt < 2; ++dt)
#pragma unroll
                    for (int i = 0; i < 16; ++i) O[dt][nt][i] *= alpha;
            }
            const float mnew = mrow[nt];
#pragma unroll
            for (int mt = 0; mt < 2; ++mt) {
                const unsigned w = wm[nt][mt];
                float p[16];
#pragma unroll
                for (int i = 0; i < 16; ++i) { const int kl = (i & 3) + 8 * (i >> 2);
                    const float e = fexp2(S[mt][i] * sc2 - mnew); unsigned mk_; asm("v_bfe_i32 %0, %1, %2, 1" : "=v"(mk_) : "v"(w), "n"(kl));
                    p[i] = __builtin_bit_cast(float, __builtin_bit_cast(unsigned, e) & mk_); lrow[nt] += p[i]; }
#pragma unroll
                for (int half = 0; half < 2; ++half) {
                    const bf16x8 pb = pack8(p[8 * half + 0], p[8 * half + 1], p[8 * half + 2], p[8 * half + 3], p[8 * half + 4], p[8 * half + 5], p[8 * half + 6], p[8 * half + 7]);
#pragma unroll
                    for (int dt = 0; dt < 2; ++dt) O[dt][nt] = mfma32(va[dt][2 * mt + half], pb, O[dt][nt]);
                }
            }
            __builtin_amdgcn_sched_barrier(0);
        }
        if (kt < j) {
            const int nb = buf ^ 1;
            *(LAS v4u*)(Ks + nb * 64 * KSTR + krow_s * KSTR + 8 * kch_s) = kreg;
            const unsigned ve[4] = {vreg.x, vreg.y, vreg.z, vreg.w};
#pragma unroll
            for (int e = 0; e < 4; ++e) { Vt[nb * 64 * VSTR + (8 * vch_s + 2 * e) * VSTR + vkey_s] = (bf16)(ve[e] & 0xffffu); Vt[nb * 64 * VSTR + (8 * vch_s + 2 * e + 1) * VSTR + vkey_s] = (bf16)(ve[e] >> 16); }
        }
        __syncthreads();
    }
#pragma unroll
    for (int nt = 0; nt < 2; ++nt) {
        const float l = lrow[nt] + __shfl_xor(lrow[nt], 32); const float inv = 1.0f / l;
        bf16* orow = YC + (rb + 64 * j + 32 * nt + c) * DM + 512 + wave * 64;
#pragma unroll
        for (int dt = 0; dt < 2; ++dt)
#pragma unroll
            for (int g4 = 0; g4 < 4; ++g4) {
                v2u w; w.x = pk2(O[dt][nt][4 * g4 + 0] * inv, O[dt][nt][4 * g4 + 1] * inv); w.y = pk2(O[dt][nt][4 * g4 + 2] * inv, O[dt][nt][4 * g4 + 3] * inv);
                *(v2u*)(orow + 32 * dt + 8 * g4 + 4 * hi) = w;
            }
    }
    __syncthreads();
    }
}

__device__ __forceinline__ void conv_unit(const Frame& F, const bf16* U, bf16* YC, const float* conv_w, const float* conv_b, const float* ln_g, const float* ln_b, int tile) {
    LAUNDER_TID();
    const int b = tile >> 5, t0 = (tile & 31) * 64, c = tid;
    const size_t rb = (size_t)b * SEQ;
    LAS bf16* Hs = (LAS bf16*)F.lds;
    LAS float* O2 = (LAS float*)(F.lds + 94 * 512 * 2);
    LAS float* ST = (LAS float*)(F.lds + 94 * 512 * 2 + 8 * 512 * 4);
    {
        v4u tmp[12];
#pragma unroll
        for (int k = 0; k < 12; ++k) { const int e = tid + 512 * k, r = e >> 6, ch = e & 63; int t = t0 - 30 + r; t = t < 0 ? 0 : t; t = t > SEQ - 1 ? SEQ - 1 : t;
            tmp[k] = *(const v4u*)(U + (rb + t) * ABP + 8 * ch); }
#pragma unroll
        for (int k = 0; k < 12; ++k) { const int e = tid + 512 * k, r = e >> 6, ch = e & 63; const bool z = (t0 - 30 + r) < 0; v4u x = tmp[k]; if (z) { x.x = 0u; x.y = 0u; x.z = 0u; x.w = 0u; }
            if (r < 94) *(LAS v4u*)(Hs + r * 512 + 8 * ch) = x; }
    }
    float w[31];
#pragma unroll
    for (int jj = 0; jj < 31; ++jj) w[jj] = conv_w[jj * 512 + c];
    const float bias = conv_b[c], lg = ln_g[c], lb = ln_b[c];
    LDS_BARRIER();
    for (int grp = 0; grp < 8; ++grp) {
        float in[38];
#pragma unroll
        for (int r = 0; r < 38; ++r) in[r] = bf2f(Hs[(8 * grp + r) * 512 + c]);
        float o[8];
#pragma unroll
        for (int tl = 0; tl < 8; ++tl) { float acc = bias;
#pragma unroll
            for (int jj = 0; jj < 31; ++jj) acc += w[jj] * in[tl + jj];
            o[tl] = acc; O2[tl * 512 + c] = acc; }
        LDS_BARRIER();
        { float s = 0.f, s2 = 0.f;
#pragma unroll
          for (int e = 0; e < 8; ++e) { const float v = O2[F.wave * 512 + lane + 64 * e]; s += v; s2 += v * v; }
          s = wave_sum(s); s2 = wave_sum(s2);
          if (lane == 0) { const float mu = s * (1.0f / 512.0f), var = fmaxf(s2 * (1.0f / 512.0f) - mu * mu, 0.f); ST[2 * F.wave] = mu; ST[2 * F.wave + 1] = rsqrtf(var + EPS); } }
        LDS_BARRIER();
        f32x4 stv[4];
#pragma unroll
        for (int k4 = 0; k4 < 4; ++k4) stv[k4] = *(const LAS f32x4*)(ST + 4 * k4);
#pragma unroll
        for (int tl = 0; tl < 8; ++tl) { const float mu = (tl & 1) ? stv[tl >> 1].z : stv[tl >> 1].x, rs = (tl & 1) ? stv[tl >> 1].w : stv[tl >> 1].y; const float y = (o[tl] - mu) * rs * lg + lb; const float ya = fsilu(y);
            YC[(rb + t0 + 8 * grp + tl) * DM + c] = (bf16)f2bf(ya); }
    }
    LDS_BARRIER();
}

constexpr int XSTR = 520;
__device__ __forceinline__ void gla_prep_unit(const Frame& F, const bf16* U1, bf16* QT, bf16* KT, bf16* KTT, float* DEC, const float* g2_w, const float* g2_b, int unit) {
    LAUNDER_TID();
    const size_t r0 = (size_t)unit * 64; const int col = tid;
    LAS bf16* XQ = (LAS bf16*)F.lds;
    LAS bf16* XK = XQ + 64 * XSTR;
    LAS float* GL = (LAS float*)(F.lds + 2 * 64 * XSTR * 2);
    {
        v4u tmp[16];
#pragma unroll
        for (int k = 0; k < 16; ++k) { const int e = tid + 512 * k; tmp[k] = *(const v4u*)(U1 + (r0 + (e >> 7)) * CP + 8 * (e & 127)); }
#pragma unroll
        for (int k = 0; k < 16; ++k) { const int e = tid + 512 * k, row = e >> 7, ch = e & 127;
            LAS bf16* dst = (ch < 64) ? (XQ + row * XSTR + 8 * ch) : (XK + row * XSTR + 8 * (ch - 64)); *(LAS v4u*)dst = tmp[k]; }
    }
    for (int e = tid; e < 1024; e += 512) GL[e] = bf2f(U1[(r0 + (e >> 4)) * CP + C_GL + (e & 15)]);
    float w[16];
#pragma unroll
    for (int r = 0; r < 16; ++r) w[r] = g2_w[r * 512 + col];
    const float bias = g2_b[col];
    LDS_BARRIER();
    float bc = 0.f;
#pragma unroll 4
    for (int t = 0; t < 64; ++t) {
        float x = bias;
#pragma unroll
        for (int r4 = 0; r4 < 4; ++r4) { const f32x4 gvv = *(const LAS f32x4*)(GL + t * 16 + 4 * r4); x += gvv.x * w[4 * r4] + gvv.y * w[4 * r4 + 1] + gvv.z * w[4 * r4 + 2] + gvv.w * w[4 * r4 + 3]; }
        const float ls = fminf(x, 0.f) - 0.69314718056f * __builtin_amdgcn_logf(1.0f + fexp(-fabsf(x)));
        bc += ls * (1.0f / 16.0f);
        const float qv = bf2f(XQ[t * XSTR + col]), kv = bf2f(XK[t * XSTR + col]);
        XQ[t * XSTR + col] = (bf16)f2bf(qv * fexp(bc) * 0.08838834764f);
        XK[t * XSTR + col] = (bf16)f2bf(kv * fexp(-bc));
    }
    DEC[(size_t)unit * 512 + col] = fexp(bc);
    LDS_BARRIER();
#pragma unroll
    for (int k = 0; k < 8; ++k) { const int e = tid + 512 * k, row = e >> 6, ch = e & 63;
        *(v4u*)(QT + (r0 + row) * 512 + 8 * ch) = *(const LAS v4u*)(XQ + row * XSTR + 8 * ch);
        *(v4u*)(KT + (r0 + row) * 512 + 8 * ch) = *(const LAS v4u*)(XK + row * XSTR + 8 * ch); }
    {
        unsigned kp[32];
#pragma unroll
        for (int t2 = 0; t2 < 32; ++t2) kp[t2] = (unsigned)XK[(2 * t2) * XSTR + col] | ((unsigned)XK[(2 * t2 + 1) * XSTR + col] << 16);
        v4u* dst = (v4u*)(KTT + ((size_t)unit * 512 + col) * 64);
#pragma unroll
        for (int k = 0; k < 8; ++k) { v4u o; o.x = kp[4 * k]; o.y = kp[4 * k + 1]; o.z = kp[4 * k + 2]; o.w = kp[4 * k + 3]; dst[k] = o; }
    }
    LDS_BARRIER();
}
constexpr int QSTR = 136, TSTR = 72;
constexpr int VNSTR = 96;
constexpr int G2_QS = 0, G2_KS = 64 * QSTR * 2, G2_KT = 2 * 64 * QSTR * 2, G2_VT = G2_KT + 128 * TSTR * 2, G2_DS = G2_VT + 64 * VNSTR * 2, G2_BUF = G2_DS + 512;
constexpr int G2_AS = G2_BUF, G2_PO = G2_AS + 64 * TSTR * 2;
static_assert(G2_PO + 65536 <= LDS_CTL, "GLA scan LDS map");
__device__ __forceinline__ void g2_step_body(const Frame& F, LAS unsigned char* bp, LAS bf16* As, LAS float* PO, f32x16& S, const bf16* QT, bf16* OB, float* GSSQ, int b, int h, int vq, int ch, int tid, int lane) {
    const int wave = F.wave, c = lane & 31, hi = lane >> 5, vt = wave & 1, dt = wave >> 1; (void)tid; (void)QT;
        const size_t r0 = (size_t)b * SEQ + 64 * ch;
        const LAS bf16* Qs = (const LAS bf16*)(bp + G2_QS); const LAS bf16* Ks = (const LAS bf16*)(bp + G2_KS); const LAS bf16* KTs = (const LAS bf16*)(bp + G2_KT);
        const LAS float* Ds = (const LAS float*)(bp + G2_DS);
        for (int n = wave; n < 10; n += 8) {
            const int it = (n >= 6) ? 3 : (n >= 3) ? 2 : (n >= 1) ? 1 : 0, jt = n - (it * (it + 1)) / 2; const int r16 = lane & 15, g = lane >> 4;
            f32x4 acc = {0.f, 0.f, 0.f, 0.f};
#pragma unroll
            for (int ks = 0; ks < 4; ++ks) acc = mfma16(*(const LAS bf16x8*)(Ks + (16 * jt + r16) * QSTR + 32 * ks + 8 * g), *(const LAS bf16x8*)(Qs + (16 * it + r16) * QSTR + 32 * ks + 8 * g), acc);
            const int i = 16 * it + r16, j0 = 16 * jt + 4 * g;
            v2u w; w.x = pk2(j0 <= i ? acc[0] : 0.f, j0 + 1 <= i ? acc[1] : 0.f); w.y = pk2(j0 + 2 <= i ? acc[2] : 0.f, j0 + 3 <= i ? acc[3] : 0.f);
            *(LAS v2u*)(As + i * TSTR + j0) = w;
        }
        LDS_BARRIER();
        f32x16 OT[2];
#pragma unroll
        for (int it = 0; it < 2; ++it)
#pragma unroll
            for (int i = 0; i < 16; ++i) OT[it][i] = 0.f;
#pragma unroll
        for (int half = 0; half < 2; ++half) {
            const bf16x8 sa = pack8(S[8 * half + 0], S[8 * half + 1], S[8 * half + 2], S[8 * half + 3], S[8 * half + 4], S[8 * half + 5], S[8 * half + 6], S[8 * half + 7]);
#pragma unroll
            for (int it = 0; it < 2; ++it) { const LAS bf16* qp = Qs + (32 * it + c) * QSTR + 32 * dt + 16 * half + 4 * hi;
                OT[it] = mfma32(sa, mk8(*(const LAS v2u*)qp, *(const LAS v2u*)(qp + 8)), OT[it]); }
        }
        bf16x8 vf[4];
        {
            const unsigned va_ = (unsigned)(__UINTPTR_TYPE__)(bp + G2_VT) + (unsigned)((8 * hi + ((lane & 15) >> 2)) * (VNSTR * 2) + (32 * vt + 16 * ((lane >> 4) & 1) + 4 * (lane & 3)) * 2);
            v2u t0_, t1_, t2_, t3_, t4_, t5_, t6_, t7_;
            asm volatile("ds_read_b64_tr_b16 %0, %8\n\tds_read_b64_tr_b16 %1, %8 offset:768\n\tds_read_b64_tr_b16 %2, %8 offset:3072\n\tds_read_b64_tr_b16 %3, %8 offset:3840\n\t"
                         "ds_read_b64_tr_b16 %4, %8 offset:6144\n\tds_read_b64_tr_b16 %5, %8 offset:6912\n\tds_read_b64_tr_b16 %6, %8 offset:9216\n\tds_read_b64_tr_b16 %7, %8 offset:9984\n\t"
                         "s_waitcnt lgkmcnt(0)"
                         : "=&v"(t0_), "=&v"(t1_), "=&v"(t2_), "=&v"(t3_), "=&v"(t4_), "=&v"(t5_), "=&v"(t6_), "=&v"(t7_) : "v"(va_) : "memory");
            vf[0] = mk8(t0_, t1_); vf[1] = mk8(t2_, t3_); vf[2] = mk8(t4_, t5_); vf[3] = mk8(t6_, t7_);
        }
        {
            const bf16x8 va = (dt == 0) ? vf[0] : (dt == 1) ? vf[1] : (dt == 2) ? vf[2] : vf[3];
#pragma unroll
            for (int it = 0; it < 2; ++it) OT[it] = mfma32(va, *(const LAS bf16x8*)(As + (32 * it + c) * TSTR + 16 * dt + 8 * hi), OT[it]);
        }
#pragma unroll
        for (int it = 0; it < 2; ++it)
#pragma unroll
            for (int i = 0; i < 16; ++i) PO[(((dt * 2 + vt) * 2 + it) * 16 + i) * 64 + lane] = OT[it][i];
        LDS_BARRIER();
        {
            const int vt2 = wave & 1, it2 = (wave >> 1) & 1, q = wave >> 2;
            float o8[8];
#pragma unroll
            for (int jx = 0; jx < 8; ++jx) { float a = 0.f;
#pragma unroll
                for (int d4 = 0; d4 < 4; ++d4) a += PO[(((d4 * 2 + vt2) * 2 + it2) * 16 + 8 * q + jx) * 64 + lane];
                o8[jx] = a; }
            float ss = 0.f;
#pragma unroll
            for (int jx = 0; jx < 8; ++jx) ss += o8[jx] * o8[jx];
            ss += __shfl_xor(ss, 32);
            const size_t tok = r0 + 32 * it2 + c;
            bf16* orow = OB + tok * DM + h * 256 + 64 * vq + 32 * vt2 + 16 * q + 4 * hi;
            v2u w0, w1; w0.x = pk2(o8[0], o8[1]); w0.y = pk2(o8[2], o8[3]); w1.x = pk2(o8[4], o8[5]); w1.y = pk2(o8[6], o8[7]);
            *(v2u*)orow = w0; *(v2u*)(orow + 8) = w1;
            if (hi == 0) GSSQ[(tok * 4 + h) * 16 + vq * 4 + vt2 * 2 + q] = ss;
        }
#pragma unroll
        for (int kk = 0; kk < 4; ++kk) S = mfma32(*(const LAS bf16x8*)(KTs + (32 * dt + c) * TSTR + 16 * kk + 8 * hi), vf[kk], S);
#pragma unroll
        for (int g4 = 0; g4 < 4; ++g4) { const f32x4 dv = *(const LAS f32x4*)(Ds + 32 * dt + 8 * g4 + 4 * hi);
            S[4 * g4 + 0] *= dv.x; S[4 * g4 + 1] *= dv.y; S[4 * g4 + 2] *= dv.z; S[4 * g4 + 3] *= dv.w; }
}
__device__ __forceinline__ void gla_scan_unit(const Frame& F, const bf16* U1, const bf16* QT, const bf16* KT, const bf16* KTT, const float* DEC, bf16* OB, float* GSSQ, int b, int h, int vq) {
    LAUNDER_TID(); const int wave = F.wave, c = lane & 31, hi = lane >> 5, vt = wave & 1, dt = wave >> 1;
    LAS bf16* As = (LAS bf16*)(F.lds + G2_AS);
    LAS float* PO = (LAS float*)(F.lds + G2_PO);
    f32x16 S;
#pragma unroll
    for (int i = 0; i < 16; ++i) S[i] = 0.f;
    for (int e = tid; e < 64 * TSTR / 2; e += 512) ((LAS unsigned*)As)[e] = 0u;
    v4u pq0[2], pk0[2], pt0[2], pv0, pq1[2], pk1[2], pt1[2], pv1, pq2[2], pk2[2], pt2[2], pv2; f32x4 pd0 = {0.f, 0.f, 0.f, 0.f}, pd1 = pd0, pd2 = pd0;
    LAS unsigned char* const bp = F.lds;
#define G2_LOAD(cidx, X) do { const size_t r0_ = (size_t)b * SEQ + 64 * (cidx); const size_t u_ = (size_t)b * 32 + (cidx); \
        _Pragma("unroll") for (int k = 0; k < 2; ++k) { const int e = tid + 512 * k; \
            pq##X[k] = *(const v4u*)(QT + (r0_ + (e >> 4)) * 512 + h * 128 + 8 * (e & 15)); \
            pk##X[k] = *(const v4u*)(KT + (r0_ + (e >> 4)) * 512 + h * 128 + 8 * (e & 15)); \
            pt##X[k] = *(const v4u*)(KTT + (u_ * 512 + h * 128 + (e >> 3)) * 64 + 8 * (e & 7)); } \
        pv##X = *(const v4u*)(U1 + (r0_ + (tid >> 3)) * CP + C_V + h * 256 + 64 * vq + 8 * (tid & 7)); \
        if (tid < 32) pd##X = *(const f32x4*)(DEC + u_ * 512 + h * 128 + 4 * tid); } while (0)
#define G2_STORE(X) do { \
        _Pragma("unroll") for (int k = 0; k < 2; ++k) { const int e = tid + 512 * k; \
            *(LAS v4u*)((LAS bf16*)(bp + G2_QS) + (e >> 4) * QSTR + 8 * (e & 15)) = pq##X[k]; \
            *(LAS v4u*)((LAS bf16*)(bp + G2_KS) + (e >> 4) * QSTR + 8 * (e & 15)) = pk##X[k]; \
            *(LAS v4u*)((LAS bf16*)(bp + G2_KT) + (e >> 3) * TSTR + 8 * (e & 7)) = pt##X[k]; } \
        *(LAS v4u*)((LAS bf16*)(bp + G2_VT) + (tid >> 3) * VNSTR + 8 * (tid & 7)) = pv##X; \
        if (tid < 32) *(LAS f32x4*)((LAS float*)(bp + G2_DS) + 4 * tid) = pd##X; } while (0)
    G2_LOAD(0, 0); G2_LOAD(1, 1); G2_LOAD(2, 2);
    G2_STORE(0);
    __syncthreads();
#define G2_STEP(CH, LX, SX) do { const int ch = (CH); if (ch < 32) { \
        if (ch + 3 < 32) G2_LOAD(ch + 3, LX); \
        g2_step_body(F, bp, As, PO, S, QT, OB, GSSQ, b, h, vq, ch, tid, lane); \
        LDS_BARRIER(); \
        if (ch + 1 < 32) G2_STORE(SX); \
        LDS_BARRIER(); } } while (0)
#pragma unroll 1
    for (int ch0 = 0; ch0 < 33; ch0 += 3) { G2_STEP(ch0, 0, 1); G2_STEP(ch0 + 1, 1, 2); G2_STEP(ch0 + 2, 2, 0); }
#undef G2_STEP
#undef G2_LOAD
#undef G2_STORE
    __syncthreads();
}
__device__ __forceinline__ void gla_norm_gate(const Frame& F, const bf16* U1, bf16* YO, const bf16* OB, const float* GSSQ, const float* onorm_g) {
    LAUNDER_TID();
    const int gw = F.vcu * NWAVES + F.wave, NGW = F.G * NWAVES;
    f32x4 gv[2][2];
#pragma unroll
    for (int jx = 0; jx < 2; ++jx) { gv[jx][0] = *((const f32x4*)onorm_g + 2 * (lane + 64 * jx)); gv[jx][1] = *((const f32x4*)onorm_g + 2 * (lane + 64 * jx) + 1); }
    for (int m0 = gw * 4; m0 < M; m0 += NGW * 4) {
        v4u ov[4][2], rv[4][2]; float rs[4][2];
#pragma unroll
        for (int q = 0; q < 4; ++q)
#pragma unroll
            for (int jx = 0; jx < 2; ++jx) {
                ov[q][jx] = *((const v4u*)(OB + (size_t)(m0 + q) * DM) + lane + 64 * jx);
                rv[q][jx] = *((const v4u*)(U1 + (size_t)(m0 + q) * CP + C_R) + lane + 64 * jx);
                rs[q][jx] = 0.f;
            }
#pragma unroll
        for (int q = 0; q < 4; ++q) {
            float ps = GSSQ[(size_t)(m0 + q) * 64 + lane];
            ps += __shfl_xor(ps, 1); ps += __shfl_xor(ps, 2); ps += __shfl_xor(ps, 4); ps += __shfl_xor(ps, 8);
#pragma unroll
            for (int jx = 0; jx < 2; ++jx) rs[q][jx] = rsqrtf(__shfl(ps, 16 * ((lane + 64 * jx) >> 5)) * (1.0f / 256.0f) + EPS);
        }
#pragma unroll
        for (int q = 0; q < 4; ++q)
#pragma unroll
            for (int jx = 0; jx < 2; ++jx) {
                const unsigned ow[4] = {ov[q][jx].x, ov[q][jx].y, ov[q][jx].z, ov[q][jx].w}, rw[4] = {rv[q][jx].x, rv[q][jx].y, rv[q][jx].z, rv[q][jx].w};
                const float gg[8] = {gv[jx][0].x, gv[jx][0].y, gv[jx][0].z, gv[jx][0].w, gv[jx][1].x, gv[jx][1].y, gv[jx][1].z, gv[jx][1].w};
                unsigned yw[4];
#pragma unroll
                for (int e = 0; e < 4; ++e) { const float o0 = bf2f(ow[e] & 0xffffu), o1 = bf2f(ow[e] >> 16), r0v = bf2f(rw[e] & 0xffffu), r1v = bf2f(rw[e] >> 16);
                    yw[e] = pk2(o0 * rs[q][jx] * gg[2 * e] * fsilu(r0v), o1 * rs[q][jx] * gg[2 * e + 1] * fsilu(r1v)); }
                v4u y; y.x = yw[0]; y.y = yw[1]; y.z = yw[2]; y.w = yw[3];
                *((v4u*)(YO + (size_t)(m0 + q) * DM) + lane + 64 * jx) = y;
            }
    }
}

__device__ __forceinline__ void final_norm(const Frame& F, const bf16* hb, float* out, const float* ssq, const float* g) {
    LAUNDER_TID();
    const int gw = F.vcu * NWAVES + F.wave, NGW = F.G * NWAVES;
    f32x4 gv[2][2];
#pragma unroll
    for (int jx = 0; jx < 2; ++jx) { gv[jx][0] = *((const f32x4*)g + 2 * (lane + 64 * jx)); gv[jx][1] = *((const f32x4*)g + 2 * (lane + 64 * jx) + 1); }
    for (int m0 = gw * 4; m0 < M; m0 += NGW * 4) {
        v4u hv[4][2]; float r[4];
#pragma unroll
        for (int q = 0; q < 4; ++q) { float ps = (lane < 16) ? ssq[(size_t)(m0 + q) * 16 + lane] : 0.f; ps = wave_sum(ps); r[q] = rsqrtf(ps * (1.0f / 1024.0f) + EPS);
#pragma unroll
            for (int jx = 0; jx < 2; ++jx) hv[q][jx] = __builtin_nontemporal_load((const v4u*)(hb + (size_t)(m0 + q) * DM) + lane + 64 * jx); }
#pragma unroll
        for (int q = 0; q < 4; ++q)
#pragma unroll
            for (int jx = 0; jx < 2; ++jx) { const v4u w = hv[q][jx]; f32x4* o = (f32x4*)(out + (size_t)(m0 + q) * DM) + 2 * (lane + 64 * jx);
                f32x4 a, b; a.x = bf2f(w.x & 0xffffu); a.y = bf2f(w.x >> 16); a.z = bf2f(w.y & 0xffffu); a.w = bf2f(w.y >> 16); b.x = bf2f(w.z & 0xffffu); b.y = bf2f(w.z >> 16); b.z = bf2f(w.w & 0xffffu); b.w = bf2f(w.w >> 16);
                __builtin_nontemporal_store(a * r[q] * gv[jx][0], o); __builtin_nontemporal_store(b * r[q] * gv[jx][1], o + 1); }
    }
}

struct Args { const float* in[18]; float* out; unsigned char* ws; int ph_lo, ph_hi; };
constexpr int N_PHASES = 16;
#ifndef REP_P0
#define REP_P0 1
#endif
#ifndef REP_DSA
#define REP_DSA 1
#endif
#ifndef REP_CONV
#define REP_CONV 1
#endif
#ifndef REP_PREP
#define REP_PREP 1
#endif
#ifndef REP_SCAN
#define REP_SCAN 1
#endif
#ifndef MK_MULTI
#define MK_MULTI 0
#endif
__global__ void __launch_bounds__(NWAVES * 64, 2) fwd(Args args) {
    extern __shared__ __attribute__((aligned(16))) unsigned char lds_raw[];
    Frame F;
    F.lds = (LAS unsigned char*)lds_raw;
    F.tid = threadIdx.x; F.lane = F.tid & 63; F.wave = __builtin_amdgcn_readfirstlane(F.tid >> 6);
    F.G = gridDim.x; { const int bx = blockIdx.x; F.vcu = (F.G % 8 == 0) ? (bx % 8) * (F.G / 8) + bx / 8 : bx; }
    unsigned char* ws = args.ws;
    volatile LAS unsigned* MISC = (volatile LAS unsigned*)(F.lds + LDS_CTL);
    for (int u = F.tid; u < (LDS_BYTES - LDS_CTL) / 4; u += NWAVES * 64) ((LAS unsigned*)(F.lds + LDS_CTL))[u] = 0u;
    __syncthreads();
    unsigned* ctl = (unsigned*)(ws + WS_CTL);
    XcdBarrier bar = xcd_barrier_post(ctl + CW_BAR, MISC + 8);
    const int lo = args.ph_lo, hi = args.ph_hi;
#define IN(k) (lo <= (k) && (k) < hi)
#define SEAM(k) do { if (lo <= (k) && (k) + 1 < hi) xcd_barrier(bar); } while (0)
    float* ssq = (float*)(ws + WS_SSQ);
    const float* rope = (const float*)(ws + WS_ROPE);
    bf16* HB = (bf16*)(ws + WS_HB); bf16* UB = (bf16*)(ws + WS_U); bf16* YC = (bf16*)(ws + WS_YC); bf16* QT = (bf16*)(ws + WS_QT); bf16* KT = (bf16*)(ws + WS_KT); bf16* KTT = (bf16*)(ws + WS_KTT);
    float* DEC = (float*)(ws + WS_DEC); float* gssq = (float*)(ws + WS_GSSQ);

    P0Args A; A.x = args.in[0]; A.mix_g = args.in[1]; A.ab_w_in = args.in[2]; A.ab_w_out = args.in[7]; A.c_w_in = args.in[8]; A.c_w_out = args.in[12];
    A.ffn_g = args.in[13]; A.w_gate = args.in[14]; A.w_up = args.in[15]; A.w_down = args.in[16]; A.ws = ws;
    if (IN(0)) {
#pragma unroll 1
        for (int rep_ = 0; rep_ < REP_P0; ++rep_) p0_prologue(F, A);
    }
    SEAM(0);
#pragma unroll 1
    for (int L = 0; L < 2; ++L) {
        const int pb = 7 * L;
        if (IN(pb + 1)) {
            const int N = L ? CP : ABP;
            pg8::Gemm g{HB, (const bf16*)(ws + (L ? WS_WIN1 : WS_WIN0)), M, N, DM}; pg8::StaticOrder S; S.init(M, N, F.G, (int)blockIdx.x);
            pg8::EpiIn E{UB, N, ssq + (size_t)(2 * L) * M * 16, rope, L == 0 ? 1 : 0};
#pragma unroll 1
            for (int rep_ = 0; rep_ < REP_IN; ++rep_) pg8::gemm_phase<pg8::EpiIn, pg8::StaticOrder, true, true>(F.lds, g, S, E);
        }
        SEAM(pb + 1);
        if (L == 0) {
            if (IN(2)) {
#pragma unroll 1
                for (int pu = F.vcu; pu < 256; pu += F.G) {
                    const int b = pu >> 4, p = pu & 15;
#pragma unroll 1
                    for (int rep = 0; rep < 2 * REP_DSA; ++rep) dsa_unit(F, UB, YC, b, (rep & 1) ? p : 31 - p); }
#pragma unroll 1
                for (int rep_ = 0; rep_ < REP_CONV; ++rep_)
                for (int tile = F.vcu; tile < 512; tile += F.G) conv_unit(F, UB, YC, args.in[3], args.in[4], args.in[5], args.in[6], tile);
            }
            SEAM(2);
        } else {
            if (IN(9)) {
#pragma unroll 1
                for (int rep_ = 0; rep_ < REP_PREP; ++rep_)
                for (int unit = F.vcu; unit < 512; unit += F.G) gla_prep_unit(F, UB, QT, KT, KTT, DEC, args.in[9], args.in[10], unit); }
            SEAM(9);
            if (IN(10)) {
#pragma unroll 1
                for (int rep_ = 0; rep_ < REP_SCAN; ++rep_)
                for (int unit = F.vcu; unit < 256; unit += F.G) gla_scan_unit(F, UB, QT, KT, KTT, DEC, YC, rep_ + 1 < REP_SCAN ? (float*)args.out : gssq, unit >> 4, (unit >> 2) & 3, unit & 3);
            }
            SEAM(10);
            if (IN(11)) {
#pragma unroll 1
                for (int rep_ = 0; rep_ < REP_G3; ++rep_) gla_norm_gate(F, UB, rep_ + 1 < REP_G3 ? QT : YC, YC, gssq, args.in[11]); }
            SEAM(11);
        }
        if (IN(pb + 5)) {
            pg8::Gemm g{YC, (const bf16*)(ws + (L ? WS_WOUT1 : WS_WOUT0)), M, DM, DM}; pg8::StaticOrder S; S.init(M, DM, F.G, (int)blockIdx.x);
            pg8::EpiRes E{HB, HB, ssq + (size_t)(2 * L + 1) * M * 16, 0};
#if REP_OUT > 1
            { pg8::EpiRes EP{HB, QT, ssq + (size_t)5 * M * 16, PROBE_PMODE}; pg8::gemm_phase<pg8::EpiRes, pg8::StaticOrder, true, true>(F.lds, g, S, EP); }
#endif
            pg8::gemm_phase<pg8::EpiRes, pg8::StaticOrder, true, true>(F.lds, g, S, E);
        }
        SEAM(pb + 5);
        if (IN(pb + 6)) {
            pg8::Gemm g{HB, (const bf16*)(ws + (L ? WS_WGU1 : WS_WGU0)), M, GU, DM}; pg8::StaticOrder S; S.init(M, GU, F.G, (int)blockIdx.x, WGM_GU);
            pg8::EpiGLU E{UB, ssq + (size_t)(2 * L + 1) * M * 16, 0};
#if REP_GU > 1
            { pg8::EpiGLU EP{UB, ssq + (size_t)(2 * L + 1) * M * 16, PROBE_PMODE}; pg8::gemm_phase<pg8::EpiGLU, pg8::StaticOrder, true, true>(F.lds, g, S, EP); }
#endif
            pg8::gemm_phase<pg8::EpiGLU, pg8::StaticOrder, true, true>(F.lds, g, S, E);
        }
        SEAM(pb + 6);
        if (IN(pb + 7)) {
            pg8::Gemm g{UB, (const bf16*)(ws + (L ? WS_WDN1 : WS_WDN0)), M, DM, DFF}; pg8::StaticOrder S; S.init(M, DM, F.G, (int)blockIdx.x);
            pg8::EpiRes E{HB, HB, ssq + (size_t)(2 * L + 2) * M * 16, 0};
#if REP_DN > 1
            { pg8::EpiRes EP{HB, QT, ssq + (size_t)5 * M * 16, PROBE_PMODE}; pg8::gemm_phase<pg8::EpiRes, pg8::StaticOrder, true, true>(F.lds, g, S, EP); }
#endif
            pg8::gemm_phase<pg8::EpiRes, pg8::StaticOrder, true, true>(F.lds, g, S, E);
        }
        SEAM(pb + 7);
    }
    if (IN(15)) final_norm(F, HB, args.out, ssq + (size_t)4 * M * 16, args.in[17]);
#undef IN
#undef SEAM
}

extern "C" void kernel_launch(void* const* d_in, const int* in_sizes, int n_in, void* d_out, int out_size, void* d_ws, size_t ws_size, hipStream_t stream) {
    static int grid = 0;
    if (grid == 0) {
        if (n_in != 18 || in_sizes[0] != M * DM || out_size != M * DM || ws_size < WS_END) { fprintf(stderr, "kernel_launch: unexpected shapes (n_in %d, in0 %d, out %d, ws %zu); nothing launched\n", n_in, n_in > 0 ? in_sizes[0] : -1, out_size, ws_size); grid = -1; return; }
        int dev = 0, cus = 0, per_cu = 0;
        if (hipGetDevice(&dev) != hipSuccess || hipDeviceGetAttribute(&cus, hipDeviceAttributeMultiprocessorCount, dev) != hipSuccess) { grid = -1; return; }
        if (hipFuncSetAttribute((const void*)fwd, hipFuncAttributeMaxDynamicSharedMemorySize, LDS_BYTES) != hipSuccess) { fprintf(stderr, "kernel_launch: hipFuncSetAttribute failed\n"); grid = -1; return; }
        if (hipOccupancyMaxActiveBlocksPerMultiprocessor(&per_cu, (const void*)fwd, NWAVES * 64, LDS_BYTES) != hipSuccess || per_cu < 1) fprintf(stderr, "kernel_launch: occupancy query reports %d\n", per_cu);
        (void)hipGetLastError();
        grid = cus;
    }
    if (grid < 0) return;
    if (hipMemsetAsync((char*)d_ws + WS_CTL, 0, CTL_ZERO_BYTES, stream) != hipSuccess) return;
    Args a{};
    for (int i = 0; i < 18; ++i) a.in[i] = (const float*)d_in[i];
    a.out = (float*)d_out; a.ws = (unsigned char*)d_ws;
#if MK_MULTI
    for (int k = 0; k < N_PHASES; ++k) { if (k == 3 || k == 4) continue; a.ph_lo = k; a.ph_hi = k + 1; hipLaunchKernelGGL(fwd, dim3(grid), dim3(NWAVES * 64), LDS_BYTES, stream, a); }
#else
    a.ph_lo = 0; a.ph_hi = N_PHASES; hipLaunchKernelGGL(fwd, dim3(grid), dim3(NWAVES * 64), LDS_BYTES, stream, a);
#endif
}
```

```cpp
#include <hip/hip_runtime.h>
#include <cstdio>
#include <cstdint>
#ifndef REP_IN
#define REP_IN 1
#endif
#ifndef REP_GU
#define REP_GU 1
#endif
#ifndef REP_DSA12
#define REP_DSA12 1
#endif
#ifndef REP_DSA3
#define REP_DSA3 1
#endif
#ifndef REP_DSA1
#define REP_DSA1 1
#endif
#ifndef REP_DSA2
#define REP_DSA2 1
#endif
#ifndef REP_OUT
#define REP_OUT 1
#endif
#ifndef REP_DN
#define REP_DN 1
#endif
#ifndef REP_G3
#define REP_G3 1
#endif
#ifndef PROBE_PMODE
#define PROBE_PMODE 0
#endif
#ifndef WGM_GU
#define WGM_GU 8
#endif
namespace pg8 {
#define PG8_LAS __attribute__((address_space(3)))
typedef unsigned short bf16_t;
typedef short bf16x8 __attribute__((ext_vector_type(8)));
typedef float f32x4 __attribute__((ext_vector_type(4)));
typedef unsigned u32x4 __attribute__((ext_vector_type(4)));
constexpr int BM = 256, BK = 64, HALF = 128, HTB = HALF * BK * 2  , STAGE_BYTES = 8 * HTB, NXCD = 8, WGM = 8;

__host__ __device__ __forceinline__ int lds_byte(int r, int c) { const int st = (r >> 4) * 2 + (c >> 5), rr = r & 15, cc = c & 31, ob = rr * 64 + cc * 2; return st * 1024 + (ob ^ (((ob >> 9) & 1) << 5)); }
__host__ __device__ __forceinline__ void stage_rc(int b, int& R, int& C) { const int st = b / 1024, sb = b % 1024, swz = sb ^ (((sb >> 9) & 1) << 5); R = (st >> 1) * 16 + swz / 64; C = (st & 1) * 32 + (swz % 64) / 2; }
__host__ __device__ __forceinline__ int perm32(int rho) { const int n = rho >> 4, i = rho & 15; return 8 * (i >> 2) + 4 * n + (i & 3); }

struct Unit { int pm, pn; };
struct Gemm { const bf16_t* A; const bf16_t* Bt; int M, N, K; };

struct StaticOrder {
    int nM, nN, nwg, G, c, wgm;
    __host__ __device__ void init(int M, int N, int G_, int c_, int wgm_ = WGM) { nM = M / BM; nN = N / BM; nwg = nM * nN; G = G_; c = c_; wgm = wgm_; }
    __host__ __device__ bool next(int i, Unit& u) const {
        const long L = (long)i * G + c; if (L >= nwg) return false;
        int wgid = (int)L; { const int q = nwg / NXCD, r = nwg % NXCD, xcd = wgid % NXCD, off = wgid / NXCD; wgid = (xcd < r ? xcd * (q + 1) : r * (q + 1) + (xcd - r) * q) + off; }
        const int nig = wgm * nN, gid = wgid / nig, fm = gid * wgm, gsz = (nM - fm) < wgm ? (nM - fm) : wgm;
        u.pm = fm + ((wgid % nig) % gsz); u.pn = (wgid % nig) / gsz; return true;
    }
    __device__ __forceinline__ void a_ready(const Unit&) const {}
    __device__ __forceinline__ void done(const Unit&) const {}
};

__device__ __forceinline__ unsigned cvt_pk_bf16(float lo, float hi) { unsigned r; asm volatile("v_cvt_pk_bf16_f32 %0, %1, %2" : "=v"(r) : "v"(lo), "v"(hi)); return r; }
typedef float f32x2 __attribute__((ext_vector_type(2)));
typedef unsigned u32x2 __attribute__((ext_vector_type(2)));
constexpr float RMS_EPS = 1e-6f;
struct EpiIn {
    static constexpr bool PERM = true, AFTER_DRAIN = false, PREF = true;
    bf16_t* O; int ldc; const float* ssq; const float* rope; int do_rope;
    __device__ __forceinline__ void pref(const Unit& u, int wr, int lane, float& p0, float& p1) const { const f32x4* s = (const f32x4*)(ssq + (size_t)(u.pm * BM + wr * 64 + lane) * 16);
        const f32x4 a0 = s[0], a1 = s[1], a2 = s[2], a3 = s[3], b0 = s[4 * HALF], b1 = s[4 * HALF + 1], b2 = s[4 * HALF + 2], b3 = s[4 * HALF + 3];
        const f32x4 sa = (a0 + a1) + (a2 + a3), sb = (b0 + b1) + (b2 + b3); p0 = (sa.x + sa.y) + (sa.z + sa.w); p1 = (sb.x + sb.y) + (sb.z + sb.w); }
    __device__ __forceinline__ void operator()(const f32x4 (&acc)[2][2][4][2], const Unit& u, int wr, int wc, int fr, int fq, float p0, float p1) const {
        const int row0 = u.pm * BM + wr * 64 + fr, cg0 = u.pn * BM + wc * 32;
#pragma unroll
        for (int ai = 0; ai < 2; ++ai)
#pragma unroll
            for (int m = 0; m < 4; ++m) {
                const int row = row0 + ai * HALF + m * 16;
                const float r = rsqrtf(__shfl(ai ? p1 : p0, fr + 16 * m) * (1.0f / 1024.0f) + RMS_EPS);
                bf16_t* rowp = O + (size_t)row * ldc + cg0 + 8 * fq;
                if (do_rope && u.pn < 4) {
                    float hh[8];
#pragma unroll
                    for (int n = 0; n < 2; ++n)
#pragma unroll
                        for (int e2 = 0; e2 < 4; ++e2) { const float a = acc[ai][0][m][n][e2] * r, g = acc[ai][1][m][n][e2] * r; hh[4 * n + e2] = a * __builtin_amdgcn_rcpf(1.0f + __expf(-g)); }
                    u32x4 w; w.x = cvt_pk_bf16(hh[0], hh[1]); w.y = cvt_pk_bf16(hh[2], hh[3]); w.z = cvt_pk_bf16(hh[4], hh[5]); w.w = cvt_pk_bf16(hh[6], hh[7]);
                    __builtin_nontemporal_store(w, (u32x4*)(O + (size_t)row * ldc + u.pn * HALF + wc * 32 + 8 * fq));
                    continue;
                }
#pragma unroll
                for (int bj = 0; bj < 2; ++bj) {
                    f32x4 v0 = acc[ai][bj][m][0] * r, v1 = acc[ai][bj][m][1] * r;
                    const int cg = cg0 + bj * HALF;
                    const bool rp = do_rope && ((cg & 63) == 0) && ((cg >= 1024 && cg < 1600) || (cg >= 1664 && cg < 2240));
                    if (rp) {
                        const float* cs = rope + (row & 2047) * 16;
                        const f32x4 c0 = *(const f32x4*)cs, c1 = *(const f32x4*)(cs + 4), s0 = *(const f32x4*)(cs + 8), s1 = *(const f32x4*)(cs + 12);
                        f32x4 p0, p1;
#pragma unroll
                        for (int e = 0; e < 4; ++e) { p0[e] = __shfl_xor(v0[e], 16); p1[e] = __shfl_xor(v1[e], 16); }
                        const float sg = (fq == 0) ? -1.0f : 1.0f;
                        if (fq < 2) { v0 = v0 * c0 + p0 * s0 * sg; v1 = v1 * c1 + p1 * s1 * sg; }
                    }
                    u32x4 w; w.x = cvt_pk_bf16(v0[0], v0[1]); w.y = cvt_pk_bf16(v0[2], v0[3]); w.z = cvt_pk_bf16(v1[0], v1[1]); w.w = cvt_pk_bf16(v1[2], v1[3]);
                    __builtin_nontemporal_store(w, (u32x4*)(rowp + bj * HALF));
                }
            }
    }
};
struct EpiRes {
    static constexpr bool PERM = true, AFTER_DRAIN = false, PREF = false;
    const bf16_t* hin; bf16_t* hb; float* ssq; int pmode;
    __device__ __forceinline__ void operator()(const f32x4 (&acc)[2][2][4][2], const Unit& u, int wr, int wc, int fr, int fq) const {
        const int row0 = u.pm * BM + wr * 64 + fr, col0 = u.pn * BM + wc * 32 + 8 * fq;
#pragma unroll
        for (int ai = 0; ai < 2; ++ai)
#pragma unroll
            for (int m = 0; m < 4; ++m) {
                const int row = row0 + ai * HALF + m * 16; const size_t ro = (size_t)row * 1024 + col0; float s = 0.f;
                u32x4 old[2];
#pragma unroll
                for (int bj = 0; bj < 2; ++bj) { if (pmode >= 1) old[bj] = (u32x4){0u, 0u, 0u, 0u}; else old[bj] = *(const u32x4*)(hin + ro + bj * HALF); }
#pragma unroll
                for (int bj = 0; bj < 2; ++bj) {
                    f32x4 v0 = acc[ai][bj][m][0], v1 = acc[ai][bj][m][1];
                    v0[0] += __builtin_bit_cast(float, old[bj].x << 16); v0[1] += __builtin_bit_cast(float, old[bj].x & 0xffff0000u);
                    v0[2] += __builtin_bit_cast(float, old[bj].y << 16); v0[3] += __builtin_bit_cast(float, old[bj].y & 0xffff0000u);
                    v1[0] += __builtin_bit_cast(float, old[bj].z << 16); v1[1] += __builtin_bit_cast(float, old[bj].z & 0xffff0000u);
                    v1[2] += __builtin_bit_cast(float, old[bj].w << 16); v1[3] += __builtin_bit_cast(float, old[bj].w & 0xffff0000u);
                    u32x4 w; w.x = cvt_pk_bf16(v0[0], v0[1]); w.y = cvt_pk_bf16(v0[2], v0[3]); w.z = cvt_pk_bf16(v1[0], v1[1]); w.w = cvt_pk_bf16(v1[2], v1[3]);
                    if (pmode < 3) __builtin_nontemporal_store(w, (u32x4*)(hb + ro + bj * HALF));
                    s += ((v0[0] * v0[0] + v0[1] * v0[1]) + (v0[2] * v0[2] + v0[3] * v0[3])) + ((v1[0] * v1[0] + v1[1] * v1[1]) + (v1[2] * v1[2] + v1[3] * v1[3]));
                }
                s += __shfl_xor(s, 16); s += __shfl_xor(s, 32);
                if (fq == 0 && pmode < 2) ssq[(size_t)row * 16 + u.pn * 4 + wc] = s;
                if (pmode >= 3 && s == 12345.678f) hb[ro] = 0;
                if (m & 1) asm volatile("" ::: "memory");
            }
    }
};
struct EpiGLU {
    static constexpr bool PERM = true, AFTER_DRAIN = false, PREF = true;
    bf16_t* O; const float* ssq; int pmode;
    __device__ __forceinline__ void pref(const Unit& u, int wr, int lane, float& p0, float& p1) const { const f32x4* s = (const f32x4*)(ssq + (size_t)(u.pm * BM + wr * 64 + lane) * 16);
        const f32x4 a0 = s[0], a1 = s[1], a2 = s[2], a3 = s[3], b0 = s[4 * HALF], b1 = s[4 * HALF + 1], b2 = s[4 * HALF + 2], b3 = s[4 * HALF + 3];
        const f32x4 sa = (a0 + a1) + (a2 + a3), sb = (b0 + b1) + (b2 + b3); p0 = (sa.x + sa.y) + (sa.z + sa.w); p1 = (sb.x + sb.y) + (sb.z + sb.w); }
    __device__ __forceinline__ void operator()(const f32x4 (&acc)[2][2][4][2], const Unit& u, int wr, int wc, int fr, int fq, float p0, float p1) const {
        const int row0 = u.pm * BM + wr * 64 + fr, col0 = u.pn * HALF + wc * 32 + 8 * fq;
#pragma unroll
        for (int ai = 0; ai < 2; ++ai)
#pragma unroll
            for (int m = 0; m < 4; ++m) {
                const int row = row0 + ai * HALF + m * 16;
                const float r = rsqrtf(__shfl(ai ? p1 : p0, fr + 16 * m) * (1.0f / 1024.0f) + RMS_EPS);
                float a[8];
#pragma unroll
                for (int n = 0; n < 2; ++n)
#pragma unroll
                    for (int e = 0; e < 4; ++e) { const float g = acc[ai][0][m][n][e] * r, up = acc[ai][1][m][n][e] * r;
                        a[4 * n + e] = (pmode >= 1) ? (g + up) : g * __builtin_amdgcn_rcpf(1.0f + __expf(-g)) * up; }
                u32x4 w; w.x = cvt_pk_bf16(a[0], a[1]); w.y = cvt_pk_bf16(a[2], a[3]); w.z = cvt_pk_bf16(a[4], a[5]); w.w = cvt_pk_bf16(a[6], a[7]);
                if (pmode < 2 || a[0] == 12345.678f) __builtin_nontemporal_store(w, (u32x4*)(O + (size_t)row * 2816 + col0));
            }
    }
};

template <class Epi, class Sched, bool ALIGN_EPI = false, bool SP2 = false>
__device__ __forceinline__ void gemm_phase(PG8_LAS unsigned char* lds, const Gemm g, const Sched& S, const Epi& E) {
    int tid_ = threadIdx.x; asm volatile("" : "+v"(tid_));
    const int tid = tid_, wid = __builtin_amdgcn_readfirstlane(tid >> 6), lane = tid & 63, wr = wid >> 2, wc = wid & 3, fr = lane & 15, fq = lane >> 4;
    const int K = g.K, nt = K / BK;
    unsigned voffA[2], voffB[2];
#pragma unroll
    for (int i = 0; i < 2; ++i) { int R, C; stage_rc(tid * 16 + i * 8192, R, C); const int Rb = Epi::PERM ? ((R & ~31) + perm32(R & 31)) : R;
        voffA[i] = (unsigned)(R * K + C) * 2u; voffB[i] = (unsigned)(Rb * K + C) * 2u; }
    const size_t kstep = (size_t)(BK * 2);
    const size_t hstep = (size_t)HALF * K * 2;
    const size_t tstep = 2 * hstep;
    const unsigned ldsw = (unsigned)wid * 1024u;
    const int aoff = lds_byte(wr * 64 + fr, fq * 8), boff = lds_byte(wc * 32 + fr, fq * 8);
#define PG8_SA(b, h) (((b) * 2 + (h)) * HTB)
#define PG8_SB(b, h) ((4 + (b) * 2 + (h)) * HTB)
#define PG8_STAGE(bufoff, gbase, voff) do { _Pragma("unroll") for (int _i = 0; _i < 2; ++_i) \
        __builtin_amdgcn_global_load_lds((const unsigned*)((const char*)(gbase) + (voff)[_i]), (PG8_LAS unsigned*)(lds + (bufoff) + ldsw + _i * 8192), 16, 0, 0); } while (0)
#define PG8_LDA(dst, b, h) do { _Pragma("unroll") for (int m = 0; m < 4; ++m) _Pragma("unroll") for (int k = 0; k < 2; ++k) dst[m][k] = *(const PG8_LAS bf16x8*)(lds + PG8_SA(b, h) + aoff + m * 2048 + k * 1024); } while (0)
#define PG8_LDB(dst, b, h) do { _Pragma("unroll") for (int n = 0; n < 2; ++n) _Pragma("unroll") for (int k = 0; k < 2; ++k) dst[n][k] = *(const PG8_LAS bf16x8*)(lds + PG8_SB(b, h) + boff + n * 2048 + k * 1024); } while (0)
#define PG8_MMA(ai, bj, At, Bt) do { __builtin_amdgcn_s_setprio(1); _Pragma("unroll") for (int m = 0; m < 4; ++m) _Pragma("unroll") for (int n = 0; n < 2; ++n) _Pragma("unroll") for (int k = 0; k < 2; ++k) \
        acc[ai][bj][m][n] = __builtin_amdgcn_mfma_f32_16x16x32_bf16(Bt[n][k], At[m][k], acc[ai][bj][m][n], 0, 0, 0); __builtin_amdgcn_s_setprio(0); } while (0)
#define PG8_WAIT_V(n) asm volatile("s_waitcnt vmcnt(" #n ")" ::: "memory")
#define PG8_WAIT_L(n) asm volatile("s_waitcnt lgkmcnt(" #n ")" ::: "memory")
#define PG8_BAR __builtin_amdgcn_s_barrier()
#define PG8_SCHED __builtin_amdgcn_sched_barrier(0)
    Unit cur, nxt; int ui = 0;
    if (!S.next(0, cur)) return;
    f32x4 acc[2][2][4][2];
#pragma unroll
    for (int a = 0; a < 2; ++a)
#pragma unroll
        for (int b = 0; b < 2; ++b)
#pragma unroll
            for (int m = 0; m < 4; ++m)
#pragma unroll
                for (int n = 0; n < 2; ++n) acc[a][b][m][n] = (f32x4){0.f, 0.f, 0.f, 0.f};
    bf16x8 At[4][2], B0[2][2], B1[2][2];
    const char* cA = (const char*)g.A + (size_t)cur.pm * tstep; const char* cB = (const char*)g.Bt + (size_t)cur.pn * tstep;
    float pf0 = 0.f, pf1 = 0.f;
    if constexpr (Epi::PREF) E.pref(cur, wr, lane, pf0, pf1);
    S.a_ready(cur);
    if constexpr (SP2) {
        PG8_STAGE(PG8_SB(0, 0), cB, voffB); PG8_STAGE(PG8_SB(0, 1), cB + hstep, voffB); PG8_STAGE(PG8_SA(0, 0), cA, voffA); PG8_STAGE(PG8_SA(0, 1), cA + hstep, voffA);
        if (wr == 1) PG8_BAR;
        PG8_WAIT_V(2); PG8_BAR;
        PG8_STAGE(PG8_SB(1, 0), cB + kstep, voffB); PG8_STAGE(PG8_SA(1, 0), cA + kstep, voffA); PG8_STAGE(PG8_SB(1, 1), cB + hstep + kstep, voffB);
        PG8_WAIT_V(6); PG8_BAR;
    } else {
        PG8_STAGE(PG8_SB(0, 0), cB, voffB); PG8_STAGE(PG8_SA(0, 0), cA, voffA); PG8_STAGE(PG8_SB(0, 1), cB + hstep, voffB); PG8_STAGE(PG8_SA(0, 1), cA + hstep, voffA);
        if (wr == 1) PG8_BAR;
        PG8_WAIT_V(4); PG8_BAR;
        PG8_STAGE(PG8_SB(1, 0), cB + kstep, voffB); PG8_STAGE(PG8_SA(1, 0), cA + kstep, voffA); PG8_STAGE(PG8_SB(1, 1), cB + hstep + kstep, voffB);
        PG8_WAIT_V(6); PG8_BAR;
    }
    for (;;) {
        const bool has_next = S.next(ui + 1, nxt);
        const char* nA = has_next ? (const char*)g.A + (size_t)nxt.pm * tstep : cA; const char* nB = has_next ? (const char*)g.Bt + (size_t)nxt.pn * tstep : cB;
        for (int t = 0; t < nt; t += 2) {
            const bool last = (t == nt - 2);
            const char* a1 = cA + (size_t)(t + 1) * kstep;
            const char* a2 = last ? nA : cA + (size_t)(t + 2) * kstep; const char* b2 = last ? nB : cB + (size_t)(t + 2) * kstep;
            const char* a3 = a2 + kstep; const char* b3 = b2 + kstep;
            if (last && has_next) S.a_ready(nxt);
            if constexpr (SP2) {
            PG8_LDB(B0, 0, 0); PG8_LDB(B1, 0, 1); PG8_SCHED; PG8_LDA(At, 0, 0); PG8_STAGE(PG8_SA(1, 1), a1 + hstep, voffA);
            PG8_WAIT_V(8); PG8_WAIT_L(0); PG8_BAR; PG8_MMA(0, 0, At, B0); PG8_MMA(0, 1, At, B1); PG8_BAR; PG8_SCHED;
            PG8_LDA(At, 0, 1); PG8_STAGE(PG8_SB(0, 0), b2, voffB); PG8_STAGE(PG8_SB(0, 1), b2 + hstep, voffB); PG8_STAGE(PG8_SA(0, 0), a2, voffA);
            PG8_WAIT_V(8); PG8_WAIT_L(0); PG8_BAR; PG8_MMA(1, 0, At, B0); PG8_MMA(1, 1, At, B1); PG8_BAR; PG8_SCHED;
            PG8_LDB(B0, 1, 0); PG8_LDB(B1, 1, 1); PG8_SCHED; PG8_LDA(At, 1, 0); PG8_STAGE(PG8_SA(0, 1), a2 + hstep, voffA);
            PG8_WAIT_V(8); PG8_WAIT_L(0); PG8_BAR; PG8_MMA(0, 0, At, B0); PG8_MMA(0, 1, At, B1); PG8_BAR; PG8_SCHED;
            PG8_LDA(At, 1, 1); PG8_STAGE(PG8_SB(1, 0), b3, voffB); PG8_STAGE(PG8_SB(1, 1), b3 + hstep, voffB); PG8_STAGE(PG8_SA(1, 0), a3, voffA);
            PG8_WAIT_V(8); PG8_WAIT_L(0); PG8_BAR; PG8_MMA(1, 0, At, B0); PG8_MMA(1, 1, At, B1); PG8_BAR; PG8_SCHED;
            } else {
            PG8_LDB(B0, 0, 0); PG8_SCHED; PG8_LDA(At, 0, 0); PG8_STAGE(PG8_SA(1, 1), a1 + hstep, voffA);
            PG8_WAIT_L(8); PG8_BAR; PG8_WAIT_L(0); PG8_MMA(0, 0, At, B0); PG8_BAR; PG8_SCHED;
            PG8_LDB(B1, 0, 1); PG8_STAGE(PG8_SB(0, 0), b2, voffB);
            PG8_BAR; PG8_WAIT_L(0); PG8_MMA(0, 1, At, B1); PG8_BAR;
            PG8_LDA(At, 0, 1); PG8_STAGE(PG8_SA(0, 0), a2, voffA);
            PG8_BAR; PG8_WAIT_L(0); PG8_MMA(1, 0, At, B0); PG8_BAR; PG8_SCHED;
            PG8_STAGE(PG8_SB(0, 1), b2 + hstep, voffB);
            PG8_WAIT_V(6); PG8_BAR; PG8_MMA(1, 1, At, B1); PG8_BAR;
            PG8_LDB(B0, 1, 0); PG8_SCHED; PG8_LDA(At, 1, 0); PG8_STAGE(PG8_SA(0, 1), a2 + hstep, voffA);
            PG8_WAIT_L(8); PG8_BAR; PG8_WAIT_L(0); PG8_MMA(0, 0, At, B0); PG8_BAR; PG8_SCHED;
            PG8_LDB(B1, 1, 1); PG8_STAGE(PG8_SB(1, 0), b3, voffB);
            PG8_BAR; PG8_WAIT_L(0); PG8_MMA(0, 1, At, B1); PG8_BAR;
            PG8_LDA(At, 1, 1); PG8_STAGE(PG8_SA(1, 0), a3, voffA);
            PG8_BAR; PG8_WAIT_L(0); PG8_MMA(1, 0, At, B0); PG8_BAR; PG8_SCHED;
            PG8_STAGE(PG8_SB(1, 1), b3 + hstep, voffB);
            PG8_WAIT_V(6); PG8_BAR; PG8_MMA(1, 1, At, B1); PG8_BAR;
            }
        }
        if constexpr (ALIGN_EPI) { if (wr == 0) PG8_BAR; }
        if constexpr (!Epi::AFTER_DRAIN) { if constexpr (Epi::PREF) { E(acc, cur, wr, wc, fr, fq, pf0, pf1); if (has_next) E.pref(nxt, wr, lane, pf0, pf1); } else E(acc, cur, wr, wc, fr, fq); S.done(cur); }
        if (!has_next) break;
#pragma unroll
        for (int a = 0; a < 2; ++a)
#pragma unroll
            for (int b = 0; b < 2; ++b)
#pragma unroll
                for (int m = 0; m < 4; ++m)
#pragma unroll
                    for (int n = 0; n < 2; ++n) acc[a][b][m][n] = (f32x4){0.f, 0.f, 0.f, 0.f};
        cur = nxt; cA = nA; cB = nB; ++ui;
        if constexpr (ALIGN_EPI) { if (wr == 1) PG8_BAR; }
    }
    PG8_WAIT_V(0);
    if constexpr (!ALIGN_EPI) { if (wr == 0) PG8_BAR; }
    PG8_BAR;
    if constexpr (Epi::AFTER_DRAIN) { E.fused(acc, cur, wr, wc, fr, fq, lds, wid, lane); S.done(cur); }
#undef PG8_SA
#undef PG8_SB
#undef PG8_STAGE
#undef PG8_LDA
#undef PG8_LDB
#undef PG8_MMA
#undef PG8_WAIT_V
#undef PG8_WAIT_L
#undef PG8_BAR
#undef PG8_SCHED
}
}
constexpr int NWAVES = 8;
constexpr int NB = 16, SEQ = 2048, DM = 1024, M = NB * SEQ;
constexpr int ABN = 2248, ABP = 2304, CN = 3088, CP = 3328, DFF = 2816, GU = 2 * DFF;
constexpr int AB_G = 512, AB_Q = 1024, AB_K = 1536, AB_V = 1600, AB_IQ = 1664, AB_IK = 2176, AB_IW = 2240;
constexpr int C_K = 512, C_V = 1024, C_R = 2048, C_GL = 3072;
constexpr float EPS = 1e-6f;
constexpr size_t MiB = 1u << 20;
constexpr size_t WS_CTL = 0, CTL_ZERO_BYTES = 1 * MiB;
constexpr size_t WS_ROPE = 5 * MiB / 2, WS_DEC = 3 * MiB;
constexpr size_t WS_WIN0 = 4 * MiB, WS_WIN1 = WS_WIN0 + (size_t)ABP * DM * 2, WS_WOUT0 = WS_WIN1 + (size_t)CP * DM * 2, WS_WOUT1 = WS_WOUT0 + 2 * MiB;
constexpr size_t WS_WGU0 = WS_WOUT1 + 2 * MiB, WS_WGU1 = WS_WGU0 + (size_t)GU * DM * 2, WS_WDN0 = WS_WGU1 + (size_t)GU * DM * 2, WS_WDN1 = WS_WDN0 + (size_t)DM * DFF * 2;
constexpr size_t WS_HB = 52 * MiB, WS_U = 116 * MiB, WS_YC = 324 * MiB, WS_QT = 388 * MiB, WS_KT = 420 * MiB, WS_KTT = 452 * MiB, WS_SSQ = 484 * MiB, WS_GSSQ = 496 * MiB, WS_END = 504 * MiB;
static_assert(WS_WDN1 + (size_t)DM * DFF * 2 <= WS_HB && WS_HB + (size_t)M * DM * 2 <= WS_U && WS_U + (size_t)M * CP * 2 <= WS_YC && WS_YC + (size_t)M * DM * 2 <= WS_QT && WS_QT + (size_t)M * 512 * 2 <= WS_KT && WS_KT + (size_t)M * 512 * 2 <= WS_KTT && WS_KTT + (size_t)M * 512 * 2 <= WS_SSQ && WS_SSQ + (size_t)6 * M * 64 <= WS_GSSQ && WS_GSSQ + (size_t)M * 256 <= WS_END, "d_ws map");
constexpr int CW_BAR = 4096;
constexpr int SC_STRIDE = 2064;
constexpr int LDS_BM = 16 * SC_STRIDE * 4;
constexpr int LDS_CTL = LDS_BM + 16384;
constexpr int LDS_BYTES = LDS_CTL + 1024;
#define GAS __attribute__((address_space(1)))
#define LAS __attribute__((address_space(3)))
typedef unsigned short bf16;
typedef unsigned v4u __attribute__((ext_vector_type(4)));
typedef unsigned v2u __attribute__((ext_vector_type(2)));
typedef float f32x4 __attribute__((ext_vector_type(4)));
typedef float f32x16 __attribute__((ext_vector_type(16)));
typedef short bf16x8 __attribute__((ext_vector_type(8)));
#define LDS_WAIT() asm volatile("s_waitcnt lgkmcnt(0)" ::: "memory")
#define LDS_BARRIER() do { asm volatile("s_waitcnt lgkmcnt(0)" ::: "memory"); __builtin_amdgcn_s_barrier(); asm volatile("" ::: "memory"); } while (0)
typedef __bf16 bf16pair_t __attribute__((ext_vector_type(2)));
__device__ __forceinline__ unsigned pk2(float lo, float hi) { bf16pair_t v; v.x = (__bf16)lo; v.y = (__bf16)hi; return __builtin_bit_cast(unsigned, v); }
__device__ __forceinline__ unsigned f2bf(float f) { return pk2(f, 0.f) & 0xffffu; }
__device__ __forceinline__ float fexp2(float x) { return __builtin_amdgcn_exp2f(x); }
__device__ __forceinline__ float fexp(float x) { return __builtin_amdgcn_exp2f(x * 1.44269504089f); }
__device__ __forceinline__ float frcp(float x) { return __builtin_amdgcn_rcpf(x); }
__device__ __forceinline__ float fsilu(float x) { return x * __builtin_amdgcn_rcpf(1.0f + __builtin_amdgcn_exp2f(-1.44269504089f * x)); }
__device__ __forceinline__ float bf2f(unsigned b) { return __builtin_bit_cast(float, b << 16); }
__device__ __forceinline__ float wave_sum(float v) {
#pragma unroll
    for (int o = 1; o < 64; o <<= 1) v += __shfl_xor(v, o);
    return v;
}
__device__ __forceinline__ int wave_isum(int v) {
    v += __builtin_amdgcn_update_dpp(0, v, 0xB1, 0xf, 0xf, false);
    v += __builtin_amdgcn_update_dpp(0, v, 0x4E, 0xf, 0xf, false);
    v += __builtin_amdgcn_update_dpp(0, v, 0x141, 0xf, 0xf, false);
    v += __builtin_amdgcn_update_dpp(0, v, 0x140, 0xf, 0xf, false);
    v += __builtin_amdgcn_update_dpp(0, v, 0x142, 0xa, 0xf, false);
    v += __builtin_amdgcn_update_dpp(0, v, 0x143, 0xc, 0xf, false);
    return __builtin_amdgcn_readlane(v, 63);
}
#define DPPF(v, ctl, rmask) __builtin_bit_cast(float, __builtin_amdgcn_update_dpp(__builtin_bit_cast(int, v), __builtin_bit_cast(int, v), ctl, rmask, 0xf, false))
__device__ __forceinline__ float wave_fmax(float v) {
    v = fmaxf(v, DPPF(v, 0xB1, 0xf)); v = fmaxf(v, DPPF(v, 0x4E, 0xf)); v = fmaxf(v, DPPF(v, 0x141, 0xf)); v = fmaxf(v, DPPF(v, 0x140, 0xf));
    v = fmaxf(v, DPPF(v, 0x142, 0xa)); v = fmaxf(v, DPPF(v, 0x143, 0xc));
    return __builtin_bit_cast(float, __builtin_amdgcn_readlane(__builtin_bit_cast(int, v), 63));
}
__device__ __forceinline__ f32x4 mfma16(bf16x8 a, bf16x8 b, f32x4 c) { return __builtin_amdgcn_mfma_f32_16x16x32_bf16(a, b, c, 0, 0, 0); }
__device__ __forceinline__ f32x16 mfma32(bf16x8 a, bf16x8 b, f32x16 c) { return __builtin_amdgcn_mfma_f32_32x32x16_bf16(a, b, c, 0, 0, 0); }
__device__ __forceinline__ bf16x8 mk8(v2u lo, v2u hi) { v4u t; t.x = lo.x; t.y = lo.y; t.z = hi.x; t.w = hi.y; return __builtin_bit_cast(bf16x8, t); }
__device__ __forceinline__ bf16x8 pack8(float a0, float a1, float a2, float a3, float a4, float a5, float a6, float a7) {
    v4u t; t.x = pk2(a0, a1); t.y = pk2(a2, a3); t.z = pk2(a4, a5); t.w = pk2(a6, a7); return __builtin_bit_cast(bf16x8, t); }

#define XB_TMO      128
#define XB_XCNT(j)  (256  + 64 * (j))
#define XB_XSUB(j)  (1280 + 64 * (j))
#define XB_XGEN(j)  (2304 + 64 * (j))
#define XB_TOP      3328
#define XB_TOPGEN   3392
#define XCD_BAR_WORDS 3456
#define XB_SPIN_CAP (1u << 18)

__device__ __forceinline__ unsigned xb_ld(unsigned* p)              { return __hip_atomic_load(p, __ATOMIC_RELAXED, __HIP_MEMORY_SCOPE_AGENT); }
__device__ __forceinline__ unsigned xb_add(unsigned* p, unsigned v) { return __hip_atomic_fetch_add(p, v, __ATOMIC_RELAXED, __HIP_MEMORY_SCOPE_AGENT); }
__device__ __forceinline__ unsigned xb_xcc_id() { return (unsigned)__builtin_amdgcn_s_getreg((3 << 11) | 20) & 0xFu; }
#define XB_SPIN(cond, bar) do { unsigned _sp = 0; while (cond) { __builtin_amdgcn_s_sleep(1); \
    if ((++_sp & 255u) == 0u) { if (xb_ld(&(bar)[XB_TMO])) break; if (_sp > XB_SPIN_CAP) { atomicAdd(&(bar)[XB_TMO], 1u); break; } } } } while (0)

struct XcdBarrier {
    unsigned* bar; unsigned x;
    volatile LAS unsigned* st;
};

__device__ __forceinline__ XcdBarrier xcd_barrier_post(unsigned* bar, volatile LAS unsigned* st) {
    XcdBarrier b; b.bar = bar; b.x = xb_xcc_id(); b.st = st;
    if (threadIdx.x == 0) (void)xb_add(&bar[XB_XCNT(b.x)], 1u);
    return b;
}
__device__ __forceinline__ void xcd_barrier_complete(unsigned* bar, unsigned x, unsigned& nloc, unsigned& nx) {
    const unsigned G = gridDim.x * gridDim.y * gridDim.z;
    unsigned sum, cnt, mine, sp = 0u;
    for (;;) {
        sum = 0u; cnt = 0u; mine = 0u;
#pragma unroll
        for (unsigned j = 0; j < 16; ++j) { const unsigned c = xb_ld(&bar[XB_XCNT(j)]); sum += c; cnt += (c > 0u) ? 1u : 0u; mine = (j == x) ? c : mine; }
        if (sum == G) break;
        __builtin_amdgcn_s_sleep(1);
        if ((++sp & 255u) == 0u) { if (xb_ld(&bar[XB_TMO])) break; if (sp > XB_SPIN_CAP) { atomicAdd(&bar[XB_TMO], 1u); break; } }
    }
    nloc = mine > 0u ? mine : 1u; nx = cnt > 0u ? cnt : 1u;
}

__device__ __forceinline__ void xcd_barrier(const XcdBarrier& b) {
    asm volatile("s_waitcnt vmcnt(0)" ::: "memory");
    __syncthreads();
    if (threadIdx.x == 0) {
        unsigned* bar = b.bar;
        __builtin_amdgcn_s_waitcnt(0);
        unsigned nloc = b.st[0], nx = b.st[1];
        if (nloc == 0u) { xcd_barrier_complete(bar, b.x, nloc, nx); b.st[0] = nloc; b.st[1] = nx; }
        const unsigned old = xb_add(&bar[XB_XSUB(b.x)], 1u);
        const unsigned gen = old / nloc;
        if (old + 1u == (gen + 1u) * nloc) {
            __builtin_amdgcn_fence(__ATOMIC_RELEASE, "agent");
            asm volatile("s_waitcnt vmcnt(0)" ::: "memory");
            const unsigned og = xb_add(&bar[XB_TOP], 1u);
            const unsigned tg = og / nx;
            if (og + 1u == (tg + 1u) * nx) xb_add(&bar[XB_TOPGEN], 1u);
            else XB_SPIN(xb_ld(&bar[XB_TOPGEN]) == tg, bar);
            __builtin_amdgcn_fence(__ATOMIC_ACQUIRE, "agent");
            xb_add(&bar[XB_XGEN(b.x)], 1u);
            asm volatile("s_waitcnt vmcnt(0)" ::: "memory");
        } else {
            XB_SPIN(xb_ld(&bar[XB_XGEN(b.x)]) == gen, bar);
            __builtin_amdgcn_fence(__ATOMIC_ACQUIRE, "agent");
            asm volatile("s_waitcnt vmcnt(0)" ::: "memory");
        }
    }
    __syncthreads();
}

struct Frame { LAS unsigned char* lds; int tid, lane, wave, vcu, G; };
#define LAUNDER_TID() int tid_l_ = threadIdx.x; asm volatile("" : "+v"(tid_l_)); const int tid = tid_l_, lane = tid & 63; (void)tid; (void)lane

__device__ __forceinline__ void p0_item(const float* W, int K, int N, const float* gain, bf16* WT, int drow0, int k0, int n0, LAS float* scr, int lane) {
    const int n_ = n0 + (lane & 31), nc_ = n_ < N ? n_ : N - 1; const float keep_ = n_ < N ? 1.f : 0.f;
#pragma unroll
    for (int i0 = 0; i0 < 32; i0 += 16) {
        float v[16];
#pragma unroll
        for (int i = 0; i < 16; ++i) v[i] = __builtin_nontemporal_load(W + (size_t)(k0 + 2 * (i0 + i) + (lane >> 5)) * N + nc_);
#pragma unroll
        for (int i = 0; i < 16; ++i) { const int kk = 2 * (i0 + i) + (lane >> 5); float x = v[i] * keep_; if (gain) x *= gain[k0 + kk]; scr[kk * 33 + (lane & 31)] = x; }
    }
    LDS_WAIT(); asm volatile("" ::: "memory");
    const int c = lane & 7;
#pragma unroll
    for (int j = 0; j < 4; ++j) { const int n = (lane >> 3) + 8 * j; const LAS float* s = scr + (8 * c) * 33 + n;
        v4u o; o.x = pk2(s[0 * 33], s[1 * 33]); o.y = pk2(s[2 * 33], s[3 * 33]); o.z = pk2(s[4 * 33], s[5 * 33]); o.w = pk2(s[6 * 33], s[7 * 33]);
        *(v4u*)(WT + (size_t)(drow0 + n) * K + k0 + 8 * c) = o; }
    LDS_WAIT(); asm volatile("" ::: "memory");
}
struct P0Args { const float *x, *mix_g, *ab_w_in, *ab_w_out, *c_w_in, *c_w_out, *ffn_g, *w_gate, *w_up, *w_down; unsigned char* ws; };
__device__ __forceinline__ void p0_weights(const Frame& F, const P0Args& A, int it_lo, int it_hi, int gw, int NGW) {
    LAUNDER_TID();
    LAS float* scr = (LAS float*)(F.lds + F.wave * 16384);
    bf16* const win0 = (bf16*)(A.ws + WS_WIN0); bf16* const win1 = (bf16*)(A.ws + WS_WIN1); bf16* const wout0 = (bf16*)(A.ws + WS_WOUT0); bf16* const wout1 = (bf16*)(A.ws + WS_WOUT1);
    bf16* const wgu0 = (bf16*)(A.ws + WS_WGU0); bf16* const wgu1 = (bf16*)(A.ws + WS_WGU1); bf16* const wdn0 = (bf16*)(A.ws + WS_WDN0); bf16* const wdn1 = (bf16*)(A.ws + WS_WDN1);
    constexpr int I_IN0 = 16 * (ABP / 32), I_IN1 = 16 * (CP / 32), I_OUT = 16 * 32, I_GU = 16 * (DFF / 32), I_DN = (DFF / 64) * 32;
    constexpr int NITEMS = I_IN0 + I_IN1 + 2 * I_OUT + 4 * I_GU + 2 * I_DN;
    for (int it = it_lo + gw; it < (it_hi < NITEMS ? it_hi : NITEMS); it += NGW) {
        int r = it; const float* W = nullptr; const float* gain = nullptr; bf16* WT = nullptr; int K = 0, N = 0, Np = 0, mode = 0; bool found = false;
#define P0_MAT(Wp, Kv, Nv, Npv, gp, WTp, md, cnt) { if (!found) { if (r < (cnt)) { W = (Wp); K = (Kv); N = (Nv); Np = (Npv); gain = (gp); WT = (WTp); mode = (md); found = true; } else r -= (cnt); } }
        P0_MAT(A.ab_w_in, DM, ABN, ABP, A.mix_g, win0, 3, I_IN0)
        P0_MAT(A.c_w_in, DM, CN, CP, A.mix_g + DM, win1, 0, I_IN1)
        P0_MAT(A.ab_w_out, DM, DM, DM, nullptr, wout0, 0, I_OUT)
        P0_MAT(A.c_w_out, DM, DM, DM, nullptr, wout1, 0, I_OUT)
        P0_MAT(A.w_gate, DM, DFF, DFF, A.ffn_g, wgu0, 1, I_GU)
        P0_MAT(A.w_up, DM, DFF, DFF, A.ffn_g, wgu0, 2, I_GU)
        P0_MAT(A.w_gate + (size_t)DM * DFF, DM, DFF, DFF, A.ffn_g + DM, wgu1, 1, I_GU)
        P0_MAT(A.w_up + (size_t)DM * DFF, DM, DFF, DFF, A.ffn_g + DM, wgu1, 2, I_GU)
        P0_MAT(A.w_down, DFF, DM, DM, nullptr, wdn0, 0, I_DN)
        P0_MAT(A.w_down + (size_t)DFF * DM, DFF, DM, DM, nullptr, wdn1, 0, I_DN)
#undef P0_MAT
        const int nblk = Np / 32, kb = r / nblk, nb = r % nblk, n0 = 32 * nb;
        int drow0 = n0; if (mode == 1 || mode == 2) drow0 = 256 * (n0 >> 7) + (n0 & 127) + (mode == 2 ? 128 : 0);
        if (mode == 3 && n0 < 1024) { const int nn = n0 & 511; drow0 = 256 * (nn >> 7) + (nn & 127) + (n0 >= 512 ? 128 : 0); }
        p0_item(W, K, N, gain, WT, drow0, 64 * kb, n0, scr, lane);
    }
}
constexpr int P0_I_IN0 = 16 * (ABP / 32);
__device__ __forceinline__ void p0_prologue(const Frame& F, const P0Args& A) {
    LAUNDER_TID();
    const int gw = F.vcu * NWAVES + F.wave, NGW = F.G * NWAVES;
    p0_weights(F, A, 0, 1 << 30, gw, NGW);
    bf16* HB = (bf16*)(A.ws + WS_HB); float* ssq0 = (float*)(A.ws + WS_SSQ);
    for (int m0 = gw * 4; m0 < M; m0 += NGW * 4) {
        f32x4 v[4][4];
#pragma unroll
        for (int q = 0; q < 4; ++q)
#pragma unroll
            for (int j = 0; j < 4; ++j) v[q][j] = __builtin_nontemporal_load((const f32x4*)(A.x + (size_t)(m0 + q) * DM) + lane + 64 * j);
#pragma unroll
        for (int q = 0; q < 4; ++q) { float s = 0.f;
#pragma unroll
            for (int j = 0; j < 4; ++j) s += (v[q][j].x * v[q][j].x + v[q][j].y * v[q][j].y) + (v[q][j].z * v[q][j].z + v[q][j].w * v[q][j].w);
            s = wave_sum(s); if (lane < 4) *((f32x4*)(ssq0 + (size_t)(m0 + q) * 16) + lane) = (f32x4){lane == 0 ? s : 0.f, 0.f, 0.f, 0.f};
            v2u* o8 = (v2u*)(HB + (size_t)(m0 + q) * DM) + lane;
#pragma unroll
            for (int j = 0; j < 4; ++j) { v2u w; w.x = pk2(v[q][j].x, v[q][j].y); w.y = pk2(v[q][j].z, v[q][j].w); o8[64 * j] = w; } }
    }
    float* rope = (float*)(A.ws + WS_ROPE);
    for (int e = F.vcu * 512 + tid; e < SEQ * 8; e += F.G * 512) { const int t = e >> 3, i = e & 7;
        const float inv = powf(500000.0f, -(float)i * 0.125f); const float ang = (float)t * inv;
        rope[t * 16 + i] = cosf(ang); rope[t * 16 + 8 + i] = sinf(ang); }
}

__device__ __forceinline__ unsigned ordkey(float f) { const unsigned u = __builtin_bit_cast(unsigned, f); return (u & 0x80000000u) ? ~u : (u | 0x80000000u); }
#ifndef DSA_VALU_COUNT
#define DSA_VALU_COUNT 0
#endif
#define DSA_CNT8(ca, cb, cfs, b) do { unsigned long long m0_, m1_, m2_, m3_; \
    asm("v_cmp_le_f32_e64 %2, %6, %7\n\tv_cmp_le_f32_e64 %3, %6, %8\n\tv_cmp_le_f32_e64 %4, %6, %9\n\tv_cmp_le_f32_e64 %5, %6, %10\n\t" \
        "v_addc_co_u32_e64 %0, %2, 0, %0, %2\n\tv_cmp_le_f32_e64 %2, %6, %11\n\tv_addc_co_u32_e64 %1, %3, 0, %1, %3\n\tv_cmp_le_f32_e64 %3, %6, %12\n\t" \
        "v_addc_co_u32_e64 %0, %4, 0, %0, %4\n\tv_cmp_le_f32_e64 %4, %6, %13\n\tv_addc_co_u32_e64 %1, %5, 0, %1, %5\n\tv_cmp_le_f32_e64 %5, %6, %14\n\t" \
        "v_addc_co_u32_e64 %0, %2, 0, %0, %2\n\tv_addc_co_u32_e64 %1, %3, 0, %1, %3\n\tv_addc_co_u32_e64 %0, %4, 0, %0, %4\n\tv_addc_co_u32_e64 %1, %5, 0, %1, %5" \
        : "+v"(ca), "+v"(cb), "=&s"(m0_), "=&s"(m1_), "=&s"(m2_), "=&s"(m3_) : "s"(cfs), "v"(k[8 * (b) + 0]), "v"(k[8 * (b) + 1]), "v"(k[8 * (b) + 2]), "v"(k[8 * (b) + 3]), \
          "v"(k[8 * (b) + 4]), "v"(k[8 * (b) + 5]), "v"(k[8 * (b) + 6]), "v"(k[8 * (b) + 7])); } while (0)
template <int NB> __device__ __forceinline__ int dsa_count(const float (&k)[32], float cf) {
#if DSA_VALU_COUNT
    int ca = 0, cb = 0;
    DSA_CNT8(ca, cb, cf, 0);
    if (NB > 1) DSA_CNT8(ca, cb, cf, 1);
    if (NB > 2) DSA_CNT8(ca, cb, cf, 2);
    if (NB > 3) DSA_CNT8(ca, cb, cf, 3);
    return wave_isum(ca + cb);
#else
    int cnt = 0;
#pragma unroll
    for (int blk = 0; blk < NB; ++blk) { unsigned long long mm_[8];
#pragma unroll
        for (int i = 0; i < 8; ++i) mm_[i] = __ballot(k[8 * blk + i] >= cf);
        __builtin_amdgcn_sched_barrier(0);
#pragma unroll
        for (int i = 0; i < 8; ++i) cnt += __popcll(mm_[i]); }
    return cnt;
#endif
}
#undef DSA_CNT8
template <int NB> __device__ __forceinline__ void dsa_select(const float (&k)[32], int lane, unsigned& mlo, unsigned& mhi) {
    unsigned T = 0u; bool exact = false; int bit = 30;
    int cnt = dsa_count<NB>(k, 0.0f);
    if (cnt >= 256) {
        T = 0x80000000u;
        if (cnt == 256) exact = true;
        else {
            float kmx = k[0];
#pragma unroll
            for (int i = 1; i < 8 * NB; ++i) kmx = fmaxf(kmx, k[i]);
            kmx = wave_fmax(kmx);
            int eb = (int)((__builtin_bit_cast(unsigned, kmx) >> 23) & 0xffu);
            bit = 30;
            for (int step = 0; step < 3 && eb >= 1; ++step, --eb) { const float cf = __builtin_bit_cast(float, (unsigned)eb << 23); cnt = dsa_count<NB>(k, cf);
                if (cnt >= 256) { T = 0x80000000u | ((unsigned)eb << 23); if (cnt == 256) exact = true; bit = 22; break; } }
        }
    }
    for (; bit >= 0 && !exact; --bit) {
        const unsigned cand = T | (1u << bit); const float cf = __builtin_bit_cast(float, (cand & 0x80000000u) ? (cand & 0x7fffffffu) : ~cand);
        cnt = dsa_count<NB>(k, cf);
        if (cnt >= 256) { T = cand; if (cnt == 256) exact = true; }
    }
    const float Tf = __builtin_bit_cast(float, (T & 0x80000000u) ? (T & 0x7fffffffu) : ~T);
    if (exact) {
#pragma unroll
        for (int i = 0; i < 8 * NB; ++i) { const unsigned long long mm = __ballot(k[i] >= Tf); if (lane == i) { mlo = (unsigned)mm; mhi = (unsigned)(mm >> 32); } }
    } else {
        int cgt = 0;
#pragma unroll
        for (int i = 0; i < 8 * NB; ++i) cgt += __popcll(__ballot(k[i] > Tf));
        const int need = 256 - cgt; int base = 0;
#pragma unroll
        for (int i = 0; i < 8 * NB; ++i) {
            const bool eq = (k[i] == Tf); const unsigned long long me = __ballot(eq);
            const int rank = base + (int)__builtin_amdgcn_mbcnt_hi((unsigned)(me >> 32), __builtin_amdgcn_mbcnt_lo((unsigned)me, 0u));
            const bool sel = (k[i] > Tf) || (eq && rank < need);
            const unsigned long long mm = __ballot(sel);
            if (lane == i) { mlo = (unsigned)mm; mhi = (unsigned)(mm >> 32); }
            base += __popcll(me);
        }
    }
}
constexpr int KSTR = 72, VSTR = 72;
__device__ __forceinline__ void dsa_unit(const Frame& F, const bf16* U, bf16* YC, int b, int j) {
    LAUNDER_TID(); const int wave = F.wave;
    const size_t rb = (size_t)b * SEQ;
    LAS float* SC = (LAS float*)F.lds;
    LAS unsigned* BM = (LAS unsigned*)(F.lds + LDS_BM);
#pragma unroll 1
    for (int rep12_ = 0; rep12_ < REP_DSA12; ++rep12_)
    {
        const f32x4 ninf = {-__builtin_inff(), -__builtin_inff(), -__builtin_inff(), -__builtin_inff()};
        for (int e = tid; e < 16 * SC_STRIDE / 4; e += 512) ((LAS f32x4*)SC)[e] = ninf;
        LDS_BARRIER();
    }
    {
    bf16x8 nbq[8][2]; v4u niw;
    { const bf16* qrow = U + (rb + 64 * j + (lane & 15)) * ABP;
#pragma unroll
      for (int h = 0; h < 8; ++h)
#pragma unroll
        for (int ks = 0; ks < 2; ++ks) nbq[h][ks] = *(const bf16x8*)(qrow + AB_IQ + h * 64 + ks * 32 + (lane >> 4) * 8);
      niw = *(const v4u*)(qrow + AB_IW); }
#pragma unroll 1
    for (int s = 0; s < 4; ++s) {
        const int t0 = 64 * j + 16 * s, nkt = (t0 >> 4) + 1;
        {
            const int c = lane & 15, g = lane >> 4;
            bf16x8 bq[8][2];
#pragma unroll
            for (int h = 0; h < 8; ++h)
#pragma unroll
                for (int ks = 0; ks < 2; ++ks) bq[h][ks] = nbq[h][ks];
            float iwv[8];
            { const v4u raw = niw; const float ws = 0.04419417382f;
              iwv[0] = bf2f(raw.x & 0xffffu) * ws; iwv[1] = bf2f(raw.x >> 16) * ws; iwv[2] = bf2f(raw.y & 0xffffu) * ws; iwv[3] = bf2f(raw.y >> 16) * ws;
              iwv[4] = bf2f(raw.z & 0xffffu) * ws; iwv[5] = bf2f(raw.z >> 16) * ws; iwv[6] = bf2f(raw.w & 0xffffu) * ws; iwv[7] = bf2f(raw.w >> 16) * ws; }
            bf16x8 nak[4][2];
#pragma unroll
            for (int u = 0; u < 4; ++u) { const int kt = wave + 8 * u;
                if (kt < nkt) { const bf16* krow = U + (rb + 16 * kt + c) * ABP + AB_IK + g * 8; nak[u][0] = *(const bf16x8*)krow; nak[u][1] = *(const bf16x8*)(krow + 32); } }
            for (int kt0 = wave; kt0 < nkt; kt0 += 32) {
                bf16x8 ak[4][2];
#pragma unroll
                for (int u = 0; u < 4; ++u) { ak[u][0] = nak[u][0]; ak[u][1] = nak[u][1]; }
#pragma unroll
                for (int u = 0; u < 4; ++u) { const int kt = kt0 + 32 + 8 * u;
                    if (kt < nkt) { const bf16* krow = U + (rb + 16 * kt + c) * ABP + AB_IK + g * 8; nak[u][0] = *(const bf16x8*)krow; nak[u][1] = *(const bf16x8*)(krow + 32); } }
#pragma unroll
                for (int u = 0; u < 4; ++u) { const int kt = kt0 + 8 * u;
                    if (kt < nkt) {
                        f32x4 sc = {0.f, 0.f, 0.f, 0.f};
#pragma unroll
                        for (int h = 0; h < 8; ++h) { f32x4 acc = {0.f, 0.f, 0.f, 0.f}; acc = mfma16(ak[u][0], bq[h][0], acc); acc = mfma16(ak[u][1], bq[h][1], acc);
#pragma unroll
                            for (int i = 0; i < 4; ++i) sc[i] += fmaxf(acc[i], 0.f) * iwv[h]; }
#pragma unroll
                        for (int i = 0; i < 4; ++i) sc[i] = (16 * kt + 4 * g + i <= t0 + c) ? sc[i] : -__builtin_inff();
                        *(LAS f32x4*)(SC + c * SC_STRIDE + 16 * kt + 4 * g) = sc;
                    } }
            }
            if (s < 3) { const bf16* qrow = U + (rb + t0 + 16 + c) * ABP;
#pragma unroll
                for (int h = 0; h < 8; ++h)
#pragma unroll
                    for (int ks = 0; ks < 2; ++ks) nbq[h][ks] = *(const bf16x8*)(qrow + AB_IQ + h * 64 + ks * 32 + g * 8);
                niw = *(const v4u*)(qrow + AB_IW); }
        }
        LDS_BARRIER();
#pragma unroll 1
        for (int rep2_ = 0; rep2_ < REP_DSA2; ++rep2_)
        for (int qq = 0; qq < 2; ++qq) {
            const int q = 2 * wave + qq, t = t0 + q;
            float k[32];
#pragma unroll
            for (int i = 0; i < 32; ++i) k[i] = *(volatile LAS float*)(SC + q * SC_STRIDE + 64 * i + lane);
            unsigned mlo = 0u, mhi = 0u;
            if (t < 256) {
#pragma unroll
                for (int i = 0; i < 4; ++i) { const unsigned long long mm = __ballot((64 * i + lane) <= t); if (lane == i) { mlo = (unsigned)mm; mhi = (unsigned)(mm >> 32); } }
            } else if (t < 512) dsa_select<1>(k, lane, mlo, mhi);
            else if (t < 1024) dsa_select<2>(k, lane, mlo, mhi);
            else if (t < 1536) dsa_select<3>(k, lane, mlo, mhi);
            else dsa_select<4>(k, lane, mlo, mhi);
            if (lane < 32) { BM[(16 * s + q) * 64 + 2 * lane] = mlo; BM[(16 * s + q) * 64 + 2 * lane + 1] = mhi; }
        }
        LDS_BARRIER();
    }
    }
    __syncthreads();
    LAS bf16* Ks = (LAS bf16*)F.lds;
    LAS bf16* Vt = (LAS bf16*)(F.lds + 2 * 64 * KSTR * 2);
    const int c = lane & 31, hi = lane >> 5;
#pragma unroll 1
    for (int rep3_ = 0; rep3_ < REP_DSA3; ++rep3_) {
    LAS bf16x8* QF = (LAS bf16x8*)(F.lds + 4 * 64 * KSTR * 2) + wave * 512;
#pragma unroll
    for (int nt = 0; nt < 2; ++nt)
#pragma unroll
        for (int ks = 0; ks < 4; ++ks) QF[(nt * 4 + ks) * 64 + lane] = *(const bf16x8*)(U + (rb + 64 * j + 32 * nt + c) * ABP + AB_Q + wave * 64 + 16 * ks + 8 * hi);
    f32x16 O[2][2];
#pragma unroll
    for (int dt = 0; dt < 2; ++dt)
#pragma unroll
        for (int nt = 0; nt < 2; ++nt)
#pragma unroll
            for (int i = 0; i < 16; ++i) O[dt][nt][i] = 0.f;
    float mrow[2] = {-1e30f, -1e30f}, lrow[2] = {0.f, 0.f};
    const float sc2 = 0.125f * 1.44269504089f;
    const int krow_s = tid >> 3, kch_s = tid & 7, vkey_s = tid & 63, vch_s = tid >> 6;
    v4u kreg = *(const v4u*)(U + (rb + krow_s) * ABP + AB_K + 8 * kch_s);
    v4u vreg = *(const v4u*)(U + (rb + vkey_s) * ABP + AB_V + 8 * vch_s);
    {
        *(LAS v4u*)(Ks + krow_s * KSTR + 8 * kch_s) = kreg;
        const unsigned ve[4] = {vreg.x, vreg.y, vreg.z, vreg.w};
#pragma unroll
        for (int e = 0; e < 4; ++e) { Vt[(8 * vch_s + 2 * e) * VSTR + vkey_s] = (bf16)(ve[e] & 0xffffu); Vt[(8 * vch_s + 2 * e + 1) * VSTR + vkey_s] = (bf16)(ve[e] >> 16); }
    }
    __syncthreads();
    for (int kt = 0; kt <= j; ++kt) {
        const int buf = kt & 1;
        if (kt < j) {
            kreg = *(const v4u*)(U + (rb + 64 * (kt + 1) + krow_s) * ABP + AB_K + 8 * kch_s);
            vreg = *(const v4u*)(U + (rb + 64 * (kt + 1) + vkey_s) * ABP + AB_V + 8 * vch_s);
        }
        const LAS bf16* Kb = Ks + buf * 64 * KSTR; const LAS bf16* Vb = Vt + buf * 64 * VSTR;
        bf16x8 va[2][4]; unsigned wm[2][2];
#pragma unroll
        for (int dt = 0; dt < 2; ++dt)
#pragma unroll
            for (int kk = 0; kk < 4; ++kk) { const LAS bf16* vp = Vb + (32 * dt + c) * VSTR + 16 * kk + 4 * hi; va[dt][kk] = mk8(*(const LAS v2u*)vp, *(const LAS v2u*)(vp + 8)); }
#pragma unroll
        for (int nt = 0; nt < 2; ++nt)
#pragma unroll
            for (int mt = 0; mt < 2; ++mt) wm[nt][mt] = BM[(32 * nt + c) * 64 + 2 * kt + mt] >> (4 * hi);
#pragma unroll
        for (int nt = 0; nt < 2; ++nt) {
            f32x16 S[2];
            {
                bf16x8 ka[2][4], bq[4];
#pragma unroll
                for (int ks = 0; ks < 4; ++ks) bq[ks] = QF[(nt * 4 + ks) * 64 + lane];
#pragma unroll
                for (int mt = 0; mt < 2; ++mt)
#pragma unroll
                    for (int ks = 0; ks < 4; ++ks) ka[mt][ks] = *(const LAS bf16x8*)(Kb + (32 * mt + c) * KSTR + 16 * ks + 8 * hi);
#pragma unroll
                for (int mt = 0; mt < 2; ++mt) {
#pragma unroll
                    for (int i = 0; i < 16; ++i) S[mt][i] = 0.f;
#pragma unroll
                    for (int ks = 0; ks < 4; ++ks) S[mt] = mfma32(ka[mt][ks], bq[ks], S[mt]);
                }
            }
            float mx = -1e30f;
#pragma unroll
            for (int mt = 0; mt < 2; ++mt)
#pragma unroll
                for (int i = 0; i < 16; ++i) mx = fmaxf(mx, S[mt][i]);
            mx = fmaxf(mx, __shfl_xor(mx, 32)) * sc2;
            if (!__all(mx <= mrow[nt] + 8.0f)) {
                const float mn = fmaxf(mrow[nt], mx), alpha = fexp2(mrow[nt] - mn);
                mrow[nt] = mn; lrow[nt] *= alpha;
#pragma unroll
                for (int dt = 0; dt < 2; ++dt)
#pragma unroll
                    for (int i = 0; i < 16; ++i) O[dt][nt][i] *= alpha;
            }
            const float mnew = mrow[nt];
#pragma unroll
            for (int mt = 0; mt < 2; ++mt) {
                const unsigned w = wm[nt][mt];
                float p[16];
#pragma unroll
                for (int i = 0; i < 16; ++i) { const int kl = (i & 3) + 8 * (i >> 2);
                    const float e = fexp2(S[mt][i] * sc2 - mnew); unsigned mk_; asm("v_bfe_i32 %0, %1, %2, 1" : "=v"(mk_) : "v"(w), "n"(kl));
                    p[i] = __builtin_bit_cast(float, __builtin_bit_cast(unsigned, e) & mk_); lrow[nt] += p[i]; }
#pragma unroll
                for (int half = 0; half < 2; ++half) {
                    const bf16x8 pb = pack8(p[8 * half + 0], p[8 * half + 1], p[8 * half + 2], p[8 * half + 3], p[8 * half + 4], p[8 * half + 5], p[8 * half + 6], p[8 * half + 7]);
#pragma unroll
                    for (int dt = 0; dt < 2; ++dt) O[dt][nt] = mfma32(va[dt][2 * mt + half], pb, O[dt][nt]);
                }
            }
            __builtin_amdgcn_sched_barrier(0);
        }
        if (kt < j) {
            const int nb = buf ^ 1;
            *(LAS v4u*)(Ks + nb * 64 * KSTR + krow_s * KSTR + 8 * kch_s) = kreg;
            const unsigned ve[4] = {vreg.x, vreg.y, vreg.z, vreg.w};
#pragma unroll
            for (int e = 0; e < 4; ++e) { Vt[nb * 64 * VSTR + (8 * vch_s + 2 * e) * VSTR + vkey_s] = (bf16)(ve[e] & 0xffffu); Vt[nb * 64 * VSTR + (8 * vch_s + 2 * e + 1) * VSTR + vkey_s] = (bf16)(ve[e] >> 16); }
        }
        __syncthreads();
    }
#pragma unroll
    for (int nt = 0; nt < 2; ++nt) {
        const float l = lrow[nt] + __shfl_xor(lrow[nt], 32); const float inv = 1.0f / l;
        bf16* orow = YC + (rb + 64 * j + 32 * nt + c) * DM + 512 + wave * 64;
#pragma unroll
        for (int dt = 0; dt < 2; ++dt)
#pragma unroll
            for (int g4 = 0; g4 < 4; ++g4) {
                v2u w; w.x = pk2(O[dt][nt][4 * g4 + 0] * inv, O[dt][nt][4 * g4 + 1] * inv); w.y = pk2(O[dt][nt][4 * g4 + 2] * inv, O[dt][nt][4 * g4 + 3] * inv);
                *(v2u*)(orow + 32 * dt + 8 * g4 + 4 * hi) = w;
            }
    }
    __syncthreads();
    }
}

__device__ __forceinline__ void conv_unit(const Frame& F, const bf16* U, bf16* YC, const float* conv_w, const float* conv_b, const float* ln_g, const float* ln_b, int tile) {
    LAUNDER_TID();
    const int b = tile >> 5, t0 = (tile & 31) * 64, c = tid;
    const size_t rb = (size_t)b * SEQ;
    LAS bf16* Hs = (LAS bf16*)F.lds;
    LAS float* O2 = (LAS float*)(F.lds + 94 * 512 * 2);
    LAS float* ST = (LAS float*)(F.lds + 94 * 512 * 2 + 8 * 512 * 4);
    {
        v4u tmp[12];
#pragma unroll
        for (int k = 0; k < 12; ++k) { const int e = tid + 512 * k, r = e >> 6, ch = e & 63; int t = t0 - 30 + r; t = t < 0 ? 0 : t; t = t > SEQ - 1 ? SEQ - 1 : t;
            tmp[k] = *(const v4u*)(U + (rb + t) * ABP + 8 * ch); }
#pragma unroll
        for (int k = 0; k < 12; ++k) { const int e = tid + 512 * k, r = e >> 6, ch = e & 63; const bool z = (t0 - 30 + r) < 0; v4u x = tmp[k]; if (z) { x.x = 0u; x.y = 0u; x.z = 0u; x.w = 0u; }
            if (r < 94) *(LAS v4u*)(Hs + r * 512 + 8 * ch) = x; }
    }
    float w[31];
#pragma unroll
    for (int jj = 0; jj < 31; ++jj) w[jj] = conv_w[jj * 512 + c];
    const float bias = conv_b[c], lg = ln_g[c], lb = ln_b[c];
    LDS_BARRIER();
    for (int grp = 0; grp < 8; ++grp) {
        float in[38];
#pragma unroll
        for (int r = 0; r < 38; ++r) in[r] = bf2f(Hs[(8 * grp + r) * 512 + c]);
        float o[8];
#pragma unroll
        for (int tl = 0; tl < 8; ++tl) { float acc = bias;
#pragma unroll
            for (int jj = 0; jj < 31; ++jj) acc += w[jj] * in[tl + jj];
            o[tl] = acc; O2[tl * 512 + c] = acc; }
        LDS_BARRIER();
        { float s = 0.f, s2 = 0.f;
#pragma unroll
          for (int e = 0; e < 8; ++e) { const float v = O2[F.wave * 512 + lane + 64 * e]; s += v; s2 += v * v; }
          s = wave_sum(s); s2 = wave_sum(s2);
          if (lane == 0) { const float mu = s * (1.0f / 512.0f), var = fmaxf(s2 * (1.0f / 512.0f) - mu * mu, 0.f); ST[2 * F.wave] = mu; ST[2 * F.wave + 1] = rsqrtf(var + EPS); } }
        LDS_BARRIER();
        f32x4 stv[4];
#pragma unroll
        for (int k4 = 0; k4 < 4; ++k4) stv[k4] = *(const LAS f32x4*)(ST + 4 * k4);
#pragma unroll
        for (int tl = 0; tl < 8; ++tl) { const float mu = (tl & 1) ? stv[tl >> 1].z : stv[tl >> 1].x, rs = (tl & 1) ? stv[tl >> 1].w : stv[tl >> 1].y; const float y = (o[tl] - mu) * rs * lg + lb; const float ya = fsilu(y);
            YC[(rb + t0 + 8 * grp + tl) * DM + c] = (bf16)f2bf(ya); }
    }
    LDS_BARRIER();
}

constexpr int XSTR = 520;
__device__ __forceinline__ void gla_prep_unit(const Frame& F, const bf16* U1, bf16* QT, bf16* KT, bf16* KTT, float* DEC, const float* g2_w, const float* g2_b, int unit) {
    LAUNDER_TID();
    const size_t r0 = (size_t)unit * 64; const int col = tid;
    LAS bf16* XQ = (LAS bf16*)F.lds;
    LAS bf16* XK = XQ + 64 * XSTR;
    LAS float* GL = (LAS float*)(F.lds + 2 * 64 * XSTR * 2);
    {
        v4u tmp[16];
#pragma unroll
        for (int k = 0; k < 16; ++k) { const int e = tid + 512 * k; tmp[k] = *(const v4u*)(U1 + (r0 + (e >> 7)) * CP + 8 * (e & 127)); }
#pragma unroll
        for (int k = 0; k < 16; ++k) { const int e = tid + 512 * k, row = e >> 7, ch = e & 127;
            LAS bf16* dst = (ch < 64) ? (XQ + row * XSTR + 8 * ch) : (XK + row * XSTR + 8 * (ch - 64)); *(LAS v4u*)dst = tmp[k]; }
    }
    for (int e = tid; e < 1024; e += 512) GL[e] = bf2f(U1[(r0 + (e >> 4)) * CP + C_GL + (e & 15)]);
    float w[16];
#pragma unroll
    for (int r = 0; r < 16; ++r) w[r] = g2_w[r * 512 + col];
    const float bias = g2_b[col];
    LDS_BARRIER();
    float bc = 0.f;
#pragma unroll 4
    for (int t = 0; t < 64; ++t) {
        float x = bias;
#pragma unroll
        for (int r4 = 0; r4 < 4; ++r4) { const f32x4 gvv = *(const LAS f32x4*)(GL + t * 16 + 4 * r4); x += gvv.x * w[4 * r4] + gvv.y * w[4 * r4 + 1] + gvv.z * w[4 * r4 + 2] + gvv.w * w[4 * r4 + 3]; }
        const float ls = fminf(x, 0.f) - 0.69314718056f * __builtin_amdgcn_logf(1.0f + fexp(-fabsf(x)));
        bc += ls * (1.0f / 16.0f);
        const float qv = bf2f(XQ[t * XSTR + col]), kv = bf2f(XK[t * XSTR + col]);
        XQ[t * XSTR + col] = (bf16)f2bf(qv * fexp(bc) * 0.08838834764f);
        XK[t * XSTR + col] = (bf16)f2bf(kv * fexp(-bc));
    }
    DEC[(size_t)unit * 512 + col] = fexp(bc);
    LDS_BARRIER();
#pragma unroll
    for (int k = 0; k < 8; ++k) { const int e = tid + 512 * k, row = e >> 6, ch = e & 63;
        *(v4u*)(QT + (r0 + row) * 512 + 8 * ch) = *(const LAS v4u*)(XQ + row * XSTR + 8 * ch);
        *(v4u*)(KT + (r0 + row) * 512 + 8 * ch) = *(const LAS v4u*)(XK + row * XSTR + 8 * ch); }
    {
        unsigned kp[32];
#pragma unroll
        for (int t2 = 0; t2 < 32; ++t2) kp[t2] = (unsigned)XK[(2 * t2) * XSTR + col] | ((unsigned)XK[(2 * t2 + 1) * XSTR + col] << 16);
        v4u* dst = (v4u*)(KTT + ((size_t)unit * 512 + col) * 64);
#pragma unroll
        for (int k = 0; k < 8; ++k) { v4u o; o.x = kp[4 * k]; o.y = kp[4 * k + 1]; o.z = kp[4 * k + 2]; o.w = kp[4 * k + 3]; dst[k] = o; }
    }
    LDS_BARRIER();
}
constexpr int QSTR = 136, TSTR = 72;
constexpr int VNSTR = 96;
constexpr int G2_QS = 0, G2_KS = 64 * QSTR * 2, G2_KT = 2 * 64 * QSTR * 2, G2_VT = G2_KT + 128 * TSTR * 2, G2_DS = G2_VT + 64 * VNSTR * 2, G2_BUF = G2_DS + 512;
constexpr int G2_AS = G2_BUF, G2_PO = G2_AS + 64 * TSTR * 2;
static_assert(G2_PO + 65536 <= LDS_CTL, "GLA scan LDS map");
__device__ __forceinline__ void g2_step_body(const Frame& F, LAS unsigned char* bp, LAS bf16* As, LAS float* PO, f32x16& S, const bf16* QT, bf16* OB, float* GSSQ, int b, int h, int vq, int ch, int tid, int lane) {
    const int wave = F.wave, c = lane & 31, hi = lane >> 5, vt = wave & 1, dt = wave >> 1; (void)tid; (void)QT;
        const size_t r0 = (size_t)b * SEQ + 64 * ch;
        const LAS bf16* Qs = (const LAS bf16*)(bp + G2_QS); const LAS bf16* Ks = (const LAS bf16*)(bp + G2_KS); const LAS bf16* KTs = (const LAS bf16*)(bp + G2_KT);
        const LAS float* Ds = (const LAS float*)(bp + G2_DS);
        for (int n = wave; n < 10; n += 8) {
            const int it = (n >= 6) ? 3 : (n >= 3) ? 2 : (n >= 1) ? 1 : 0, jt = n - (it * (it + 1)) / 2; const int r16 = lane & 15, g = lane >> 4;
            f32x4 acc = {0.f, 0.f, 0.f, 0.f};
#pragma unroll
            for (int ks = 0; ks < 4; ++ks) acc = mfma16(*(const LAS bf16x8*)(Ks + (16 * jt + r16) * QSTR + 32 * ks + 8 * g), *(const LAS bf16x8*)(Qs + (16 * it + r16) * QSTR + 32 * ks + 8 * g), acc);
            const int i = 16 * it + r16, j0 = 16 * jt + 4 * g;
            v2u w; w.x = pk2(j0 <= i ? acc[0] : 0.f, j0 + 1 <= i ? acc[1] : 0.f); w.y = pk2(j0 + 2 <= i ? acc[2] : 0.f, j0 + 3 <= i ? acc[3] : 0.f);
            *(LAS v2u*)(As + i * TSTR + j0) = w;
        }
        LDS_BARRIER();
        f32x16 OT[2];
#pragma unroll
        for (int it = 0; it < 2; ++it)
#pragma unroll
            for (int i = 0; i < 16; ++i) OT[it][i] = 0.f;
#pragma unroll
        for (int half = 0; half < 2; ++half) {
            const bf16x8 sa = pack8(S[8 * half + 0], S[8 * half + 1], S[8 * half + 2], S[8 * half + 3], S[8 * half + 4], S[8 * half + 5], S[8 * half + 6], S[8 * half + 7]);
#pragma unroll
            for (int it = 0; it < 2; ++it) { const LAS bf16* qp = Qs + (32 * it + c) * QSTR + 32 * dt + 16 * half + 4 * hi;
                OT[it] = mfma32(sa, mk8(*(const LAS v2u*)qp, *(const LAS v2u*)(qp + 8)), OT[it]); }
        }
        bf16x8 vf[4];
        {
            const unsigned va_ = (unsigned)(__UINTPTR_TYPE__)(bp + G2_VT) + (unsigned)((8 * hi + ((lane & 15) >> 2)) * (VNSTR * 2) + (32 * vt + 16 * ((lane >> 4) & 1) + 4 * (lane & 3)) * 2);
            v2u t0_, t1_, t2_, t3_, t4_, t5_, t6_, t7_;
            asm volatile("ds_read_b64_tr_b16 %0, %8\n\tds_read_b64_tr_b16 %1, %8 offset:768\n\tds_read_b64_tr_b16 %2, %8 offset:3072\n\tds_read_b64_tr_b16 %3, %8 offset:3840\n\t"
                         "ds_read_b64_tr_b16 %4, %8 offset:6144\n\tds_read_b64_tr_b16 %5, %8 offset:6912\n\tds_read_b64_tr_b16 %6, %8 offset:9216\n\tds_read_b64_tr_b16 %7, %8 offset:9984\n\t"
                         "s_waitcnt lgkmcnt(0)"
                         : "=&v"(t0_), "=&v"(t1_), "=&v"(t2_), "=&v"(t3_), "=&v"(t4_), "=&v"(t5_), "=&v"(t6_), "=&v"(t7_) : "v"(va_) : "memory");
            vf[0] = mk8(t0_, t1_); vf[1] = mk8(t2_, t3_); vf[2] = mk8(t4_, t5_); vf[3] = mk8(t6_, t7_);
        }
        {
            const bf16x8 va = (dt == 0) ? vf[0] : (dt == 1) ? vf[1] : (dt == 2) ? vf[2] : vf[3];
#pragma unroll
            for (int it = 0; it < 2; ++it) OT[it] = mfma32(va, *(const LAS bf16x8*)(As + (32 * it + c) * TSTR + 16 * dt + 8 * hi), OT[it]);
        }
#pragma unroll
        for (int it = 0; it < 2; ++it)
#pragma unroll
            for (int i = 0; i < 16; ++i) PO[(((dt * 2 + vt) * 2 + it) * 16 + i) * 64 + lane] = OT[it][i];
        LDS_BARRIER();
        {
            const int vt2 = wave & 1, it2 = (wave >> 1) & 1, q = wave >> 2;
            float o8[8];
#pragma unroll
            for (int jx = 0; jx < 8; ++jx) { float a = 0.f;
#pragma unroll
                for (int d4 = 0; d4 < 4; ++d4) a += PO[(((d4 * 2 + vt2) * 2 + it2) * 16 + 8 * q + jx) * 64 + lane];
                o8[jx] = a; }
            float ss = 0.f;
#pragma unroll
            for (int jx = 0; jx < 8; ++jx) ss += o8[jx] * o8[jx];
            ss += __shfl_xor(ss, 32);
            const size_t tok = r0 + 32 * it2 + c;
            bf16* orow = OB + tok * DM + h * 256 + 64 * vq + 32 * vt2 + 16 * q + 4 * hi;
            v2u w0, w1; w0.x = pk2(o8[0], o8[1]); w0.y = pk2(o8[2], o8[3]); w1.x = pk2(o8[4], o8[5]); w1.y = pk2(o8[6], o8[7]);
            *(v2u*)orow = w0; *(v2u*)(orow + 8) = w1;
            if (hi == 0) GSSQ[(tok * 4 + h) * 16 + vq * 4 + vt2 * 2 + q] = ss;
        }
#pragma unroll
        for (int kk = 0; kk < 4; ++kk) S = mfma32(*(const LAS bf16x8*)(KTs + (32 * dt + c) * TSTR + 16 * kk + 8 * hi), vf[kk], S);
#pragma unroll
        for (int g4 = 0; g4 < 4; ++g4) { const f32x4 dv = *(const LAS f32x4*)(Ds + 32 * dt + 8 * g4 + 4 * hi);
            S[4 * g4 + 0] *= dv.x; S[4 * g4 + 1] *= dv.y; S[4 * g4 + 2] *= dv.z; S[4 * g4 + 3] *= dv.w; }
}
__device__ __forceinline__ void gla_scan_unit(const Frame& F, const bf16* U1, const bf16* QT, const bf16* KT, const bf16* KTT, const float* DEC, bf16* OB, float* GSSQ, int b, int h, int vq) {
    LAUNDER_TID(); const int wave = F.wave, c = lane & 31, hi = lane >> 5, vt = wave & 1, dt = wave >> 1;
    LAS bf16* As = (LAS bf16*)(F.lds + G2_AS);
    LAS float* PO = (LAS float*)(F.lds + G2_PO);
    f32x16 S;
#pragma unroll
    for (int i = 0; i < 16; ++i) S[i] = 0.f;
    for (int e = tid; e < 64 * TSTR / 2; e += 512) ((LAS unsigned*)As)[e] = 0u;
    v4u pq0[2], pk0[2], pt0[2], pv0, pq1[2], pk1[2], pt1[2], pv1, pq2[2], pk2[2], pt2[2], pv2; f32x4 pd0 = {0.f, 0.f, 0.f, 0.f}, pd1 = pd0, pd2 = pd0;
    LAS unsigned char* const bp = F.lds;
#define G2_LOAD(cidx, X) do { const size_t r0_ = (size_t)b * SEQ + 64 * (cidx); const size_t u_ = (size_t)b * 32 + (cidx); \
        _Pragma("unroll") for (int k = 0; k < 2; ++k) { const int e = tid + 512 * k; \
            pq##X[k] = *(const v4u*)(QT + (r0_ + (e >> 4)) * 512 + h * 128 + 8 * (e & 15)); \
            pk##X[k] = *(const v4u*)(KT + (r0_ + (e >> 4)) * 512 + h * 128 + 8 * (e & 15)); \
            pt##X[k] = *(const v4u*)(KTT + (u_ * 512 + h * 128 + (e >> 3)) * 64 + 8 * (e & 7)); } \
        pv##X = *(const v4u*)(U1 + (r0_ + (tid >> 3)) * CP + C_V + h * 256 + 64 * vq + 8 * (tid & 7)); \
        if (tid < 32) pd##X = *(const f32x4*)(DEC + u_ * 512 + h * 128 + 4 * tid); } while (0)
#define G2_STORE(X) do { \
        _Pragma("unroll") for (int k = 0; k < 2; ++k) { const int e = tid + 512 * k; \
            *(LAS v4u*)((LAS bf16*)(bp + G2_QS) + (e >> 4) * QSTR + 8 * (e & 15)) = pq##X[k]; \
            *(LAS v4u*)((LAS bf16*)(bp + G2_KS) + (e >> 4) * QSTR + 8 * (e & 15)) = pk##X[k]; \
            *(LAS v4u*)((LAS bf16*)(bp + G2_KT) + (e >> 3) * TSTR + 8 * (e & 7)) = pt##X[k]; } \
        *(LAS v4u*)((LAS bf16*)(bp + G2_VT) + (tid >> 3) * VNSTR + 8 * (tid & 7)) = pv##X; \
        if (tid < 32) *(LAS f32x4*)((LAS float*)(bp + G2_DS) + 4 * tid) = pd##X; } while (0)
    G2_LOAD(0, 0); G2_LOAD(1, 1); G2_LOAD(2, 2);
    G2_STORE(0);
    __syncthreads();
#define G2_STEP(CH, LX, SX) do { const int ch = (CH); if (ch < 32) { \
        if (ch + 3 < 32) G2_LOAD(ch + 3, LX); \
        g2_step_body(F, bp, As, PO, S, QT, OB, GSSQ, b, h, vq, ch, tid, lane); \
        LDS_BARRIER(); \
        if (ch + 1 < 32) G2_STORE(SX); \
        LDS_BARRIER(); } } while (0)
#pragma unroll 1
    for (int ch0 = 0; ch0 < 33; ch0 += 3) { G2_STEP(ch0, 0, 1); G2_STEP(ch0 + 1, 1, 2); G2_STEP(ch0 + 2, 2, 0); }
#undef G2_STEP
#undef G2_LOAD
#undef G2_STORE
    __syncthreads();
}
__device__ __forceinline__ void gla_norm_gate(const Frame& F, const bf16* U1, bf16* YO, const bf16* OB, const float* GSSQ, const float* onorm_g) {
    LAUNDER_TID();
    const int gw = F.vcu * NWAVES + F.wave, NGW = F.G * NWAVES;
    f32x4 gv[2][2];
#pragma unroll
    for (int jx = 0; jx < 2; ++jx) { gv[jx][0] = *((const f32x4*)onorm_g + 2 * (lane + 64 * jx)); gv[jx][1] = *((const f32x4*)onorm_g + 2 * (lane + 64 * jx) + 1); }
    for (int m0 = gw * 4; m0 < M; m0 += NGW * 4) {
        v4u ov[4][2], rv[4][2]; float rs[4][2];
#pragma unroll
        for (int q = 0; q < 4; ++q)
#pragma unroll
            for (int jx = 0; jx < 2; ++jx) {
                ov[q][jx] = *((const v4u*)(OB + (size_t)(m0 + q) * DM) + lane + 64 * jx);
                rv[q][jx] = *((const v4u*)(U1 + (size_t)(m0 + q) * CP + C_R) + lane + 64 * jx);
                rs[q][jx] = 0.f;
            }
#pragma unroll
        for (int q = 0; q < 4; ++q) {
            float ps = GSSQ[(size_t)(m0 + q) * 64 + lane];
            ps += __shfl_xor(ps, 1); ps += __shfl_xor(ps, 2); ps += __shfl_xor(ps, 4); ps += __shfl_xor(ps, 8);
#pragma unroll
            for (int jx = 0; jx < 2; ++jx) rs[q][jx] = rsqrtf(__shfl(ps, 16 * ((lane + 64 * jx) >> 5)) * (1.0f / 256.0f) + EPS);
        }
#pragma unroll
        for (int q = 0; q < 4; ++q)
#pragma unroll
            for (int jx = 0; jx < 2; ++jx) {
                const unsigned ow[4] = {ov[q][jx].x, ov[q][jx].y, ov[q][jx].z, ov[q][jx].w}, rw[4] = {rv[q][jx].x, rv[q][jx].y, rv[q][jx].z, rv[q][jx].w};
                const float gg[8] = {gv[jx][0].x, gv[jx][0].y, gv[jx][0].z, gv[jx][0].w, gv[jx][1].x, gv[jx][1].y, gv[jx][1].z, gv[jx][1].w};
                unsigned yw[4];
#pragma unroll
                for (int e = 0; e < 4; ++e) { const float o0 = bf2f(ow[e] & 0xffffu), o1 = bf2f(ow[e] >> 16), r0v = bf2f(rw[e] & 0xffffu), r1v = bf2f(rw[e] >> 16);
                    yw[e] = pk2(o0 * rs[q][jx] * gg[2 * e] * fsilu(r0v), o1 * rs[q][jx] * gg[2 * e + 1] * fsilu(r1v)); }
                v4u y; y.x = yw[0]; y.y = yw[1]; y.z = yw[2]; y.w = yw[3];
                *((v4u*)(YO + (size_t)(m0 + q) * DM) + lane + 64 * jx) = y;
            }
    }
}

__device__ __forceinline__ void final_norm(const Frame& F, const bf16* hb, float* out, const float* ssq, const float* g) {
    LAUNDER_TID();
    const int gw = F.vcu * NWAVES + F.wave, NGW = F.G * NWAVES;
    f32x4 gv[2][2];
#pragma unroll
    for (int jx = 0; jx < 2; ++jx) { gv[jx][0] = *((const f32x4*)g + 2 * (lane + 64 * jx)); gv[jx][1] = *((const f32x4*)g + 2 * (lane + 64 * jx) + 1); }
    for (int m0 = gw * 4; m0 < M; m0 += NGW * 4) {
        v4u hv[4][2]; float r[4];
#pragma unroll
        for (int q = 0; q < 4; ++q) { float ps = (lane < 16) ? ssq[(size_t)(m0 + q) * 16 + lane] : 0.f; ps = wave_sum(ps); r[q] = rsqrtf(ps * (1.0f / 1024.0f) + EPS);
#pragma unroll
            for (int jx = 0; jx < 2; ++jx) hv[q][jx] = __builtin_nontemporal_load((const v4u*)(hb + (size_t)(m0 + q) * DM) + lane + 64 * jx); }
#pragma unroll
        for (int q = 0; q < 4; ++q)
#pragma unroll
            for (int jx = 0; jx < 2; ++jx) { const v4u w = hv[q][jx]; f32x4* o = (f32x4*)(out + (size_t)(m0 + q) * DM) + 2 * (lane + 64 * jx);
                f32x4 a, b; a.x = bf2f(w.x & 0xffffu); a.y = bf2f(w.x >> 16); a.z = bf2f(w.y & 0xffffu); a.w = bf2f(w.y >> 16); b.x = bf2f(w.z & 0xffffu); b.y = bf2f(w.z >> 16); b.z = bf2f(w.w & 0xffffu); b.w = bf2f(w.w >> 16);
                __builtin_nontemporal_store(a * r[q] * gv[jx][0], o); __builtin_nontemporal_store(b * r[q] * gv[jx][1], o + 1); }
    }
}

struct Args { const float* in[18]; float* out; unsigned char* ws; int ph_lo, ph_hi; };
constexpr int N_PHASES = 16;
#ifndef REP_P0
#define REP_P0 1
#endif
#ifndef REP_DSA
#define REP_DSA 1
#endif
#ifndef REP_CONV
#define REP_CONV 1
#endif
#ifndef REP_PREP
#define REP_PREP 1
#endif
#ifndef REP_SCAN
#define REP_SCAN 1
#endif
#ifndef MK_MULTI
#define MK_MULTI 0
#endif
__global__ void __launch_bounds__(NWAVES * 64, 2) fwd(Args args) {
    extern __shared__ __attribute__((aligned(16))) unsigned char lds_raw[];
    Frame F;
    F.lds = (LAS unsigned char*)lds_raw;
    F.tid = threadIdx.x; F.lane = F.tid & 63; F.wave = __builtin_amdgcn_readfirstlane(F.tid >> 6);
    F.G = gridDim.x; { const int bx = blockIdx.x; F.vcu = (F.G % 8 == 0) ? (bx % 8) * (F.G / 8) + bx / 8 : bx; }
    unsigned char* ws = args.ws;
    volatile LAS unsigned* MISC = (volatile LAS unsigned*)(F.lds + LDS_CTL);
    for (int u = F.tid; u < (LDS_BYTES - LDS_CTL) / 4; u += NWAVES * 64) ((LAS unsigned*)(F.lds + LDS_CTL))[u] = 0u;
    __syncthreads();
    unsigned* ctl = (unsigned*)(ws + WS_CTL);
    XcdBarrier bar = xcd_barrier_post(ctl + CW_BAR, MISC + 8);
    const int lo = args.ph_lo, hi = args.ph_hi;
#define IN(k) (lo <= (k) && (k) < hi)
#define SEAM(k) do { if (lo <= (k) && (k) + 1 < hi) xcd_barrier(bar); } while (0)
    float* ssq = (float*)(ws + WS_SSQ);
    const float* rope = (const float*)(ws + WS_ROPE);
    bf16* HB = (bf16*)(ws + WS_HB); bf16* UB = (bf16*)(ws + WS_U); bf16* YC = (bf16*)(ws + WS_YC); bf16* QT = (bf16*)(ws + WS_QT); bf16* KT = (bf16*)(ws + WS_KT); bf16* KTT = (bf16*)(ws + WS_KTT);
    float* DEC = (float*)(ws + WS_DEC); float* gssq = (float*)(ws + WS_GSSQ);

    P0Args A; A.x = args.in[0]; A.mix_g = args.in[1]; A.ab_w_in = args.in[2]; A.ab_w_out = args.in[7]; A.c_w_in = args.in[8]; A.c_w_out = args.in[12];
    A.ffn_g = args.in[13]; A.w_gate = args.in[14]; A.w_up = args.in[15]; A.w_down = args.in[16]; A.ws = ws;
    if (IN(0)) {
#pragma unroll 1
        for (int rep_ = 0; rep_ < REP_P0; ++rep_) p0_prologue(F, A);
    }
    SEAM(0);
#pragma unroll 1
    for (int L = 0; L < 2; ++L) {
        const int pb = 7 * L;
        if (IN(pb + 1)) {
            const int N = L ? CP : ABP;
            pg8::Gemm g{HB, (const bf16*)(ws + (L ? WS_WIN1 : WS_WIN0)), M, N, DM}; pg8::StaticOrder S; S.init(M, N, F.G, (int)blockIdx.x);
            pg8::EpiIn E{UB, N, ssq + (size_t)(2 * L) * M * 16, rope, L == 0 ? 1 : 0};
#pragma unroll 1
            for (int rep_ = 0; rep_ < REP_IN; ++rep_) pg8::gemm_phase<pg8::EpiIn, pg8::StaticOrder, true, true>(F.lds, g, S, E);
        }
        SEAM(pb + 1);
        if (L == 0) {
            if (IN(2)) {
#pragma unroll 1
                for (int pu = F.vcu; pu < 256; pu += F.G) {
                    const int b = pu >> 4, p = pu & 15;
#pragma unroll 1
                    for (int rep = 0; rep < 2 * REP_DSA; ++rep) dsa_unit(F, UB, YC, b, (rep & 1) ? p : 31 - p); }
#pragma unroll 1
                for (int rep_ = 0; rep_ < REP_CONV; ++rep_)
                for (int tile = F.vcu; tile < 512; tile += F.G) conv_unit(F, UB, YC, args.in[3], args.in[4], args.in[5], args.in[6], tile);
            }
            SEAM(2);
        } else {
            if (IN(9)) {
#pragma unroll 1
                for (int rep_ = 0; rep_ < REP_PREP; ++rep_)
                for (int unit = F.vcu; unit < 512; unit += F.G) gla_prep_unit(F, UB, QT, KT, KTT, DEC, args.in[9], args.in[10], unit); }
            SEAM(9);
            if (IN(10)) {
#pragma unroll 1
                for (int rep_ = 0; rep_ < REP_SCAN; ++rep_)
                for (int unit = F.vcu; unit < 256; unit += F.G) gla_scan_unit(F, UB, QT, KT, KTT, DEC, YC, rep_ + 1 < REP_SCAN ? (float*)args.out : gssq, unit >> 4, (unit >> 2) & 3, unit & 3);
            }
            SEAM(10);
            if (IN(11)) {
#pragma unroll 1
                for (int rep_ = 0; rep_ < REP_G3; ++rep_) gla_norm_gate(F, UB, rep_ + 1 < REP_G3 ? QT : YC, YC, gssq, args.in[11]); }
            SEAM(11);
        }
        if (IN(pb + 5)) {
            pg8::Gemm g{YC, (const bf16*)(ws + (L ? WS_WOUT1 : WS_WOUT0)), M, DM, DM}; pg8::StaticOrder S; S.init(M, DM, F.G, (int)blockIdx.x);
            pg8::EpiRes E{HB, HB, ssq + (size_t)(2 * L + 1) * M * 16, 0};
#if REP_OUT > 1
            { pg8::EpiRes EP{HB, QT, ssq + (size_t)5 * M * 16, PROBE_PMODE}; pg8::gemm_phase<pg8::EpiRes, pg8::StaticOrder, true, true>(F.lds, g, S, EP); }
#endif
            pg8::gemm_phase<pg8::EpiRes, pg8::StaticOrder, true, true>(F.lds, g, S, E);
        }
        SEAM(pb + 5);
        if (IN(pb + 6)) {
            pg8::Gemm g{HB, (const bf16*)(ws + (L ? WS_WGU1 : WS_WGU0)), M, GU, DM}; pg8::StaticOrder S; S.init(M, GU, F.G, (int)blockIdx.x, WGM_GU);
            pg8::EpiGLU E{UB, ssq + (size_t)(2 * L + 1) * M * 16, 0};
#if REP_GU > 1
            { pg8::EpiGLU EP{UB, ssq + (size_t)(2 * L + 1) * M * 16, PROBE_PMODE}; pg8::gemm_phase<pg8::EpiGLU, pg8::StaticOrder, true, true>(F.lds, g, S, EP); }
#endif
            pg8::gemm_phase<pg8::EpiGLU, pg8::StaticOrder, true, true>(F.lds, g, S, E);
        }
        SEAM(pb + 6);
        if (IN(pb + 7)) {
            pg8::Gemm g{UB, (const bf16*)(ws + (L ? WS_WDN1 : WS_WDN0)), M, DM, DFF}; pg8::StaticOrder S; S.init(M, DM, F.G, (int)blockIdx.x);
            pg8::EpiRes E{HB, HB, ssq + (size_t)(2 * L + 2) * M * 16, 0};
#if REP_DN > 1
            { pg8::EpiRes EP{HB, QT, ssq + (size_t)5 * M * 16, PROBE_PMODE}; pg8::gemm_phase<pg8::EpiRes, pg8::StaticOrder, true, true>(F.lds, g, S, EP); }
#endif
            pg8::gemm_phase<pg8::EpiRes, pg8::StaticOrder, true, true>(F.lds, g, S, E);
        }
        SEAM(pb + 7);
    }
    if (IN(15)) final_norm(F, HB, args.out, ssq + (size_t)4 * M * 16, args.in[17]);
#undef IN
#undef SEAM
}

extern "C" void kernel_launch(void* const* d_in, const int* in_sizes, int n_in, void* d_out, int out_size, void* d_ws, size_t ws_size, hipStream_t stream) {
    static int grid = 0;
    if (grid == 0) {
        if (n_in != 18 || in_sizes[0] != M * DM || out_size != M * DM || ws_size < WS_END) { fprintf(stderr, "kernel_launch: unexpected shapes (n_in %d, in0 %d, out %d, ws %zu); nothing launched\n", n_in, n_in > 0 ? in_sizes[0] : -1, out_size, ws_size); grid = -1; return; }
        int dev = 0, cus = 0, per_cu = 0;
        if (hipGetDevice(&dev) != hipSuccess || hipDeviceGetAttribute(&cus, hipDeviceAttributeMultiprocessorCount, dev) != hipSuccess) { grid = -1; return; }
        if (hipFuncSetAttribute((const void*)fwd, hipFuncAttributeMaxDynamicSharedMemorySize, LDS_BYTES) != hipSuccess) { fprintf(stderr, "kernel_launch: hipFuncSetAttribute failed\n"); grid = -1; return; }
        if (hipOccupancyMaxActiveBlocksPerMultiprocessor(&per_cu, (const void*)fwd, NWAVES * 64, LDS_BYTES) != hipSuccess || per_cu < 1) fprintf(stderr, "kernel_launch: occupancy query reports %d\n", per_cu);
        (void)hipGetLastError();
        grid = cus;
    }
    if (grid < 0) return;
    if (hipMemsetAsync((char*)d_ws + WS_CTL, 0, CTL_ZERO_BYTES, stream) != hipSuccess) return;
    Args a{};
    for (int i = 0; i < 18; ++i) a.in[i] = (const float*)d_in[i];
    a.out = (float*)d_out; a.ws = (unsigned char*)d_ws;
#if MK_MULTI
    for (int k = 0; k < N_PHASES; ++k) { if (k == 3 || k == 4) continue; a.ph_lo = k; a.ph_hi = k + 1; hipLaunchKernelGGL(fwd, dim3(grid), dim3(NWAVES * 64), LDS_BYTES, stream, a); }
#else
    a.ph_lo = 0; a.ph_hi = N_PHASES; hipLaunchKernelGGL(fwd, dim3(grid), dim3(NWAVES * 64), LDS_BYTES, stream, a);
#endif
}
```

```cpp
#include <hip/hip_runtime.h>
#include <cstdio>
#include <cstdint>
#ifndef REP_IN
#define REP_IN 1
#endif
#ifndef REP_GU
#define REP_GU 1
#endif
#ifndef REP_DSA12
#define REP_DSA12 1
#endif
#ifndef REP_DSA3
#define REP_DSA3 1
#endif
#ifndef REP_DSA1
#define REP_DSA1 1
#endif
#ifndef REP_DSA2
#define REP_DSA2 1
#endif
#ifndef REP_OUT
#define REP_OUT 1
#endif
#ifndef REP_DN
#define REP_DN 1
#endif
#ifndef REP_G3
#define REP_G3 1
#endif
#ifndef PROBE_PMODE
#define PROBE_PMODE 0
#endif
#ifndef WGM_GU
#define WGM_GU 8
#endif
namespace pg8 {
#define PG8_LAS __attribute__((address_space(3)))
typedef unsigned short bf16_t;
typedef short bf16x8 __attribute__((ext_vector_type(8)));
typedef float f32x4 __attribute__((ext_vector_type(4)));
typedef unsigned u32x4 __attribute__((ext_vector_type(4)));
constexpr int BM = 256, BK = 64, HALF = 128, HTB = HALF * BK * 2  , STAGE_BYTES = 8 * HTB, NXCD = 8, WGM = 8;

__host__ __device__ __forceinline__ int lds_byte(int r, int c) { const int st = (r >> 4) * 2 + (c >> 5), rr = r & 15, cc = c & 31, ob = rr * 64 + cc * 2; return st * 1024 + (ob ^ (((ob >> 9) & 1) << 5)); }
__host__ __device__ __forceinline__ void stage_rc(int b, int& R, int& C) { const int st = b / 1024, sb = b % 1024, swz = sb ^ (((sb >> 9) & 1) << 5); R = (st >> 1) * 16 + swz / 64; C = (st & 1) * 32 + (swz % 64) / 2; }
__host__ __device__ __forceinline__ int perm32(int rho) { const int n = rho >> 4, i = rho & 15; return 8 * (i >> 2) + 4 * n + (i & 3); }

struct Unit { int pm, pn; };
struct Gemm { const bf16_t* A; const bf16_t* Bt; int M, N, K; };

struct StaticOrder {
    int nM, nN, nwg, G, c, wgm;
    __host__ __device__ void init(int M, int N, int G_, int c_, int wgm_ = WGM) { nM = M / BM; nN = N / BM; nwg = nM * nN; G = G_; c = c_; wgm = wgm_; }
    __host__ __device__ bool next(int i, Unit& u) const {
        const long L = (long)i * G + c; if (L >= nwg) return false;
        int wgid = (int)L; { const int q = nwg / NXCD, r = nwg % NXCD, xcd = wgid % NXCD, off = wgid / NXCD; wgid = (xcd < r ? xcd * (q + 1) : r * (q + 1) + (xcd - r) * q) + off; }
        const int nig = wgm * nN, gid = wgid / nig, fm = gid * wgm, gsz = (nM - fm) < wgm ? (nM - fm) : wgm;
        u.pm = fm + ((wgid % nig) % gsz); u.pn = (wgid % nig) / gsz; return true;
    }
    __device__ __forceinline__ void a_ready(const Unit&) const {}
    __device__ __forceinline__ void done(const Unit&) const {}
};

__device__ __forceinline__ unsigned cvt_pk_bf16(float lo, float hi) { unsigned r; asm volatile("v_cvt_pk_bf16_f32 %0, %1, %2" : "=v"(r) : "v"(lo), "v"(hi)); return r; }
typedef float f32x2 __attribute__((ext_vector_type(2)));
typedef unsigned u32x2 __attribute__((ext_vector_type(2)));
constexpr float RMS_EPS = 1e-6f;
struct EpiIn {
    static constexpr bool PERM = true, AFTER_DRAIN = false, PREF = true; static constexpr bool HS = false;
    bf16_t* O; int ldc; const float* ssq; const float* rope; int do_rope;
    __device__ __forceinline__ void pref(const Unit& u, int wr, int lane, float& p0, float& p1) const { const f32x4* s = (const f32x4*)(ssq + (size_t)(u.pm * BM + wr * 64 + lane) * 16);
        const f32x4 a0 = s[0], a1 = s[1], a2 = s[2], a3 = s[3], b0 = s[4 * HALF], b1 = s[4 * HALF + 1], b2 = s[4 * HALF + 2], b3 = s[4 * HALF + 3];
        const f32x4 sa = (a0 + a1) + (a2 + a3), sb = (b0 + b1) + (b2 + b3); p0 = (sa.x + sa.y) + (sa.z + sa.w); p1 = (sb.x + sb.y) + (sb.z + sb.w); }
    __device__ __forceinline__ void operator()(const f32x4 (&acc)[2][2][4][2], const Unit& u, int wr, int wc, int fr, int fq, float p0, float p1) const {
        const int row0 = u.pm * BM + wr * 64 + fr, cg0 = u.pn * BM + wc * 32;
#pragma unroll
        for (int ai = 0; ai < 2; ++ai)
#pragma unroll
            for (int m = 0; m < 4; ++m) {
                const int row = row0 + ai * HALF + m * 16;
                const float r = rsqrtf(__shfl(ai ? p1 : p0, fr + 16 * m) * (1.0f / 1024.0f) + RMS_EPS);
                bf16_t* rowp = O + (size_t)row * ldc + cg0 + 8 * fq;
                if (do_rope && u.pn < 4) {
                    float hh[8];
#pragma unroll
                    for (int n = 0; n < 2; ++n)
#pragma unroll
                        for (int e2 = 0; e2 < 4; ++e2) { const float a = acc[ai][0][m][n][e2] * r, g = acc[ai][1][m][n][e2] * r; hh[4 * n + e2] = a * __builtin_amdgcn_rcpf(1.0f + __expf(-g)); }
                    u32x4 w; w.x = cvt_pk_bf16(hh[0], hh[1]); w.y = cvt_pk_bf16(hh[2], hh[3]); w.z = cvt_pk_bf16(hh[4], hh[5]); w.w = cvt_pk_bf16(hh[6], hh[7]);
                    __builtin_nontemporal_store(w, (u32x4*)(O + (size_t)row * ldc + u.pn * HALF + wc * 32 + 8 * fq));
                    continue;
                }
#pragma unroll
                for (int bj = 0; bj < 2; ++bj) {
                    f32x4 v0 = acc[ai][bj][m][0] * r, v1 = acc[ai][bj][m][1] * r;
                    const int cg = cg0 + bj * HALF;
                    const bool rp = do_rope && ((cg & 63) == 0) && ((cg >= 1024 && cg < 1600) || (cg >= 1664 && cg < 2240));
                    if (rp) {
                        const float* cs = rope + (row & 2047) * 16;
                        const f32x4 c0 = *(const f32x4*)cs, c1 = *(const f32x4*)(cs + 4), s0 = *(const f32x4*)(cs + 8), s1 = *(const f32x4*)(cs + 12);
                        f32x4 p0, p1;
#pragma unroll
                        for (int e = 0; e < 4; ++e) { p0[e] = __shfl_xor(v0[e], 16); p1[e] = __shfl_xor(v1[e], 16); }
                        const float sg = (fq == 0) ? -1.0f : 1.0f;
                        if (fq < 2) { v0 = v0 * c0 + p0 * s0 * sg; v1 = v1 * c1 + p1 * s1 * sg; }
                    }
                    u32x4 w; w.x = cvt_pk_bf16(v0[0], v0[1]); w.y = cvt_pk_bf16(v0[2], v0[3]); w.z = cvt_pk_bf16(v1[0], v1[1]); w.w = cvt_pk_bf16(v1[2], v1[3]);
                    __builtin_nontemporal_store(w, (u32x4*)(rowp + bj * HALF));
                }
            }
    }
};
struct EpiRes {
    static constexpr bool PERM = true, AFTER_DRAIN = false, PREF = false; static constexpr bool HS = true;
    const bf16_t* hin; bf16_t* hb; float* ssq; int pmode;
    int hs_on;
    __device__ __forceinline__ void rescale(f32x4 (&acc)[2][2][4][2], int ui, int k) const {
        int t2 = threadIdx.x; asm volatile("" : "+v"(t2));
        const PG8_LAS float* T = (const PG8_LAS float*)(unsigned)(131072u + (unsigned)(((ui * 4 + k) * 256 + ((t2 >> 8) & 1) * 64 + (t2 & 15)) * 4));
#pragma unroll
        for (int ai = 0; ai < 2; ++ai)
#pragma unroll
            for (int m = 0; m < 4; ++m) { const float s = T[ai * HALF + m * 16];
#pragma unroll
                for (int bj = 0; bj < 2; ++bj)
#pragma unroll
                    for (int n = 0; n < 2; ++n) acc[ai][bj][m][n] = acc[ai][bj][m][n] * s; }
    }
    __device__ __forceinline__ void operator()(const f32x4 (&acc)[2][2][4][2], const Unit& u, int wr, int wc, int fr, int fq) const {
        const int row0 = u.pm * BM + wr * 64 + fr, col0 = u.pn * BM + wc * 32 + 8 * fq;
#pragma unroll
        for (int ai = 0; ai < 2; ++ai)
#pragma unroll
            for (int m = 0; m < 4; ++m) {
                const int row = row0 + ai * HALF + m * 16; const size_t ro = (size_t)row * 1024 + col0; float s = 0.f;
                u32x4 old[2];
#pragma unroll
                for (int bj = 0; bj < 2; ++bj) { if (pmode >= 1) old[bj] = (u32x4){0u, 0u, 0u, 0u}; else old[bj] = *(const u32x4*)(hin + ro + bj * HALF); }
#pragma unroll
                for (int bj = 0; bj < 2; ++bj) {
                    f32x4 v0 = acc[ai][bj][m][0], v1 = acc[ai][bj][m][1];
                    v0[0] += __builtin_bit_cast(float, old[bj].x << 16); v0[1] += __builtin_bit_cast(float, old[bj].x & 0xffff0000u);
                    v0[2] += __builtin_bit_cast(float, old[bj].y << 16); v0[3] += __builtin_bit_cast(float, old[bj].y & 0xffff0000u);
                    v1[0] += __builtin_bit_cast(float, old[bj].z << 16); v1[1] += __builtin_bit_cast(float, old[bj].z & 0xffff0000u);
                    v1[2] += __builtin_bit_cast(float, old[bj].w << 16); v1[3] += __builtin_bit_cast(float, old[bj].w & 0xffff0000u);
                    u32x4 w; w.x = cvt_pk_bf16(v0[0], v0[1]); w.y = cvt_pk_bf16(v0[2], v0[3]); w.z = cvt_pk_bf16(v1[0], v1[1]); w.w = cvt_pk_bf16(v1[2], v1[3]);
                    if (pmode < 3) __builtin_nontemporal_store(w, (u32x4*)(hb + ro + bj * HALF));
                    s += ((v0[0] * v0[0] + v0[1] * v0[1]) + (v0[2] * v0[2] + v0[3] * v0[3])) + ((v1[0] * v1[0] + v1[1] * v1[1]) + (v1[2] * v1[2] + v1[3] * v1[3]));
                }
                s += __shfl_xor(s, 16); s += __shfl_xor(s, 32);
                if (fq == 0 && pmode < 2) ssq[(size_t)row * 16 + u.pn * 4 + wc] = s;
                if (pmode >= 3 && s == 12345.678f) hb[ro] = 0;
                if (m & 1) asm volatile("" ::: "memory");
            }
    }
};
struct EpiGLU {
    static constexpr bool PERM = true, AFTER_DRAIN = false, PREF = true; static constexpr bool HS = false;
    bf16_t* O; const float* ssq; int pmode;
    __device__ __forceinline__ void pref(const Unit& u, int wr, int lane, float& p0, float& p1) const { const f32x4* s = (const f32x4*)(ssq + (size_t)(u.pm * BM + wr * 64 + lane) * 16);
        const f32x4 a0 = s[0], a1 = s[1], a2 = s[2], a3 = s[3], b0 = s[4 * HALF], b1 = s[4 * HALF + 1], b2 = s[4 * HALF + 2], b3 = s[4 * HALF + 3];
        const f32x4 sa = (a0 + a1) + (a2 + a3), sb = (b0 + b1) + (b2 + b3); p0 = (sa.x + sa.y) + (sa.z + sa.w); p1 = (sb.x + sb.y) + (sb.z + sb.w); }
    __device__ __forceinline__ void operator()(const f32x4 (&acc)[2][2][4][2], const Unit& u, int wr, int wc, int fr, int fq, float p0, float p1) const {
        const int row0 = u.pm * BM + wr * 64 + fr, col0 = u.pn * HALF + wc * 32 + 8 * fq;
#pragma unroll
        for (int ai = 0; ai < 2; ++ai)
#pragma unroll
            for (int m = 0; m < 4; ++m) {
                const int row = row0 + ai * HALF + m * 16;
                const float r = rsqrtf(__shfl(ai ? p1 : p0, fr + 16 * m) * (1.0f / 1024.0f) + RMS_EPS);
                float a[8];
#pragma unroll
                for (int n = 0; n < 2; ++n)
#pragma unroll
                    for (int e = 0; e < 4; ++e) { const float g = acc[ai][0][m][n][e] * r, up = acc[ai][1][m][n][e] * r;
                        a[4 * n + e] = (pmode >= 1) ? (g + up) : g * __builtin_amdgcn_rcpf(1.0f + __expf(-g)) * up; }
                u32x4 w; w.x = cvt_pk_bf16(a[0], a[1]); w.y = cvt_pk_bf16(a[2], a[3]); w.z = cvt_pk_bf16(a[4], a[5]); w.w = cvt_pk_bf16(a[6], a[7]);
                if (pmode < 2 || a[0] == 12345.678f) __builtin_nontemporal_store(w, (u32x4*)(O + (size_t)row * 2816 + col0));
            }
    }
};

template <class Epi, class Sched, bool ALIGN_EPI = false, bool SP2 = false>
__device__ __forceinline__ void gemm_phase(PG8_LAS unsigned char* lds, const Gemm g, const Sched& S, const Epi& E) {
    int tid_ = threadIdx.x; asm volatile("" : "+v"(tid_));
    const int tid = tid_, wid = __builtin_amdgcn_readfirstlane(tid >> 6), lane = tid & 63, wr = wid >> 2, wc = wid & 3, fr = lane & 15, fq = lane >> 4;
    const int K = g.K, nt = K / BK;
    unsigned voffA[2], voffB[2];
#pragma unroll
    for (int i = 0; i < 2; ++i) { int R, C; stage_rc(tid * 16 + i * 8192, R, C); const int Rb = Epi::PERM ? ((R & ~31) + perm32(R & 31)) : R;
        voffA[i] = (unsigned)(R * K + C) * 2u; voffB[i] = (unsigned)(Rb * K + C) * 2u; }
    const size_t kstep = (size_t)(BK * 2);
    const size_t hstep = (size_t)HALF * K * 2;
    const size_t tstep = 2 * hstep;
    const unsigned ldsw = (unsigned)wid * 1024u;
    const int aoff = lds_byte(wr * 64 + fr, fq * 8), boff = lds_byte(wc * 32 + fr, fq * 8);
#define PG8_SA(b, h) (((b) * 2 + (h)) * HTB)
#define PG8_SB(b, h) ((4 + (b) * 2 + (h)) * HTB)
#define PG8_STAGE(bufoff, gbase, voff) do { _Pragma("unroll") for (int _i = 0; _i < 2; ++_i) \
        __builtin_amdgcn_global_load_lds((const unsigned*)((const char*)(gbase) + (voff)[_i]), (PG8_LAS unsigned*)(lds + (bufoff) + ldsw + _i * 8192), 16, 0, 0); } while (0)
#define PG8_LDA(dst, b, h) do { _Pragma("unroll") for (int m = 0; m < 4; ++m) _Pragma("unroll") for (int k = 0; k < 2; ++k) dst[m][k] = *(const PG8_LAS bf16x8*)(lds + PG8_SA(b, h) + aoff + m * 2048 + k * 1024); } while (0)
#define PG8_LDB(dst, b, h) do { _Pragma("unroll") for (int n = 0; n < 2; ++n) _Pragma("unroll") for (int k = 0; k < 2; ++k) dst[n][k] = *(const PG8_LAS bf16x8*)(lds + PG8_SB(b, h) + boff + n * 2048 + k * 1024); } while (0)
#define PG8_MMA(ai, bj, At, Bt) do { __builtin_amdgcn_s_setprio(1); _Pragma("unroll") for (int m = 0; m < 4; ++m) _Pragma("unroll") for (int n = 0; n < 2; ++n) _Pragma("unroll") for (int k = 0; k < 2; ++k) \
        acc[ai][bj][m][n] = __builtin_amdgcn_mfma_f32_16x16x32_bf16(Bt[n][k], At[m][k], acc[ai][bj][m][n], 0, 0, 0); __builtin_amdgcn_s_setprio(0); } while (0)
#define PG8_WAIT_V(n) asm volatile("s_waitcnt vmcnt(" #n ")" ::: "memory")
#define PG8_WAIT_L(n) asm volatile("s_waitcnt lgkmcnt(" #n ")" ::: "memory")
#define PG8_BAR __builtin_amdgcn_s_barrier()
#define PG8_SCHED __builtin_amdgcn_sched_barrier(0)
    Unit cur, nxt; int ui = 0;
    if (!S.next(0, cur)) return;
    f32x4 acc[2][2][4][2];
#pragma unroll
    for (int a = 0; a < 2; ++a)
#pragma unroll
        for (int b = 0; b < 2; ++b)
#pragma unroll
            for (int m = 0; m < 4; ++m)
#pragma unroll
                for (int n = 0; n < 2; ++n) acc[a][b][m][n] = (f32x4){0.f, 0.f, 0.f, 0.f};
    bf16x8 At[4][2], B0[2][2], B1[2][2];
    const char* cA = (const char*)g.A + (size_t)cur.pm * tstep; const char* cB = (const char*)g.Bt + (size_t)cur.pn * tstep;
    float pf0 = 0.f, pf1 = 0.f;
    if constexpr (Epi::PREF) E.pref(cur, wr, lane, pf0, pf1);
    S.a_ready(cur);
    if constexpr (SP2) {
        PG8_STAGE(PG8_SB(0, 0), cB, voffB); PG8_STAGE(PG8_SB(0, 1), cB + hstep, voffB); PG8_STAGE(PG8_SA(0, 0), cA, voffA); PG8_STAGE(PG8_SA(0, 1), cA + hstep, voffA);
        if (wr == 1) PG8_BAR;
        PG8_WAIT_V(2); PG8_BAR;
        PG8_STAGE(PG8_SB(1, 0), cB + kstep, voffB); PG8_STAGE(PG8_SA(1, 0), cA + kstep, voffA); PG8_STAGE(PG8_SB(1, 1), cB + hstep + kstep, voffB);
        PG8_WAIT_V(6); PG8_BAR;
    } else {
        PG8_STAGE(PG8_SB(0, 0), cB, voffB); PG8_STAGE(PG8_SA(0, 0), cA, voffA); PG8_STAGE(PG8_SB(0, 1), cB + hstep, voffB); PG8_STAGE(PG8_SA(0, 1), cA + hstep, voffA);
        if (wr == 1) PG8_BAR;
        PG8_WAIT_V(4); PG8_BAR;
        PG8_STAGE(PG8_SB(1, 0), cB + kstep, voffB); PG8_STAGE(PG8_SA(1, 0), cA + kstep, voffA); PG8_STAGE(PG8_SB(1, 1), cB + hstep + kstep, voffB);
        PG8_WAIT_V(6); PG8_BAR;
    }
    for (;;) {
        const bool has_next = S.next(ui + 1, nxt);
        const char* nA = has_next ? (const char*)g.A + (size_t)nxt.pm * tstep : cA; const char* nB = has_next ? (const char*)g.Bt + (size_t)nxt.pn * tstep : cB;
        int tseg = nt; if constexpr (Epi::HS) { if (E.hs_on) tseg = 4; }
#pragma unroll 1
        for (int t0 = 0; t0 < nt; t0 += tseg) {
        if constexpr (Epi::HS) { if (t0 != 0) E.rescale(acc, ui & 3, (t0 >> 2) - 1); }
#pragma unroll 1
        for (int t = t0; t < t0 + tseg; t += 2) {
            const bool last = (t == nt - 2);
            const char* a1 = cA + (size_t)(t + 1) * kstep;
            const char* a2 = last ? nA : cA + (size_t)(t + 2) * kstep; const char* b2 = last ? nB : cB + (size_t)(t + 2) * kstep;
            const char* a3 = a2 + kstep; const char* b3 = b2 + kstep;
            if (last && has_next) S.a_ready(nxt);
            if constexpr (SP2) {
            PG8_LDB(B0, 0, 0); PG8_LDB(B1, 0, 1); PG8_SCHED; PG8_LDA(At, 0, 0); PG8_STAGE(PG8_SA(1, 1), a1 + hstep, voffA);
            PG8_WAIT_V(8); PG8_WAIT_L(0); PG8_BAR; PG8_MMA(0, 0, At, B0); PG8_MMA(0, 1, At, B1); PG8_BAR; PG8_SCHED;
            PG8_LDA(At, 0, 1); PG8_STAGE(PG8_SB(0, 0), b2, voffB); PG8_STAGE(PG8_SB(0, 1), b2 + hstep, voffB); PG8_STAGE(PG8_SA(0, 0), a2, voffA);
            PG8_WAIT_V(8); PG8_WAIT_L(0); PG8_BAR; PG8_MMA(1, 0, At, B0); PG8_MMA(1, 1, At, B1); PG8_BAR; PG8_SCHED;
            PG8_LDB(B0, 1, 0); PG8_LDB(B1, 1, 1); PG8_SCHED; PG8_LDA(At, 1, 0); PG8_STAGE(PG8_SA(0, 1), a2 + hstep, voffA);
            PG8_WAIT_V(8); PG8_WAIT_L(0); PG8_BAR; PG8_MMA(0, 0, At, B0); PG8_MMA(0, 1, At, B1); PG8_BAR; PG8_SCHED;
            PG8_LDA(At, 1, 1); PG8_STAGE(PG8_SB(1, 0), b3, voffB); PG8_STAGE(PG8_SB(1, 1), b3 + hstep, voffB); PG8_STAGE(PG8_SA(1, 0), a3, voffA);
            PG8_WAIT_V(8); PG8_WAIT_L(0); PG8_BAR; PG8_MMA(1, 0, At, B0); PG8_MMA(1, 1, At, B1); PG8_BAR; PG8_SCHED;
            } else {
            PG8_LDB(B0, 0, 0); PG8_SCHED; PG8_LDA(At, 0, 0); PG8_STAGE(PG8_SA(1, 1), a1 + hstep, voffA);
            PG8_WAIT_L(8); PG8_BAR; PG8_WAIT_L(0); PG8_MMA(0, 0, At, B0); PG8_BAR; PG8_SCHED;
            PG8_LDB(B1, 0, 1); PG8_STAGE(PG8_SB(0, 0), b2, voffB);
            PG8_BAR; PG8_WAIT_L(0); PG8_MMA(0, 1, At, B1); PG8_BAR;
            PG8_LDA(At, 0, 1); PG8_STAGE(PG8_SA(0, 0), a2, voffA);
            PG8_BAR; PG8_WAIT_L(0); PG8_MMA(1, 0, At, B0); PG8_BAR; PG8_SCHED;
            PG8_STAGE(PG8_SB(0, 1), b2 + hstep, voffB);
            PG8_WAIT_V(6); PG8_BAR; PG8_MMA(1, 1, At, B1); PG8_BAR;
            PG8_LDB(B0, 1, 0); PG8_SCHED; PG8_LDA(At, 1, 0); PG8_STAGE(PG8_SA(0, 1), a2 + hstep, voffA);
            PG8_WAIT_L(8); PG8_BAR; PG8_WAIT_L(0); PG8_MMA(0, 0, At, B0); PG8_BAR; PG8_SCHED;
            PG8_LDB(B1, 1, 1); PG8_STAGE(PG8_SB(1, 0), b3, voffB);
            PG8_BAR; PG8_WAIT_L(0); PG8_MMA(0, 1, At, B1); PG8_BAR;
            PG8_LDA(At, 1, 1); PG8_STAGE(PG8_SA(1, 0), a3, voffA);
            PG8_BAR; PG8_WAIT_L(0); PG8_MMA(1, 0, At, B0); PG8_BAR; PG8_SCHED;
            PG8_STAGE(PG8_SB(1, 1), b3 + hstep, voffB);
            PG8_WAIT_V(6); PG8_BAR; PG8_MMA(1, 1, At, B1); PG8_BAR;
            }
        }
        }
        if constexpr (ALIGN_EPI) { if (wr == 0) PG8_BAR; }
        if constexpr (Epi::HS) { if (E.hs_on) E.rescale(acc, ui & 3, 3); }
        if constexpr (!Epi::AFTER_DRAIN) { if constexpr (Epi::PREF) { E(acc, cur, wr, wc, fr, fq, pf0, pf1); if (has_next) E.pref(nxt, wr, lane, pf0, pf1); } else E(acc, cur, wr, wc, fr, fq); S.done(cur); }
        if (!has_next) break;
#pragma unroll
        for (int a = 0; a < 2; ++a)
#pragma unroll
            for (int b = 0; b < 2; ++b)
#pragma unroll
                for (int m = 0; m < 4; ++m)
#pragma unroll
                    for (int n = 0; n < 2; ++n) acc[a][b][m][n] = (f32x4){0.f, 0.f, 0.f, 0.f};
        cur = nxt; cA = nA; cB = nB; ++ui;
        if constexpr (ALIGN_EPI) { if (wr == 1) PG8_BAR; }
    }
    PG8_WAIT_V(0);
    if constexpr (!ALIGN_EPI) { if (wr == 0) PG8_BAR; }
    PG8_BAR;
    if constexpr (Epi::AFTER_DRAIN) { E.fused(acc, cur, wr, wc, fr, fq, lds, wid, lane); S.done(cur); }
#undef PG8_SA
#undef PG8_SB
#undef PG8_STAGE
#undef PG8_LDA
#undef PG8_LDB
#undef PG8_MMA
#undef PG8_WAIT_V
#undef PG8_WAIT_L
#undef PG8_BAR
#undef PG8_SCHED
}
}
constexpr int NWAVES = 8;
constexpr int NB = 16, SEQ = 2048, DM = 1024, M = NB * SEQ;
constexpr int ABN = 2248, ABP = 2304, CN = 3088, CP = 3328, DFF = 2816, GU = 2 * DFF;
constexpr int AB_G = 512, AB_Q = 1024, AB_K = 1536, AB_V = 1600, AB_IQ = 1664, AB_IK = 2176, AB_IW = 2240;
constexpr int C_K = 512, C_V = 1024, C_R = 2048, C_GL = 3072;
constexpr float EPS = 1e-6f;
constexpr size_t MiB = 1u << 20;
constexpr size_t WS_CTL = 0, CTL_ZERO_BYTES = 1 * MiB;
constexpr size_t WS_ROPE = 5 * MiB / 2, WS_DEC = 3 * MiB;
constexpr size_t WS_WIN0 = 4 * MiB, WS_WIN1 = WS_WIN0 + (size_t)ABP * DM * 2, WS_WOUT0 = WS_WIN1 + (size_t)CP * DM * 2, WS_WOUT1 = WS_WOUT0 + 2 * MiB;
constexpr size_t WS_WGU0 = WS_WOUT1 + 2 * MiB, WS_WGU1 = WS_WGU0 + (size_t)GU * DM * 2, WS_WDN0 = WS_WGU1 + (size_t)GU * DM * 2, WS_WDN1 = WS_WDN0 + (size_t)DM * DFF * 2;
constexpr size_t WS_HB = 52 * MiB, WS_U = 116 * MiB, WS_YC = 324 * MiB, WS_QT = 388 * MiB, WS_KT = 420 * MiB, WS_KTT = 452 * MiB, WS_SSQ = 484 * MiB, WS_GSSQ = 496 * MiB, WS_END = 504 * MiB;
static_assert(WS_WDN1 + (size_t)DM * DFF * 2 <= WS_HB && WS_HB + (size_t)M * DM * 2 <= WS_U && WS_U + (size_t)M * CP * 2 <= WS_YC && WS_YC + (size_t)M * DM * 2 <= WS_QT && WS_QT + (size_t)M * 512 * 2 <= WS_KT && WS_KT + (size_t)M * 512 * 2 <= WS_KTT && WS_KTT + (size_t)M * 512 * 2 <= WS_SSQ && WS_SSQ + (size_t)6 * M * 64 <= WS_GSSQ && WS_GSSQ + (size_t)M * 256 <= WS_END, "d_ws map");
constexpr int CW_BAR = 4096;
constexpr int SC_STRIDE = 2064;
constexpr int LDS_BM = 16 * SC_STRIDE * 4;
constexpr int LDS_CTL = LDS_BM + 16384;
constexpr int LDS_BYTES = LDS_CTL + 1024;
#define GAS __attribute__((address_space(1)))
#define LAS __attribute__((address_space(3)))
typedef unsigned short bf16;
typedef unsigned v4u __attribute__((ext_vector_type(4)));
typedef unsigned v2u __attribute__((ext_vector_type(2)));
typedef float f32x4 __attribute__((ext_vector_type(4)));
typedef float f32x16 __attribute__((ext_vector_type(16)));
typedef short bf16x8 __attribute__((ext_vector_type(8)));
#define LDS_WAIT() asm volatile("s_waitcnt lgkmcnt(0)" ::: "memory")
#define LDS_BARRIER() do { asm volatile("s_waitcnt lgkmcnt(0)" ::: "memory"); __builtin_amdgcn_s_barrier(); asm volatile("" ::: "memory"); } while (0)
typedef __bf16 bf16pair_t __attribute__((ext_vector_type(2)));
__device__ __forceinline__ unsigned pk2(float lo, float hi) { bf16pair_t v; v.x = (__bf16)lo; v.y = (__bf16)hi; return __builtin_bit_cast(unsigned, v); }
__device__ __forceinline__ unsigned f2bf(float f) { return pk2(f, 0.f) & 0xffffu; }
__device__ __forceinline__ float fexp2(float x) { return __builtin_amdgcn_exp2f(x); }
__device__ __forceinline__ float fexp(float x) { return __builtin_amdgcn_exp2f(x * 1.44269504089f); }
__device__ __forceinline__ float frcp(float x) { return __builtin_amdgcn_rcpf(x); }
__device__ __forceinline__ float fsilu(float x) { return x * __builtin_amdgcn_rcpf(1.0f + __builtin_amdgcn_exp2f(-1.44269504089f * x)); }
__device__ __forceinline__ float bf2f(unsigned b) { return __builtin_bit_cast(float, b << 16); }
__device__ __forceinline__ float wave_sum(float v) {
#pragma unroll
    for (int o = 1; o < 64; o <<= 1) v += __shfl_xor(v, o);
    return v;
}
__device__ __forceinline__ int wave_isum(int v) {
    v += __builtin_amdgcn_update_dpp(0, v, 0xB1, 0xf, 0xf, false);
    v += __builtin_amdgcn_update_dpp(0, v, 0x4E, 0xf, 0xf, false);
    v += __builtin_amdgcn_update_dpp(0, v, 0x141, 0xf, 0xf, false);
    v += __builtin_amdgcn_update_dpp(0, v, 0x140, 0xf, 0xf, false);
    v += __builtin_amdgcn_update_dpp(0, v, 0x142, 0xa, 0xf, false);
    v += __builtin_amdgcn_update_dpp(0, v, 0x143, 0xc, 0xf, false);
    return __builtin_amdgcn_readlane(v, 63);
}
__device__ __forceinline__ float wave_fsum(float v) {
#define DPPZ(v, ctl, rmask) __builtin_bit_cast(float, __builtin_amdgcn_update_dpp(0, __builtin_bit_cast(int, v), ctl, rmask, 0xf, false))
    v += DPPZ(v, 0xB1, 0xf); v += DPPZ(v, 0x4E, 0xf); v += DPPZ(v, 0x141, 0xf); v += DPPZ(v, 0x140, 0xf); v += DPPZ(v, 0x142, 0xa); v += DPPZ(v, 0x143, 0xc);
#undef DPPZ
    return __builtin_bit_cast(float, __builtin_amdgcn_readlane(__builtin_bit_cast(int, v), 63));
}
#define DPPF(v, ctl, rmask) __builtin_bit_cast(float, __builtin_amdgcn_update_dpp(__builtin_bit_cast(int, v), __builtin_bit_cast(int, v), ctl, rmask, 0xf, false))
__device__ __forceinline__ float wave_fmax(float v) {
    v = fmaxf(v, DPPF(v, 0xB1, 0xf)); v = fmaxf(v, DPPF(v, 0x4E, 0xf)); v = fmaxf(v, DPPF(v, 0x141, 0xf)); v = fmaxf(v, DPPF(v, 0x140, 0xf));
    v = fmaxf(v, DPPF(v, 0x142, 0xa)); v = fmaxf(v, DPPF(v, 0x143, 0xc));
    return __builtin_bit_cast(float, __builtin_amdgcn_readlane(__builtin_bit_cast(int, v), 63));
}
__device__ __forceinline__ float wave_fmin(float v) {
    v = fminf(v, DPPF(v, 0xB1, 0xf)); v = fminf(v, DPPF(v, 0x4E, 0xf)); v = fminf(v, DPPF(v, 0x141, 0xf)); v = fminf(v, DPPF(v, 0x140, 0xf));
    v = fminf(v, DPPF(v, 0x142, 0xa)); v = fminf(v, DPPF(v, 0x143, 0xc));
    return __builtin_bit_cast(float, __builtin_amdgcn_readlane(__builtin_bit_cast(int, v), 63));
}
__device__ __forceinline__ f32x4 mfma16(bf16x8 a, bf16x8 b, f32x4 c) { return __builtin_amdgcn_mfma_f32_16x16x32_bf16(a, b, c, 0, 0, 0); }
__device__ __forceinline__ f32x16 mfma32(bf16x8 a, bf16x8 b, f32x16 c) { return __builtin_amdgcn_mfma_f32_32x32x16_bf16(a, b, c, 0, 0, 0); }
__device__ __forceinline__ bf16x8 mk8(v2u lo, v2u hi) { v4u t; t.x = lo.x; t.y = lo.y; t.z = hi.x; t.w = hi.y; return __builtin_bit_cast(bf16x8, t); }
__device__ __forceinline__ bf16x8 pack8(float a0, float a1, float a2, float a3, float a4, float a5, float a6, float a7) {
    v4u t; t.x = pk2(a0, a1); t.y = pk2(a2, a3); t.z = pk2(a4, a5); t.w = pk2(a6, a7); return __builtin_bit_cast(bf16x8, t); }

#define XB_TMO      128
#define XB_XCNT(j)  (256  + 64 * (j))
#define XB_XSUB(j)  (1280 + 64 * (j))
#define XB_XGEN(j)  (2304 + 64 * (j))
#define XB_TOP      3328
#define XB_TOPGEN   3392
#define XCD_BAR_WORDS 3456
#define XB_SPIN_CAP (1u << 18)

__device__ __forceinline__ unsigned xb_ld(unsigned* p)              { return __hip_atomic_load(p, __ATOMIC_RELAXED, __HIP_MEMORY_SCOPE_AGENT); }
__device__ __forceinline__ unsigned xb_add(unsigned* p, unsigned v) { return __hip_atomic_fetch_add(p, v, __ATOMIC_RELAXED, __HIP_MEMORY_SCOPE_AGENT); }
__device__ __forceinline__ unsigned xb_xcc_id() { return (unsigned)__builtin_amdgcn_s_getreg((3 << 11) | 20) & 0xFu; }
#define XB_SPIN(cond, bar) do { unsigned _sp = 0; while (cond) { __builtin_amdgcn_s_sleep(1); \
    if ((++_sp & 255u) == 0u) { if (xb_ld(&(bar)[XB_TMO])) break; if (_sp > XB_SPIN_CAP) { atomicAdd(&(bar)[XB_TMO], 1u); break; } } } } while (0)

struct XcdBarrier {
    unsigned* bar; unsigned x;
    volatile LAS unsigned* st;
};

__device__ __forceinline__ XcdBarrier xcd_barrier_post(unsigned* bar, volatile LAS unsigned* st) {
    XcdBarrier b; b.bar = bar; b.x = xb_xcc_id(); b.st = st;
    if (threadIdx.x == 0) (void)xb_add(&bar[XB_XCNT(b.x)], 1u);
    return b;
}
__device__ __forceinline__ void xcd_barrier_complete(unsigned* bar, unsigned x, unsigned& nloc, unsigned& nx) {
    const unsigned G = gridDim.x * gridDim.y * gridDim.z;
    unsigned sum, cnt, mine, sp = 0u;
    for (;;) {
        sum = 0u; cnt = 0u; mine = 0u;
#pragma unroll
        for (unsigned j = 0; j < 16; ++j) { const unsigned c = xb_ld(&bar[XB_XCNT(j)]); sum += c; cnt += (c > 0u) ? 1u : 0u; mine = (j == x) ? c : mine; }
        if (sum == G) break;
        __builtin_amdgcn_s_sleep(1);
        if ((++sp & 255u) == 0u) { if (xb_ld(&bar[XB_TMO])) break; if (sp > XB_SPIN_CAP) { atomicAdd(&bar[XB_TMO], 1u); break; } }
    }
    nloc = mine > 0u ? mine : 1u; nx = cnt > 0u ? cnt : 1u;
}

__device__ __forceinline__ void xcd_barrier(const XcdBarrier& b) {
    asm volatile("s_waitcnt vmcnt(0)" ::: "memory");
    __syncthreads();
    if (threadIdx.x == 0) {
        unsigned* bar = b.bar;
        __builtin_amdgcn_s_waitcnt(0);
        unsigned nloc = b.st[0], nx = b.st[1];
        if (nloc == 0u) { xcd_barrier_complete(bar, b.x, nloc, nx); b.st[0] = nloc; b.st[1] = nx; }
        const unsigned old = xb_add(&bar[XB_XSUB(b.x)], 1u);
        const unsigned gen = old / nloc;
        if (old + 1u == (gen + 1u) * nloc) {
            __builtin_amdgcn_fence(__ATOMIC_RELEASE, "agent");
            asm volatile("s_waitcnt vmcnt(0)" ::: "memory");
            const unsigned og = xb_add(&bar[XB_TOP], 1u);
            const unsigned tg = og / nx;
            if (og + 1u == (tg + 1u) * nx) xb_add(&bar[XB_TOPGEN], 1u);
            else XB_SPIN(xb_ld(&bar[XB_TOPGEN]) == tg, bar);
            __builtin_amdgcn_fence(__ATOMIC_ACQUIRE, "agent");
            xb_add(&bar[XB_XGEN(b.x)], 1u);
            asm volatile("s_waitcnt vmcnt(0)" ::: "memory");
        } else {
            XB_SPIN(xb_ld(&bar[XB_XGEN(b.x)]) == gen, bar);
            __builtin_amdgcn_fence(__ATOMIC_ACQUIRE, "agent");
            asm volatile("s_waitcnt vmcnt(0)" ::: "memory");
        }
    }
    __syncthreads();
}

struct Frame { LAS unsigned char* lds; int tid, lane, wave, vcu, G; };
#define LAUNDER_TID() int tid_l_ = threadIdx.x; asm volatile("" : "+v"(tid_l_)); const int tid = tid_l_, lane = tid & 63; (void)tid; (void)lane

__device__ __forceinline__ void p0_item(const float* W, int K, int N, const float* gain, bf16* WT, int drow0, int k0, int n0, LAS float* scr, int lane) {
    const int n_ = n0 + (lane & 31), nc_ = n_ < N ? n_ : N - 1; const float keep_ = n_ < N ? 1.f : 0.f;
    {
        float v[32], gv[32];
#pragma unroll
        for (int i = 0; i < 32; ++i) v[i] = __builtin_nontemporal_load(W + (size_t)(k0 + 2 * i + (lane >> 5)) * N + nc_);
#pragma unroll
        for (int i = 0; i < 32; ++i) gv[i] = gain ? gain[k0 + 2 * i + (lane >> 5)] : 1.0f;
#pragma unroll
        for (int i = 0; i < 32; ++i) { const int kk = 2 * i + (lane >> 5); scr[kk * 33 + (lane & 31)] = v[i] * keep_ * gv[i]; }
    }
    LDS_WAIT(); asm volatile("" ::: "memory");
    const int c = lane & 7;
#pragma unroll
    for (int j = 0; j < 4; ++j) { const int n = (lane >> 3) + 8 * j; const LAS float* s = scr + (8 * c) * 33 + n;
        v4u o; o.x = pk2(s[0 * 33], s[1 * 33]); o.y = pk2(s[2 * 33], s[3 * 33]); o.z = pk2(s[4 * 33], s[5 * 33]); o.w = pk2(s[6 * 33], s[7 * 33]);
        *(v4u*)(WT + (size_t)(drow0 + n) * K + k0 + 8 * c) = o; }
    LDS_WAIT(); asm volatile("" ::: "memory");
}
struct P0Args { const float *x, *mix_g, *ab_w_in, *ab_w_out, *c_w_in, *c_w_out, *ffn_g, *w_gate, *w_up, *w_down; unsigned char* ws; };
__device__ __forceinline__ void p0_weights(const Frame& F, const P0Args& A, int it_lo, int it_hi, int gw, int NGW) {
    LAUNDER_TID();
    LAS float* scr = (LAS float*)(F.lds + F.wave * 16384);
    bf16* const win0 = (bf16*)(A.ws + WS_WIN0); bf16* const win1 = (bf16*)(A.ws + WS_WIN1); bf16* const wout0 = (bf16*)(A.ws + WS_WOUT0); bf16* const wout1 = (bf16*)(A.ws + WS_WOUT1);
    bf16* const wgu0 = (bf16*)(A.ws + WS_WGU0); bf16* const wgu1 = (bf16*)(A.ws + WS_WGU1); bf16* const wdn0 = (bf16*)(A.ws + WS_WDN0); bf16* const wdn1 = (bf16*)(A.ws + WS_WDN1);
    constexpr int I_IN0 = 16 * (ABP / 32), I_IN1 = 16 * (CP / 32), I_OUT = 16 * 32, I_GU = 16 * (DFF / 32), I_DN = (DFF / 64) * 32;
    constexpr int NITEMS = I_IN0 + I_IN1 + 2 * I_OUT + 4 * I_GU + 2 * I_DN;
    for (int it = it_lo + gw; it < (it_hi < NITEMS ? it_hi : NITEMS); it += NGW) {
        int r = it; const float* W = nullptr; const float* gain = nullptr; bf16* WT = nullptr; int K = 0, N = 0, Np = 0, mode = 0; bool found = false;
#define P0_MAT(Wp, Kv, Nv, Npv, gp, WTp, md, cnt) { if (!found) { if (r < (cnt)) { W = (Wp); K = (Kv); N = (Nv); Np = (Npv); gain = (gp); WT = (WTp); mode = (md); found = true; } else r -= (cnt); } }
        P0_MAT(A.ab_w_in, DM, ABN, ABP, A.mix_g, win0, 3, I_IN0)
        P0_MAT(A.c_w_in, DM, CN, CP, A.mix_g + DM, win1, 0, I_IN1)
        P0_MAT(A.ab_w_out, DM, DM, DM, nullptr, wout0, 0, I_OUT)
        P0_MAT(A.c_w_out, DM, DM, DM, nullptr, wout1, 0, I_OUT)
        P0_MAT(A.w_gate, DM, DFF, DFF, A.ffn_g, wgu0, 1, I_GU)
        P0_MAT(A.w_up, DM, DFF, DFF, A.ffn_g, wgu0, 2, I_GU)
        P0_MAT(A.w_gate + (size_t)DM * DFF, DM, DFF, DFF, A.ffn_g + DM, wgu1, 1, I_GU)
        P0_MAT(A.w_up + (size_t)DM * DFF, DM, DFF, DFF, A.ffn_g + DM, wgu1, 2, I_GU)
        P0_MAT(A.w_down, DFF, DM, DM, nullptr, wdn0, 0, I_DN)
        P0_MAT(A.w_down + (size_t)DFF * DM, DFF, DM, DM, nullptr, wdn1, 0, I_DN)
#undef P0_MAT
        const int nblk = Np / 32, kb = r / nblk, nb = r % nblk, n0 = 32 * nb;
        int drow0 = n0; if (mode == 1 || mode == 2) drow0 = 256 * (n0 >> 7) + (n0 & 127) + (mode == 2 ? 128 : 0);
        if (mode == 3 && n0 < 1024) { const int nn = n0 & 511; drow0 = 256 * (nn >> 7) + (nn & 127) + (n0 >= 512 ? 128 : 0); }
        p0_item(W, K, N, gain, WT, drow0, 64 * kb, n0, scr, lane);
    }
}
constexpr int P0_I_IN0 = 16 * (ABP / 32);
__device__ __forceinline__ void p0_prologue(const Frame& F, const P0Args& A) {
    LAUNDER_TID();
    const int gw = F.vcu * NWAVES + F.wave, NGW = F.G * NWAVES;
    p0_weights(F, A, 0, 1 << 30, gw, NGW);
    bf16* HB = (bf16*)(A.ws + WS_HB); float* ssq0 = (float*)(A.ws + WS_SSQ);
    for (int m0 = gw * 4; m0 < M; m0 += NGW * 4) {
        f32x4 v[4][4];
#pragma unroll
        for (int q = 0; q < 4; ++q)
#pragma unroll
            for (int j = 0; j < 4; ++j) v[q][j] = __builtin_nontemporal_load((const f32x4*)(A.x + (size_t)(m0 + q) * DM) + lane + 64 * j);
#pragma unroll
        for (int q = 0; q < 4; ++q) { float s = 0.f;
#pragma unroll
            for (int j = 0; j < 4; ++j) s += (v[q][j].x * v[q][j].x + v[q][j].y * v[q][j].y) + (v[q][j].z * v[q][j].z + v[q][j].w * v[q][j].w);
            s = wave_sum(s); if (lane < 4) *((f32x4*)(ssq0 + (size_t)(m0 + q) * 16) + lane) = (f32x4){lane == 0 ? s : 0.f, 0.f, 0.f, 0.f};
            v2u* o8 = (v2u*)(HB + (size_t)(m0 + q) * DM) + lane;
#pragma unroll
            for (int j = 0; j < 4; ++j) { v2u w; w.x = pk2(v[q][j].x, v[q][j].y); w.y = pk2(v[q][j].z, v[q][j].w); o8[64 * j] = w; } }
    }
    float* rope = (float*)(A.ws + WS_ROPE);
    for (int e = F.vcu * 512 + tid; e < SEQ * 8; e += F.G * 512) { const int t = e >> 3, i = e & 7;
        const float inv = powf(500000.0f, -(float)i * 0.125f); const float ang = (float)t * inv;
        rope[t * 16 + i] = cosf(ang); rope[t * 16 + 8 + i] = sinf(ang); }
}

__device__ __forceinline__ unsigned ordkey(float f) { const unsigned u = __builtin_bit_cast(unsigned, f); return (u & 0x80000000u) ? ~u : (u | 0x80000000u); }
#ifndef DSA_VALU_COUNT
#define DSA_VALU_COUNT 1
#endif
#define DSA_CNT8(ca, cb, cfs, b, PRE) do { unsigned long long m0_, m1_, m2_, m3_; \
    asm(PRE "v_cmp_le_f32_e64 %2, %6, %7\n\tv_cmp_le_f32_e64 %3, %6, %8\n\tv_cmp_le_f32_e64 %4, %6, %9\n\tv_cmp_le_f32_e64 %5, %6, %10\n\t" \
        "v_addc_co_u32_e64 %0, %2, 0, %0, %2\n\tv_cmp_le_f32_e64 %2, %6, %11\n\tv_addc_co_u32_e64 %1, %3, 0, %1, %3\n\tv_cmp_le_f32_e64 %3, %6, %12\n\t" \
        "v_addc_co_u32_e64 %0, %4, 0, %0, %4\n\tv_cmp_le_f32_e64 %4, %6, %13\n\tv_addc_co_u32_e64 %1, %5, 0, %1, %5\n\tv_cmp_le_f32_e64 %5, %6, %14\n\t" \
        "v_addc_co_u32_e64 %0, %2, 0, %0, %2\n\tv_addc_co_u32_e64 %1, %3, 0, %1, %3\n\tv_addc_co_u32_e64 %0, %4, 0, %0, %4\n\tv_addc_co_u32_e64 %1, %5, 0, %1, %5" \
        : "+v"(ca), "+v"(cb), "=&s"(m0_), "=&s"(m1_), "=&s"(m2_), "=&s"(m3_) : "s"(cfs), "v"(k[8 * (b) + 0]), "v"(k[8 * (b) + 1]), "v"(k[8 * (b) + 2]), "v"(k[8 * (b) + 3]), \
          "v"(k[8 * (b) + 4]), "v"(k[8 * (b) + 5]), "v"(k[8 * (b) + 6]), "v"(k[8 * (b) + 7])); } while (0)
template <int NB> __device__ __forceinline__ int dsa_count(const float (&k)[32], float cf) {
#if DSA_VALU_COUNT
    int ca = 0, cb = 0;
    DSA_CNT8(ca, cb, cf, 0, "s_nop 1\n\t");
    if (NB > 1) DSA_CNT8(ca, cb, cf, 1, "");
    if (NB > 2) DSA_CNT8(ca, cb, cf, 2, "");
    if (NB > 3) DSA_CNT8(ca, cb, cf, 3, "");
    return wave_isum(ca + cb);
#else
    int cnt = 0;
#pragma unroll
    for (int blk = 0; blk < NB; ++blk) { unsigned long long mm_[8];
#pragma unroll
        for (int i = 0; i < 8; ++i) mm_[i] = __ballot(k[8 * blk + i] >= cf);
        __builtin_amdgcn_sched_barrier(0);
#pragma unroll
        for (int i = 0; i < 8; ++i) cnt += __popcll(mm_[i]); }
    return cnt;
#endif
}
#undef DSA_CNT8
__device__ __forceinline__ float imgf(unsigned T) { return __builtin_bit_cast(float, (T & 0x80000000u) ? (T & 0x7fffffffu) : ~T); }
__device__ __forceinline__ float uni(float v) { return __builtin_bit_cast(float, __builtin_amdgcn_readfirstlane(__builtin_bit_cast(int, v))); }
template <int NB> __device__ __forceinline__ void dsa_select(const float (&k)[32], int lane, int t, unsigned& mlo, unsigned& mhi) {
    const int n = t + 1; const float nf = (float)n, inf = __builtin_inff();
    float s1 = 0.f, s2 = 0.f;
#pragma unroll
    for (int j = 0; j < 8; ++j) { const float v = k[NB * j]; const float vv = (v == -inf) ? 0.f : v; s1 += vv; s2 = __builtin_fmaf(vv, vv, s2); }
    s1 = wave_fsum(s1); s2 = wave_fsum(s2);
    const int qf = n / (64 * NB), rr = n - qf * (64 * NB); const int m = (qf >= 8) ? 512 : 64 * qf + (rr < 64 ? rr : 64);
    const float inv_m = frcp((float)m), mu = s1 * inv_m, sg = __builtin_sqrtf(fmaxf(s2 * inv_m - mu * mu, 1e-30f));
    const float zt = 0.4073f * (__builtin_amdgcn_logf(nf - 256.f) - 8.f);
    const float slope = sg * 4.3333f * frcp(nf);
    float g = uni(mu + zt * sg), lo_v = -inf, hi_v = inf, wl = 0.f, wh = 0.f, Tf = 0.f; bool exact = false, done = false; int last = 0;
#pragma unroll 1
    for (int probes = 0; ; ) {
        const int c = dsa_count<NB>(k, g);
        if (c == 256) { exact = true; Tf = g; break; }
        const float d = (float)(c - 256);
        if (c > 256) {
            lo_v = g; wl = d; if (last == 1) wh *= 0.5f; last = 1;
            if (c <= 258) {
#pragma unroll 1
                for (;;) { float a = inf;
#pragma unroll
                    for (int i = 0; i < 8 * NB; ++i) a = fminf(a, (k[i] > lo_v) ? k[i] : inf);
                    a = wave_fmin(a); const int ca = dsa_count<NB>(k, a);
                    if (ca == 256) { exact = true; Tf = a; break; }
                    if (ca < 256) { Tf = lo_v; break; }
                    lo_v = a; }
                done = true;
            }
        } else {
            hi_v = g; wh = -d; if (last == 2) wl *= 0.5f; last = 2;
            if (c >= 254) {
#pragma unroll 1
                for (;;) { float bmx = -inf;
#pragma unroll
                    for (int i = 0; i < 8 * NB; ++i) bmx = fmaxf(bmx, (k[i] < hi_v) ? k[i] : -inf);
                    bmx = wave_fmax(bmx); const int cb = dsa_count<NB>(k, bmx);
                    if (cb == 256) { exact = true; Tf = bmx; break; }
                    if (cb > 256) { Tf = bmx; break; }
                    hi_v = bmx; }
                done = true;
            }
        }
        if (done) break;
        ++probes;
        const float g2 = uni((last == 1 ? hi_v < inf : lo_v > -inf) ? lo_v + (hi_v - lo_v) * wl * frcp(wl + wh) : g + d * slope);
        if (!(g2 > lo_v && g2 < hi_v) || probes >= 16) {
            unsigned lo_i = ordkey(lo_v), hi_i = ordkey(hi_v);
#pragma unroll 1
            while (hi_i - lo_i > 1u) { const unsigned gi = __builtin_amdgcn_readfirstlane(lo_i + ((hi_i - lo_i) >> 1)); const float gf = imgf(gi); const int cc = dsa_count<NB>(k, gf);
                if (cc == 256) { exact = true; Tf = gf; break; }
                if (cc > 256) lo_i = gi; else hi_i = gi; }
            if (!exact) Tf = imgf(lo_i);
            break;
        }
        g = g2;
    }
    if (exact) {
#pragma unroll
        for (int i = 0; i < 8 * NB; ++i) { const unsigned long long mm = __ballot(k[i] >= Tf); if (lane == i) { mlo = (unsigned)mm; mhi = (unsigned)(mm >> 32); } }
    } else {
        int cgt = 0;
#pragma unroll
        for (int i = 0; i < 8 * NB; ++i) cgt += __popcll(__ballot(k[i] > Tf));
        const int need = 256 - cgt; int base = 0;
#pragma unroll
        for (int i = 0; i < 8 * NB; ++i) {
            const bool eq = (k[i] == Tf); const unsigned long long me = __ballot(eq);
            const int rank = base + (int)__builtin_amdgcn_mbcnt_hi((unsigned)(me >> 32), __builtin_amdgcn_mbcnt_lo((unsigned)me, 0u));
            const bool sel = (k[i] > Tf) || (eq && rank < need);
            const unsigned long long mm = __ballot(sel);
            if (lane == i) { mlo = (unsigned)mm; mhi = (unsigned)(mm >> 32); }
            base += __popcll(me);
        }
    }
}
constexpr int KSTR = 72, VSTR = 72;
__device__ __forceinline__ void dsa_unit(const Frame& F, const bf16* U, bf16* YC, int b, int j) {
    LAUNDER_TID(); const int wave = F.wave;
    if (wave >= 4) __builtin_amdgcn_s_setprio(1);
    const size_t rb = (size_t)b * SEQ;
    LAS float* SC = (LAS float*)F.lds;
    LAS unsigned* BM = (LAS unsigned*)(F.lds + LDS_BM);
#pragma unroll 1
    for (int rep12_ = 0; rep12_ < REP_DSA12; ++rep12_)
    {
        const f32x4 ninf = {-__builtin_inff(), -__builtin_inff(), -__builtin_inff(), -__builtin_inff()};
        for (int e = tid; e < 16 * SC_STRIDE / 4; e += 512) ((LAS f32x4*)SC)[e] = ninf;
        LDS_BARRIER();
    }
    {
    bf16x8 nbq[8][2]; v4u niw;
    { const bf16* qrow = U + (rb + 64 * j + (lane & 15)) * ABP;
#pragma unroll
      for (int h = 0; h < 8; ++h)
#pragma unroll
        for (int ks = 0; ks < 2; ++ks) nbq[h][ks] = *(const bf16x8*)(qrow + AB_IQ + h * 64 + ks * 32 + (lane >> 4) * 8);
      niw = *(const v4u*)(qrow + AB_IW); }
#pragma unroll 1
    for (int s = 0; s < 4; ++s) {
        const int t0 = 64 * j + 16 * s, nkt = (t0 >> 4) + 1;
        {
            const int c = lane & 15, g = lane >> 4;
            bf16x8 bq[8][2];
#pragma unroll
            for (int h = 0; h < 8; ++h)
#pragma unroll
                for (int ks = 0; ks < 2; ++ks) bq[h][ks] = nbq[h][ks];
            float iwv[8];
            { const v4u raw = niw; const float ws = 0.04419417382f;
              iwv[0] = bf2f(raw.x & 0xffffu) * ws; iwv[1] = bf2f(raw.x >> 16) * ws; iwv[2] = bf2f(raw.y & 0xffffu) * ws; iwv[3] = bf2f(raw.y >> 16) * ws;
              iwv[4] = bf2f(raw.z & 0xffffu) * ws; iwv[5] = bf2f(raw.z >> 16) * ws; iwv[6] = bf2f(raw.w & 0xffffu) * ws; iwv[7] = bf2f(raw.w >> 16) * ws; }
            bf16x8 nak[4][2];
#pragma unroll
            for (int u = 0; u < 4; ++u) { const int kt = wave + 8 * u;
                if (kt < nkt) { const bf16* krow = U + (rb + 16 * kt + c) * ABP + AB_IK + g * 8; nak[u][0] = *(const bf16x8*)krow; nak[u][1] = *(const bf16x8*)(krow + 32); } }
            for (int kt0 = wave; kt0 < nkt; kt0 += 32) {
                bf16x8 ak[4][2];
#pragma unroll
                for (int u = 0; u < 4; ++u) { ak[u][0] = nak[u][0]; ak[u][1] = nak[u][1]; }
#pragma unroll
                for (int u = 0; u < 4; ++u) { const int kt = kt0 + 32 + 8 * u;
                    if (kt < nkt) { const bf16* krow = U + (rb + 16 * kt + c) * ABP + AB_IK + g * 8; nak[u][0] = *(const bf16x8*)krow; nak[u][1] = *(const bf16x8*)(krow + 32); } }
#pragma unroll
                for (int u = 0; u < 4; ++u) { const int kt = kt0 + 8 * u;
                    if (kt < nkt) {
                        f32x4 acc[8]; const f32x4 z4 = {0.f, 0.f, 0.f, 0.f};
#pragma unroll
                        for (int h = 0; h < 8; ++h) acc[h] = mfma16(ak[u][0], bq[h][0], z4);
#pragma unroll
                        for (int h = 0; h < 8; ++h) acc[h] = mfma16(ak[u][1], bq[h][1], acc[h]);
                        __builtin_amdgcn_sched_barrier(0);
                        f32x4 sc = {0.f, 0.f, 0.f, 0.f};
#pragma unroll
                        for (int h = 0; h < 8; ++h)
#pragma unroll
                            for (int i = 0; i < 4; ++i) { const float av_ = acc[h][i]; const int rb_ = __builtin_bit_cast(int, av_); sc[i] = __builtin_fmaf(__builtin_bit_cast(float, rb_ > 0 ? rb_ : 0), iwv[h], sc[i]); }
#pragma unroll
                        for (int i = 0; i < 4; ++i) sc[i] = (16 * kt + 4 * g + i <= t0 + c) ? sc[i] : -__builtin_inff();
                        *(LAS f32x4*)(SC + c * SC_STRIDE + 16 * kt + 4 * g) = sc;
                    } }
            }
            if (s < 3) { const bf16* qrow = U + (rb + t0 + 16 + c) * ABP;
#pragma unroll
                for (int h = 0; h < 8; ++h)
#pragma unroll
                    for (int ks = 0; ks < 2; ++ks) nbq[h][ks] = *(const bf16x8*)(qrow + AB_IQ + h * 64 + ks * 32 + g * 8);
                niw = *(const v4u*)(qrow + AB_IW); }
        }
        LDS_BARRIER();
#pragma unroll 1
        for (int rep2_ = 0; rep2_ < REP_DSA2; ++rep2_)
        for (int qq = 0; qq < 2; ++qq) {
            const int q = 2 * wave + qq, t = t0 + q;
            float k[32];
#pragma unroll
            for (int i = 0; i < 32; ++i) k[i] = *(volatile LAS float*)(SC + q * SC_STRIDE + 64 * i + lane);
            unsigned mlo = 0u, mhi = 0u;
            if (t < 256) {
#pragma unroll
                for (int i = 0; i < 4; ++i) { const unsigned long long mm = __ballot((64 * i + lane) <= t); if (lane == i) { mlo = (unsigned)mm; mhi = (unsigned)(mm >> 32); } }
            } else if (t < 512) dsa_select<1>(k, lane, t, mlo, mhi);
            else if (t < 1024) dsa_select<2>(k, lane, t, mlo, mhi);
            else if (t < 1536) dsa_select<3>(k, lane, t, mlo, mhi);
            else dsa_select<4>(k, lane, t, mlo, mhi);
            if (lane < 32) { BM[(16 * s + q) * 64 + 2 * lane] = mlo; BM[(16 * s + q) * 64 + 2 * lane + 1] = mhi; }
        }
        LDS_BARRIER();
    }
    }
    __syncthreads();
    LAS bf16* Ks = (LAS bf16*)F.lds;
    LAS bf16* Vt = (LAS bf16*)(F.lds + 2 * 64 * KSTR * 2);
    const int c = lane & 31, hi = lane >> 5;
#pragma unroll 1
    for (int rep3_ = 0; rep3_ < REP_DSA3; ++rep3_) {
    LAS bf16x8* QF = (LAS bf16x8*)(F.lds + 4 * 64 * KSTR * 2) + wave * 512;
#pragma unroll
    for (int nt = 0; nt < 2; ++nt)
#pragma unroll
        for (int ks = 0; ks < 4; ++ks) QF[(nt * 4 + ks) * 64 + lane] = *(const bf16x8*)(U + (rb + 64 * j + 32 * nt + c) * ABP + AB_Q + wave * 64 + 16 * ks + 8 * hi);
    f32x16 O[2][2];
#pragma unroll
    for (int dt = 0; dt < 2; ++dt)
#pragma unroll
        for (int nt = 0; nt < 2; ++nt)
#pragma unroll
            for (int i = 0; i < 16; ++i) O[dt][nt][i] = 0.f;
    float mrow[2] = {-1e30f, -1e30f}, lrow[2] = {0.f, 0.f};
    const float sc2 = 0.125f * 1.44269504089f;
    const int krow_s = tid >> 3, kch_s = tid & 7, vkey_s = tid & 63, vch_s = tid >> 6;
    v4u kreg = *(const v4u*)(U + (rb + krow_s) * ABP + AB_K + 8 * kch_s);
    v4u vreg = *(const v4u*)(U + (rb + vkey_s) * ABP + AB_V + 8 * vch_s);
    {
        *(LAS v4u*)(Ks + krow_s * KSTR + 8 * kch_s) = kreg;
        const unsigned ve[4] = {vreg.x, vreg.y, vreg.z, vreg.w};
#pragma unroll
        for (int e = 0; e < 4; ++e) { Vt[(8 * vch_s + 2 * e) * VSTR + vkey_s] = (bf16)(ve[e] & 0xffffu); Vt[(8 * vch_s + 2 * e + 1) * VSTR + vkey_s] = (bf16)(ve[e] >> 16); }
    }
    __syncthreads();
    for (int kt = 0; kt <= j; ++kt) {
        const int buf = kt & 1;
        if (kt < j) {
            kreg = *(const v4u*)(U + (rb + 64 * (kt + 1) + krow_s) * ABP + AB_K + 8 * kch_s);
            vreg = *(const v4u*)(U + (rb + 64 * (kt + 1) + vkey_s) * ABP + AB_V + 8 * vch_s);
        }
        const LAS bf16* Kb = Ks + buf * 64 * KSTR; const LAS bf16* Vb = Vt + buf * 64 * VSTR;
        bf16x8 va[2][4]; unsigned wm[2][2];
#pragma unroll
        for (int dt = 0; dt < 2; ++dt)
#pragma unroll
            for (int kk = 0; kk < 4; ++kk) { const LAS bf16* vp = Vb + (32 * dt + c) * VSTR + 16 * kk + 4 * hi; va[dt][kk] = mk8(*(const LAS v2u*)vp, *(const LAS v2u*)(vp + 8)); }
#pragma unroll
        for (int nt = 0; nt < 2; ++nt)
#pragma unroll
            for (int mt = 0; mt < 2; ++mt) wm[nt][mt] = BM[(32 * nt + c) * 64 + 2 * kt + mt] >> (4 * hi);
#pragma unroll
        for (int nt = 0; nt < 2; ++nt) {
            f32x16 S[2];
            {
                bf16x8 ka[2][4], bq[4];
#pragma unroll
                for (int ks = 0; ks < 4; ++ks) bq[ks] = QF[(nt * 4 + ks) * 64 + lane];
#pragma unroll
                for (int mt = 0; mt < 2; ++mt)
#pragma unroll
                    for (int ks = 0; ks < 4; ++ks) ka[mt][ks] = *(const LAS bf16x8*)(Kb + (32 * mt + c) * KSTR + 16 * ks + 8 * hi);
#pragma unroll
                for (int mt = 0; mt < 2; ++mt) {
#pragma unroll
                    for (int i = 0; i < 16; ++i) S[mt][i] = 0.f;
#pragma unroll
                    for (int ks = 0; ks < 4; ++ks) S[mt] = mfma32(ka[mt][ks], bq[ks], S[mt]);
                }
            }
            float mx = -1e30f;
#pragma unroll
            for (int mt = 0; mt < 2; ++mt)
#pragma unroll
                for (int i = 0; i < 16; ++i) mx = fmaxf(mx, S[mt][i]);
            mx = fmaxf(mx, __shfl_xor(mx, 32)) * sc2;
            if (!__all(mx <= mrow[nt] + 8.0f)) {
                const float mn = fmaxf(mrow[nt], mx), alpha = fexp2(mrow[nt] - mn);
                mrow[nt] = mn; lrow[nt] *= alpha;
#pragma unroll
                for (int dt = 0; dt < 2; ++dt)
#pragma unroll
                    for (int i = 0; i < 16; ++i) O[dt][nt][i] *= alpha;
            }
            const float mnew = mrow[nt];
#pragma unroll
            for (int mt = 0; mt < 2; ++mt) {
                const unsigned w = wm[nt][mt];
                float p[16];
#pragma unroll
                for (int i = 0; i < 16; ++i) { const int kl = (i & 3) + 8 * (i >> 2);
                    const float e = fexp2(S[mt][i] * sc2 - mnew); unsigned mk_; asm("v_bfe_i32 %0, %1, %2, 1" : "=v"(mk_) : "v"(w), "n"(kl));
                    p[i] = __builtin_bit_cast(float, __builtin_bit_cast(unsigned, e) & mk_); lrow[nt] += p[i]; }
#pragma unroll
                for (int half = 0; half < 2; ++half) {
                    const bf16x8 pb = pack8(p[8 * half + 0], p[8 * half + 1], p[8 * half + 2], p[8 * half + 3], p[8 * half + 4], p[8 * half + 5], p[8 * half + 6], p[8 * half + 7]);
#pragma unroll
                    for (int dt = 0; dt < 2; ++dt) O[dt][nt] = mfma32(va[dt][2 * mt + half], pb, O[dt][nt]);
                }
            }
            __builtin_amdgcn_sched_barrier(0);
        }
        if (kt < j) {
            const int nb = buf ^ 1;
            *(LAS v4u*)(Ks + nb * 64 * KSTR + krow_s * KSTR + 8 * kch_s) = kreg;
            const unsigned ve[4] = {vreg.x, vreg.y, vreg.z, vreg.w};
#pragma unroll
            for (int e = 0; e < 4; ++e) { Vt[nb * 64 * VSTR + (8 * vch_s + 2 * e) * VSTR + vkey_s] = (bf16)(ve[e] & 0xffffu); Vt[nb * 64 * VSTR + (8 * vch_s + 2 * e + 1) * VSTR + vkey_s] = (bf16)(ve[e] >> 16); }
        }
        __syncthreads();
    }
#pragma unroll
    for (int nt = 0; nt < 2; ++nt) {
        const float l = lrow[nt] + __shfl_xor(lrow[nt], 32); const float inv = 1.0f / l;
        bf16* orow = YC + (rb + 64 * j + 32 * nt + c) * DM + 512 + wave * 64;
#pragma unroll
        for (int dt = 0; dt < 2; ++dt)
#pragma unroll
            for (int g4 = 0; g4 < 4; ++g4) {
                v2u w; w.x = pk2(O[dt][nt][4 * g4 + 0] * inv, O[dt][nt][4 * g4 + 1] * inv); w.y = pk2(O[dt][nt][4 * g4 + 2] * inv, O[dt][nt][4 * g4 + 3] * inv);
                *(v2u*)(orow + 32 * dt + 8 * g4 + 4 * hi) = w;
            }
    }
    __syncthreads();
    }
    __builtin_amdgcn_s_setprio(0);
}

__device__ __forceinline__ void conv_unit(const Frame& F, const bf16* U, bf16* YC, const float* conv_w, const float* conv_b, const float* ln_g, const float* ln_b, int tile) {
    LAUNDER_TID();
    const int b = tile >> 5, t0 = (tile & 31) * 64, c = tid;
    const size_t rb = (size_t)b * SEQ;
    LAS bf16* Hs = (LAS bf16*)F.lds;
    LAS float* O2 = (LAS float*)(F.lds + 94 * 512 * 2);
    LAS float* ST = (LAS float*)(F.lds + 94 * 512 * 2 + 8 * 512 * 4);
    {
        v4u tmp[12];
#pragma unroll
        for (int k = 0; k < 12; ++k) { const int e = tid + 512 * k, r = e >> 6, ch = e & 63; int t = t0 - 30 + r; t = t < 0 ? 0 : t; t = t > SEQ - 1 ? SEQ - 1 : t;
            tmp[k] = *(const v4u*)(U + (rb + t) * ABP + 8 * ch); }
#pragma unroll
        for (int k = 0; k < 12; ++k) { const int e = tid + 512 * k, r = e >> 6, ch = e & 63; const bool z = (t0 - 30 + r) < 0; v4u x = tmp[k]; if (z) { x.x = 0u; x.y = 0u; x.z = 0u; x.w = 0u; }
            if (r < 94) *(LAS v4u*)(Hs + r * 512 + 8 * ch) = x; }
    }
    float w[31];
#pragma unroll
    for (int jj = 0; jj < 31; ++jj) w[jj] = conv_w[jj * 512 + c];
    const float bias = conv_b[c], lg = ln_g[c], lb = ln_b[c];
    LDS_BARRIER();
    for (int grp = 0; grp < 8; ++grp) {
        float in[38];
#pragma unroll
        for (int r = 0; r < 38; ++r) in[r] = bf2f(Hs[(8 * grp + r) * 512 + c]);
        float o[8];
#pragma unroll
        for (int tl = 0; tl < 8; ++tl) { float acc = bias;
#pragma unroll
            for (int jj = 0; jj < 31; ++jj) acc += w[jj] * in[tl + jj];
            o[tl] = acc; O2[tl * 512 + c] = acc; }
        LDS_BARRIER();
        { float s = 0.f, s2 = 0.f;
#pragma unroll
          for (int e = 0; e < 8; ++e) { const float v = O2[F.wave * 512 + lane + 64 * e]; s += v; s2 += v * v; }
          s = wave_sum(s); s2 = wave_sum(s2);
          if (lane == 0) { const float mu = s * (1.0f / 512.0f), var = fmaxf(s2 * (1.0f / 512.0f) - mu * mu, 0.f); ST[2 * F.wave] = mu; ST[2 * F.wave + 1] = rsqrtf(var + EPS); } }
        LDS_BARRIER();
        f32x4 stv[4];
#pragma unroll
        for (int k4 = 0; k4 < 4; ++k4) stv[k4] = *(const LAS f32x4*)(ST + 4 * k4);
#pragma unroll
        for (int tl = 0; tl < 8; ++tl) { const float mu = (tl & 1) ? stv[tl >> 1].z : stv[tl >> 1].x, rs = (tl & 1) ? stv[tl >> 1].w : stv[tl >> 1].y; const float y = (o[tl] - mu) * rs * lg + lb; const float ya = fsilu(y);
            YC[(rb + t0 + 8 * grp + tl) * DM + c] = (bf16)f2bf(ya); }
    }
    LDS_BARRIER();
}

constexpr int XSTR = 520;
__device__ __forceinline__ void gla_prep_unit(const Frame& F, const bf16* U1, bf16* QT, bf16* KT, bf16* KTT, float* DEC, const float* g2_w, const float* g2_b, int unit) {
    LAUNDER_TID(); (void)KTT;
    const size_t r0 = (size_t)unit * 64;
    LAS bf16* XQ = (LAS bf16*)F.lds;
    LAS bf16* XK = XQ + 64 * XSTR;
    {
        v4u tmp[16];
#pragma unroll
        for (int k = 0; k < 16; ++k) { const int e = tid + 512 * k; tmp[k] = *(const v4u*)(U1 + (r0 + (e >> 7)) * CP + 8 * (e & 127)); }
#pragma unroll
        for (int k = 0; k < 16; ++k) { const int e = tid + 512 * k, row = e >> 7, ch = e & 127;
            LAS bf16* dst = (ch < 64) ? (XQ + row * XSTR + 8 * ch) : (XK + row * XSTR + 8 * (ch - 64)); *(LAS v4u*)dst = tmp[k]; }
    }
    {
        const int c = lane & 31, hi = lane >> 5, wv_ = F.wave;
        bf16x8 ga[2];
#pragma unroll
        for (int tb = 0; tb < 2; ++tb) ga[tb] = *(const bf16x8*)(U1 + (r0 + 32 * tb + c) * CP + C_GL + 8 * hi);
        float wf[2][8], bs[2];
#pragma unroll
        for (int cb = 0; cb < 2; ++cb) { bs[cb] = g2_b[64 * wv_ + 32 * cb + c];
#pragma unroll
            for (int e = 0; e < 8; ++e) wf[cb][e] = g2_w[(8 * hi + e) * 512 + 64 * wv_ + 32 * cb + c]; }
        LDS_BARRIER();
#pragma unroll
        for (int cb = 0; cb < 2; ++cb) {
            const int colc = 64 * wv_ + 32 * cb + c;
            v4u hb_, lb_;
            { unsigned hh[4], ll[4];
#pragma unroll
              for (int e2 = 0; e2 < 4; ++e2) { const unsigned h2 = pk2(wf[cb][2 * e2], wf[cb][2 * e2 + 1]); hh[e2] = h2;
                  ll[e2] = pk2(wf[cb][2 * e2] - bf2f(h2 & 0xffffu), wf[cb][2 * e2 + 1] - __builtin_bit_cast(float, h2 & 0xffff0000u)); }
              hb_.x = hh[0]; hb_.y = hh[1]; hb_.z = hh[2]; hb_.w = hh[3]; lb_.x = ll[0]; lb_.y = ll[1]; lb_.z = ll[2]; lb_.w = ll[3]; }
            const bf16x8 bh = __builtin_bit_cast(bf16x8, hb_), bl = __builtin_bit_cast(bf16x8, lb_);
            float p[2][16];
#pragma unroll
            for (int tb = 0; tb < 2; ++tb) {
                f32x16 D;
#pragma unroll
                for (int i = 0; i < 16; ++i) D[i] = 0.f;
                D = mfma32(ga[tb], bh, D); D = mfma32(ga[tb], bl, D);
#pragma unroll
                for (int i = 0; i < 16; ++i) { const float x = D[i] + bs[cb];
                    p[tb][i] = (fminf(x, 0.f) - 0.69314718056f * __builtin_amdgcn_logf(1.0f + fexp(-fabsf(x)))) * (1.0f / 16.0f); }
#pragma unroll
                for (int a = 0; a < 4; ++a) { p[tb][4 * a + 1] += p[tb][4 * a]; p[tb][4 * a + 2] += p[tb][4 * a + 1]; p[tb][4 * a + 3] += p[tb][4 * a + 2]; }
            }
            float run = 0.f;
#pragma unroll
            for (int tb = 0; tb < 2; ++tb)
#pragma unroll
                for (int a = 0; a < 4; ++a) {
                    const float gt = p[tb][4 * a + 3], pt = __shfl_xor(gt, 32);
                    const float off = run + (hi ? pt : 0.f); run += gt + pt;
#pragma unroll
                    for (int j = 0; j < 4; ++j) {
                        const float blg = (off + p[tb][4 * a + j]) * 1.44269504089f;
                        const int idx = (32 * tb + 8 * a + 4 * hi + j) * XSTR + colc;
                        const float qv = bf2f(XQ[idx]), kv = bf2f(XK[idx]);
                        XQ[idx] = (bf16)f2bf(qv * fexp2(blg) * 0.08838834764f);
                        XK[idx] = (bf16)f2bf(kv * fexp2(-blg));
                    }
                }
            if (hi == 0) DEC[(size_t)unit * 512 + colc] = fexp(run);
        }
    }
    LDS_BARRIER();
#pragma unroll
    for (int k = 0; k < 8; ++k) { const int e = tid + 512 * k, row = e >> 6, ch = e & 63;
        *(v4u*)(QT + (r0 + row) * 512 + 8 * ch) = *(const LAS v4u*)(XQ + row * XSTR + 8 * ch);
        *(v4u*)(KT + (r0 + row) * 512 + 8 * ch) = *(const LAS v4u*)(XK + row * XSTR + 8 * ch); }
    LDS_BARRIER();
}
constexpr int QSTR = 136, TSTR = 72;
constexpr int VNSTR = 96;
constexpr int G2_QS = 0, G2_KS = 64 * QSTR * 2, G2_KT = 2 * 64 * QSTR * 2, G2_VT = G2_KT + 128 * TSTR * 2, G2_DS = G2_VT + 64 * VNSTR * 2, G2_BUF = G2_DS + 512;
constexpr int G2_AS = G2_BUF, G2_PO = G2_AS + 64 * TSTR * 2;
static_assert(G2_PO + 65536 <= LDS_CTL, "GLA scan LDS map");
__device__ __forceinline__ void g2_step_body(const Frame& F, LAS unsigned char* bp, LAS bf16* As, LAS float* PO, f32x16& S, const bf16* QT, bf16* OB, float* GSSQ, int b, int h, int vq, int ch, int tid, int lane, const v2u rr0, const v2u rr1, const float (&gs)[8]) {
    const int wave = F.wave, c = lane & 31, hi = lane >> 5, vt = wave & 1, dt = wave >> 1; (void)tid; (void)QT;
        const size_t r0 = (size_t)b * SEQ + 64 * ch;
        const LAS bf16* Qs = (const LAS bf16*)(bp + G2_QS); const LAS bf16* Ks = (const LAS bf16*)(bp + G2_KS);
        const LAS float* Ds = (const LAS float*)(bp + G2_DS);
        for (int n = wave; n < 10; n += 8) {
            const int it = (n >= 6) ? 3 : (n >= 3) ? 2 : (n >= 1) ? 1 : 0, jt = n - (it * (it + 1)) / 2; const int r16 = lane & 15, g = lane >> 4;
            f32x4 acc = {0.f, 0.f, 0.f, 0.f};
#pragma unroll
            for (int ks = 0; ks < 4; ++ks) acc = mfma16(*(const LAS bf16x8*)(Ks + (16 * jt + r16) * QSTR + 32 * ks + 8 * g), *(const LAS bf16x8*)(Qs + (16 * it + r16) * QSTR + 32 * ks + 8 * g), acc);
            const int i = 16 * it + r16, j0 = 16 * jt + 4 * g;
            v2u w; w.x = pk2(j0 <= i ? acc[0] : 0.f, j0 + 1 <= i ? acc[1] : 0.f); w.y = pk2(j0 + 2 <= i ? acc[2] : 0.f, j0 + 3 <= i ? acc[3] : 0.f);
            *(LAS v2u*)(As + i * TSTR + j0) = w;
        }
        LDS_BARRIER();
        f32x16 OT[2];
#pragma unroll
        for (int it = 0; it < 2; ++it)
#pragma unroll
            for (int i = 0; i < 16; ++i) OT[it][i] = 0.f;
#pragma unroll
        for (int half = 0; half < 2; ++half) {
            const bf16x8 sa = pack8(S[8 * half + 0], S[8 * half + 1], S[8 * half + 2], S[8 * half + 3], S[8 * half + 4], S[8 * half + 5], S[8 * half + 6], S[8 * half + 7]);
#pragma unroll
            for (int it = 0; it < 2; ++it) { const LAS bf16* qp = Qs + (32 * it + c) * QSTR + 32 * dt + 16 * half + 4 * hi;
                OT[it] = mfma32(sa, mk8(*(const LAS v2u*)qp, *(const LAS v2u*)(qp + 8)), OT[it]); }
        }
        bf16x8 vf[4];
        {
            const unsigned va_ = (unsigned)(__UINTPTR_TYPE__)(bp + G2_VT) + (unsigned)((8 * hi + ((lane & 15) >> 2)) * (VNSTR * 2) + (32 * vt + 16 * ((lane >> 4) & 1) + 4 * (lane & 3)) * 2);
            v2u t0_, t1_, t2_, t3_, t4_, t5_, t6_, t7_;
            asm volatile("ds_read_b64_tr_b16 %0, %8\n\tds_read_b64_tr_b16 %1, %8 offset:768\n\tds_read_b64_tr_b16 %2, %8 offset:3072\n\tds_read_b64_tr_b16 %3, %8 offset:3840\n\t"
                         "ds_read_b64_tr_b16 %4, %8 offset:6144\n\tds_read_b64_tr_b16 %5, %8 offset:6912\n\tds_read_b64_tr_b16 %6, %8 offset:9216\n\tds_read_b64_tr_b16 %7, %8 offset:9984\n\t"
                         "s_waitcnt lgkmcnt(0)"
                         : "=&v"(t0_), "=&v"(t1_), "=&v"(t2_), "=&v"(t3_), "=&v"(t4_), "=&v"(t5_), "=&v"(t6_), "=&v"(t7_) : "v"(va_) : "memory");
            vf[0] = mk8(t0_, t1_); vf[1] = mk8(t2_, t3_); vf[2] = mk8(t4_, t5_); vf[3] = mk8(t6_, t7_);
        }
        {
            const bf16x8 va = (dt == 0) ? vf[0] : (dt == 1) ? vf[1] : (dt == 2) ? vf[2] : vf[3];
#pragma unroll
            for (int it = 0; it < 2; ++it) OT[it] = mfma32(va, *(const LAS bf16x8*)(As + (32 * it + c) * TSTR + 16 * dt + 8 * hi), OT[it]);
        }
#pragma unroll
        for (int it = 0; it < 2; ++it)
#pragma unroll
            for (int i = 0; i < 16; ++i) PO[(((dt * 2 + vt) * 2 + it) * 16 + i) * 64 + lane] = OT[it][i];
        LDS_BARRIER();
        {
            const int vt2 = wave & 1, it2 = (wave >> 1) & 1, q = wave >> 2;
            float o8[8];
#pragma unroll
            for (int jx = 0; jx < 8; ++jx) { float a = 0.f;
#pragma unroll
                for (int d4 = 0; d4 < 4; ++d4) a += PO[(((d4 * 2 + vt2) * 2 + it2) * 16 + 8 * q + jx) * 64 + lane];
                o8[jx] = a; }
            float ss = 0.f;
#pragma unroll
            for (int jx = 0; jx < 8; ++jx) ss += o8[jx] * o8[jx];
            ss += __shfl_xor(ss, 32);
            const size_t tok = r0 + 32 * it2 + c;
            bf16* orow = OB + tok * DM + h * 256 + 64 * vq + 32 * vt2 + 16 * q + 4 * hi;
            const float rvv[8] = {bf2f(rr0.x & 0xffffu), bf2f(rr0.x >> 16), bf2f(rr0.y & 0xffffu), bf2f(rr0.y >> 16), bf2f(rr1.x & 0xffffu), bf2f(rr1.x >> 16), bf2f(rr1.y & 0xffffu), bf2f(rr1.y >> 16)};
            float y8[8];
#pragma unroll
            for (int jx = 0; jx < 8; ++jx) y8[jx] = o8[jx] * gs[jx] * fsilu(rvv[jx]);
            v2u w0, w1; w0.x = pk2(y8[0], y8[1]); w0.y = pk2(y8[2], y8[3]); w1.x = pk2(y8[4], y8[5]); w1.y = pk2(y8[6], y8[7]);
            *(v2u*)orow = w0; *(v2u*)(orow + 8) = w1;
            if (hi == 0) GSSQ[(tok * 4 + h) * 16 + vq * 4 + vt2 * 2 + q] = ss;
        }
        {
            const unsigned ka_ = (unsigned)(__UINTPTR_TYPE__)(bp + G2_KS) + (unsigned)((8 * hi + ((lane & 15) >> 2)) * (QSTR * 2) + (32 * dt + 16 * ((lane >> 4) & 1) + 4 * (lane & 3)) * 2);
            v2u t0_, t1_, t2_, t3_, t4_, t5_, t6_, t7_;
            asm volatile("ds_read_b64_tr_b16 %0, %8\n\tds_read_b64_tr_b16 %1, %8 offset:1088\n\tds_read_b64_tr_b16 %2, %8 offset:4352\n\tds_read_b64_tr_b16 %3, %8 offset:5440\n\t"
                         "ds_read_b64_tr_b16 %4, %8 offset:8704\n\tds_read_b64_tr_b16 %5, %8 offset:9792\n\tds_read_b64_tr_b16 %6, %8 offset:13056\n\tds_read_b64_tr_b16 %7, %8 offset:14144\n\t"
                         "s_waitcnt lgkmcnt(0)"
                         : "=&v"(t0_), "=&v"(t1_), "=&v"(t2_), "=&v"(t3_), "=&v"(t4_), "=&v"(t5_), "=&v"(t6_), "=&v"(t7_) : "v"(ka_) : "memory");
            S = mfma32(mk8(t0_, t1_), vf[0], S); S = mfma32(mk8(t2_, t3_), vf[1], S); S = mfma32(mk8(t4_, t5_), vf[2], S); S = mfma32(mk8(t6_, t7_), vf[3], S);
        }
#pragma unroll
        for (int g4 = 0; g4 < 4; ++g4) { const f32x4 dv = *(const LAS f32x4*)(Ds + 32 * dt + 8 * g4 + 4 * hi);
            S[4 * g4 + 0] *= dv.x; S[4 * g4 + 1] *= dv.y; S[4 * g4 + 2] *= dv.z; S[4 * g4 + 3] *= dv.w; }
}
__device__ __forceinline__ void gla_scan_unit(const Frame& F, const bf16* U1, const bf16* QT, const bf16* KT, const bf16* KTT, const float* DEC, bf16* OB, float* GSSQ, const float* onorm_g, int b, int h, int vq) {
    LAUNDER_TID(); const int wave = F.wave, c = lane & 31, hi = lane >> 5, vt = wave & 1, dt = wave >> 1;
    const int ocol = h * 256 + 64 * vq + 32 * (wave & 1) + 16 * (wave >> 2) + 4 * hi;
    const bf16* RB = U1 + C_R + ocol; float gs[8];
    { const f32x4 g0 = *(const f32x4*)(onorm_g + ocol), g1 = *(const f32x4*)(onorm_g + ocol + 8); gs[0] = g0.x; gs[1] = g0.y; gs[2] = g0.z; gs[3] = g0.w; gs[4] = g1.x; gs[5] = g1.y; gs[6] = g1.z; gs[7] = g1.w; }
    LAS bf16* As = (LAS bf16*)(F.lds + G2_AS);
    LAS float* PO = (LAS float*)(F.lds + G2_PO);
    f32x16 S;
#pragma unroll
    for (int i = 0; i < 16; ++i) S[i] = 0.f;
    for (int e = tid; e < 64 * TSTR / 2; e += 512) ((LAS unsigned*)As)[e] = 0u;
    v4u pq0[2], pk0[2], pv0, pq1[2], pk1[2], pv1, pq2[2], pk2[2], pv2; f32x4 pd0 = {0.f, 0.f, 0.f, 0.f}, pd1 = pd0, pd2 = pd0;
    LAS unsigned char* const bp = F.lds;
#define G2_LOAD(cidx, X) do { const size_t r0_ = (size_t)b * SEQ + 64 * (cidx); const size_t u_ = (size_t)b * 32 + (cidx); \
        _Pragma("unroll") for (int k = 0; k < 2; ++k) { const int e = tid + 512 * k; \
            pq##X[k] = *(const v4u*)(QT + (r0_ + (e >> 4)) * 512 + h * 128 + 8 * (e & 15)); \
            pk##X[k] = *(const v4u*)(KT + (r0_ + (e >> 4)) * 512 + h * 128 + 8 * (e & 15)); \
 } \
        pv##X = *(const v4u*)(U1 + (r0_ + (tid >> 3)) * CP + C_V + h * 256 + 64 * vq + 8 * (tid & 7)); \
        if (tid < 32) pd##X = *(const f32x4*)(DEC + u_ * 512 + h * 128 + 4 * tid); } while (0)
#define G2_STORE(X) do { \
        _Pragma("unroll") for (int k = 0; k < 2; ++k) { const int e = tid + 512 * k; \
            *(LAS v4u*)((LAS bf16*)(bp + G2_QS) + (e >> 4) * QSTR + 8 * (e & 15)) = pq##X[k]; \
            *(LAS v4u*)((LAS bf16*)(bp + G2_KS) + (e >> 4) * QSTR + 8 * (e & 15)) = pk##X[k]; \
 } \
        *(LAS v4u*)((LAS bf16*)(bp + G2_VT) + (tid >> 3) * VNSTR + 8 * (tid & 7)) = pv##X; \
        if (tid < 32) *(LAS f32x4*)((LAS float*)(bp + G2_DS) + 4 * tid) = pd##X; } while (0)
    G2_LOAD(0, 0); G2_LOAD(1, 1); G2_LOAD(2, 2);
    G2_STORE(0);
    __syncthreads();
#define G2_RLOAD(cidx) do { const bf16* rp_ = RB + ((size_t)b * SEQ + 64 * (cidx) + 32 * ((wave >> 1) & 1) + c) * CP; rra = *(const v2u*)rp_; rrb = *(const v2u*)(rp_ + 8); } while (0)
    v2u rra, rrb; G2_RLOAD(0);
#define G2_STEP(CH, LX, SX) do { const int ch = (CH); if (ch < 32) { \
        const v2u rr0_ = rra, rr1_ = rrb; if (ch + 1 < 32) G2_RLOAD(ch + 1); \
        if (ch + 3 < 32) G2_LOAD(ch + 3, LX); \
        g2_step_body(F, bp, As, PO, S, QT, OB, GSSQ, b, h, vq, ch, tid, lane, rr0_, rr1_, gs); \
        LDS_BARRIER(); \
        if (ch + 1 < 32) G2_STORE(SX); \
        LDS_BARRIER(); } } while (0)
#pragma unroll 1
    for (int ch0 = 0; ch0 < 33; ch0 += 3) { G2_STEP(ch0, 0, 1); G2_STEP(ch0 + 1, 1, 2); G2_STEP(ch0 + 2, 2, 0); }
#undef G2_STEP
#undef G2_RLOAD
#undef G2_LOAD
#undef G2_STORE
    __syncthreads();
}
__device__ __forceinline__ void gla_norm_gate(const Frame& F, const bf16* U1, bf16* YO, const bf16* OB, const float* GSSQ, const float* onorm_g) {
    LAUNDER_TID();
    const int gw = F.vcu * NWAVES + F.wave, NGW = F.G * NWAVES;
    f32x4 gv[2][2];
#pragma unroll
    for (int jx = 0; jx < 2; ++jx) { gv[jx][0] = *((const f32x4*)onorm_g + 2 * (lane + 64 * jx)); gv[jx][1] = *((const f32x4*)onorm_g + 2 * (lane + 64 * jx) + 1); }
    for (int m0 = gw * 4; m0 < M; m0 += NGW * 4) {
        v4u ov[4][2], rv[4][2]; float rs[4][2];
#pragma unroll
        for (int q = 0; q < 4; ++q)
#pragma unroll
            for (int jx = 0; jx < 2; ++jx) {
                ov[q][jx] = *((const v4u*)(OB + (size_t)(m0 + q) * DM) + lane + 64 * jx);
                rv[q][jx] = *((const v4u*)(U1 + (size_t)(m0 + q) * CP + C_R) + lane + 64 * jx);
                rs[q][jx] = 0.f;
            }
#pragma unroll
        for (int q = 0; q < 4; ++q) {
            float ps = GSSQ[(size_t)(m0 + q) * 64 + lane];
            ps += __shfl_xor(ps, 1); ps += __shfl_xor(ps, 2); ps += __shfl_xor(ps, 4); ps += __shfl_xor(ps, 8);
#pragma unroll
            for (int jx = 0; jx < 2; ++jx) rs[q][jx] = rsqrtf(__shfl(ps, 16 * ((lane + 64 * jx) >> 5)) * (1.0f / 256.0f) + EPS);
        }
#pragma unroll
        for (int q = 0; q < 4; ++q)
#pragma unroll
            for (int jx = 0; jx < 2; ++jx) {
                const unsigned ow[4] = {ov[q][jx].x, ov[q][jx].y, ov[q][jx].z, ov[q][jx].w}, rw[4] = {rv[q][jx].x, rv[q][jx].y, rv[q][jx].z, rv[q][jx].w};
                const float gg[8] = {gv[jx][0].x, gv[jx][0].y, gv[jx][0].z, gv[jx][0].w, gv[jx][1].x, gv[jx][1].y, gv[jx][1].z, gv[jx][1].w};
                unsigned yw[4];
#pragma unroll
                for (int e = 0; e < 4; ++e) { const float o0 = bf2f(ow[e] & 0xffffu), o1 = bf2f(ow[e] >> 16), r0v = bf2f(rw[e] & 0xffffu), r1v = bf2f(rw[e] >> 16);
                    yw[e] = pk2(o0 * rs[q][jx] * gg[2 * e] * fsilu(r0v), o1 * rs[q][jx] * gg[2 * e + 1] * fsilu(r1v)); }
                v4u y; y.x = yw[0]; y.y = yw[1]; y.z = yw[2]; y.w = yw[3];
                *((v4u*)(YO + (size_t)(m0 + q) * DM) + lane + 64 * jx) = y;
            }
    }
}

__device__ __forceinline__ void hs_table_fill(const Frame& F, const pg8::StaticOrder& S, const float* gssq) {
    LAUNDER_TID();
    LAS float* T = (LAS float*)(F.lds + 131072); pg8::Unit u;
    for (int uu = tid >> 8; uu < 4; uu += 2)
    if (S.next(uu, u)) { const f32x4* gp = (const f32x4*)(gssq + ((size_t)u.pm * 256 + (tid & 255)) * 64); float rs[4];
#pragma unroll
        for (int hh = 0; hh < 4; ++hh) { const f32x4 a = (gp[4 * hh] + gp[4 * hh + 1]) + (gp[4 * hh + 2] + gp[4 * hh + 3]); rs[hh] = rsqrtf(((a.x + a.y) + (a.z + a.w)) * (1.0f / 256.0f) + EPS); }
        LAS float* Tu = T + uu * 1024 + (tid & 255);
        Tu[0] = rs[0] / rs[1]; Tu[256] = rs[1] / rs[2]; Tu[512] = rs[2] / rs[3]; Tu[768] = rs[3]; }
}
__device__ __forceinline__ void final_norm(const Frame& F, const bf16* hb, float* out, const float* ssq, const float* g) {
    LAUNDER_TID();
    const int gw = F.vcu * NWAVES + F.wave, NGW = F.G * NWAVES;
    f32x4 gv[2][2];
#pragma unroll
    for (int jx = 0; jx < 2; ++jx) { gv[jx][0] = *((const f32x4*)g + 2 * (lane + 64 * jx)); gv[jx][1] = *((const f32x4*)g + 2 * (lane + 64 * jx) + 1); }
    for (int m0 = gw * 4; m0 < M; m0 += NGW * 4) {
        v4u hv[4][2]; float r[4];
#pragma unroll
        for (int q = 0; q < 4; ++q) { float ps = (lane < 16) ? ssq[(size_t)(m0 + q) * 16 + lane] : 0.f; ps = wave_sum(ps); r[q] = rsqrtf(ps * (1.0f / 1024.0f) + EPS);
#pragma unroll
            for (int jx = 0; jx < 2; ++jx) hv[q][jx] = __builtin_nontemporal_load((const v4u*)(hb + (size_t)(m0 + q) * DM) + lane + 64 * jx); }
#pragma unroll
        for (int q = 0; q < 4; ++q)
#pragma unroll
            for (int jx = 0; jx < 2; ++jx) { const v4u w = hv[q][jx]; f32x4* o = (f32x4*)(out + (size_t)(m0 + q) * DM) + 2 * (lane + 64 * jx);
                f32x4 a, b; a.x = bf2f(w.x & 0xffffu); a.y = bf2f(w.x >> 16); a.z = bf2f(w.y & 0xffffu); a.w = bf2f(w.y >> 16); b.x = bf2f(w.z & 0xffffu); b.y = bf2f(w.z >> 16); b.z = bf2f(w.w & 0xffffu); b.w = bf2f(w.w >> 16);
                __builtin_nontemporal_store(a * r[q] * gv[jx][0], o); __builtin_nontemporal_store(b * r[q] * gv[jx][1], o + 1); }
    }
}

struct Args { const float* in[18]; float* out; unsigned char* ws; int ph_lo, ph_hi; };
constexpr int N_PHASES = 16;
#ifndef REP_P0
#define REP_P0 1
#endif
#ifndef REP_DSA
#define REP_DSA 1
#endif
#ifndef REP_CONV
#define REP_CONV 1
#endif
#ifndef REP_PREP
#define REP_PREP 1
#endif
#ifndef REP_SCAN
#define REP_SCAN 1
#endif
#ifndef MK_MULTI
#define MK_MULTI 0
#endif
__global__ void __launch_bounds__(NWAVES * 64, 2) fwd(Args args) {
    extern __shared__ __attribute__((aligned(16))) unsigned char lds_raw[];
    Frame F;
    F.lds = (LAS unsigned char*)lds_raw;
    F.tid = threadIdx.x; F.lane = F.tid & 63; F.wave = __builtin_amdgcn_readfirstlane(F.tid >> 6);
    F.G = gridDim.x; { const int bx = blockIdx.x; F.vcu = (F.G % 8 == 0) ? (bx % 8) * (F.G / 8) + bx / 8 : bx; }
    unsigned char* ws = args.ws;
    volatile LAS unsigned* MISC = (volatile LAS unsigned*)(F.lds + LDS_CTL);
    for (int u = F.tid; u < (LDS_BYTES - LDS_CTL) / 4; u += NWAVES * 64) ((LAS unsigned*)(F.lds + LDS_CTL))[u] = 0u;
    __syncthreads();
    unsigned* ctl = (unsigned*)(ws + WS_CTL);
    XcdBarrier bar = xcd_barrier_post(ctl + CW_BAR, MISC + 8);
    const int lo = args.ph_lo, hi = args.ph_hi;
#define IN(k) (lo <= (k) && (k) < hi)
#define SEAM(k) do { if (lo <= (k) && (k) + 1 < hi) xcd_barrier(bar); } while (0)
    float* ssq = (float*)(ws + WS_SSQ);
    const float* rope = (const float*)(ws + WS_ROPE);
    bf16* HB = (bf16*)(ws + WS_HB); bf16* UB = (bf16*)(ws + WS_U); bf16* YC = (bf16*)(ws + WS_YC); bf16* QT = (bf16*)(ws + WS_QT); bf16* KT = (bf16*)(ws + WS_KT); bf16* KTT = (bf16*)(ws + WS_KTT);
    float* DEC = (float*)(ws + WS_DEC); float* gssq = (float*)(ws + WS_GSSQ);

    P0Args A; A.x = args.in[0]; A.mix_g = args.in[1]; A.ab_w_in = args.in[2]; A.ab_w_out = args.in[7]; A.c_w_in = args.in[8]; A.c_w_out = args.in[12];
    A.ffn_g = args.in[13]; A.w_gate = args.in[14]; A.w_up = args.in[15]; A.w_down = args.in[16]; A.ws = ws;
    if (IN(0)) {
#pragma unroll 1
        for (int rep_ = 0; rep_ < REP_P0; ++rep_) p0_prologue(F, A);
    }
    SEAM(0);
#pragma unroll 1
    for (int L = 0; L < 2; ++L) {
        const int pb = 7 * L;
        if (IN(pb + 1)) {
            const int N = L ? CP : ABP;
            pg8::Gemm g{HB, (const bf16*)(ws + (L ? WS_WIN1 : WS_WIN0)), M, N, DM}; pg8::StaticOrder S; S.init(M, N, F.G, (int)blockIdx.x);
            pg8::EpiIn E{UB, N, ssq + (size_t)(2 * L) * M * 16, rope, L == 0 ? 1 : 0};
#pragma unroll 1
            for (int rep_ = 0; rep_ < REP_IN; ++rep_) pg8::gemm_phase<pg8::EpiIn, pg8::StaticOrder, true, true>(F.lds, g, S, E);
        }
        SEAM(pb + 1);
        if (L == 0) {
            if (IN(2)) {
#pragma unroll 1
                for (int pu = F.vcu; pu < 256; pu += F.G) {
                    const int b = pu >> 4, p = pu & 15;
#pragma unroll 1
                    for (int rep = 0; rep < 2 * REP_DSA; ++rep) dsa_unit(F, UB, YC, b, (rep & 1) ? p : 31 - p); }
#pragma unroll 1
                for (int rep_ = 0; rep_ < REP_CONV; ++rep_)
                for (int tile = F.vcu; tile < 512; tile += F.G) conv_unit(F, UB, YC, args.in[3], args.in[4], args.in[5], args.in[6], tile);
            }
            SEAM(2);
        } else {
            if (IN(9)) {
#pragma unroll 1
                for (int rep_ = 0; rep_ < REP_PREP; ++rep_)
                for (int unit = F.vcu; unit < 512; unit += F.G) gla_prep_unit(F, UB, QT, KT, KTT, DEC, args.in[9], args.in[10], unit); }
            SEAM(9);
            if (IN(10)) {
#pragma unroll 1
                for (int rep_ = 0; rep_ < REP_SCAN; ++rep_)
                for (int unit = F.vcu; unit < 256; unit += F.G) gla_scan_unit(F, UB, QT, KT, KTT, DEC, YC, rep_ + 1 < REP_SCAN ? (float*)args.out : gssq, args.in[11], unit >> 4, (unit >> 2) & 3, unit & 3);
            }
            SEAM(10);
        }
        if (IN(pb + 5)) {
            pg8::Gemm g{YC, (const bf16*)(ws + (L ? WS_WOUT1 : WS_WOUT0)), M, DM, DM}; pg8::StaticOrder S; S.init(M, DM, F.G, (int)blockIdx.x);
            pg8::EpiRes E{HB, HB, ssq + (size_t)(2 * L + 1) * M * 16, 0, L};
            if (L) { hs_table_fill(F, S, gssq); __syncthreads(); }
#if REP_OUT > 1
            { pg8::EpiRes EP{HB, QT, ssq + (size_t)5 * M * 16, PROBE_PMODE}; pg8::gemm_phase<pg8::EpiRes, pg8::StaticOrder, true, true>(F.lds, g, S, EP); }
#endif
            pg8::gemm_phase<pg8::EpiRes, pg8::StaticOrder, true, true>(F.lds, g, S, E);
        }
        SEAM(pb + 5);
        if (IN(pb + 6)) {
            pg8::Gemm g{HB, (const bf16*)(ws + (L ? WS_WGU1 : WS_WGU0)), M, GU, DM}; pg8::StaticOrder S; S.init(M, GU, F.G, (int)blockIdx.x, WGM_GU);
            pg8::EpiGLU E{UB, ssq + (size_t)(2 * L + 1) * M * 16, 0};
#if REP_GU > 1
            { pg8::EpiGLU EP{UB, ssq + (size_t)(2 * L + 1) * M * 16, PROBE_PMODE}; pg8::gemm_phase<pg8::EpiGLU, pg8::StaticOrder, true, true>(F.lds, g, S, EP); }
#endif
            pg8::gemm_phase<pg8::EpiGLU, pg8::StaticOrder, true, true>(F.lds, g, S, E);
        }
        SEAM(pb + 6);
        if (IN(pb + 7)) {
            pg8::Gemm g{UB, (const bf16*)(ws + (L ? WS_WDN1 : WS_WDN0)), M, DM, DFF}; pg8::StaticOrder S; S.init(M, DM, F.G, (int)blockIdx.x);
            pg8::EpiRes E{HB, HB, ssq + (size_t)(2 * L + 2) * M * 16, 0};
#if REP_DN > 1
            { pg8::EpiRes EP{HB, QT, ssq + (size_t)5 * M * 16, PROBE_PMODE}; pg8::gemm_phase<pg8::EpiRes, pg8::StaticOrder, true, true>(F.lds, g, S, EP); }
#endif
            pg8::gemm_phase<pg8::EpiRes, pg8::StaticOrder, true, true>(F.lds, g, S, E);
        }
        SEAM(pb + 7);
    }
    if (IN(15)) final_norm(F, HB, args.out, ssq + (size_t)4 * M * 16, args.in[17]);
#undef IN
#undef SEAM
}

extern "C" void kernel_launch(void* const* d_in, const int* in_sizes, int n_in, void* d_out, int out_size, void* d_ws, size_t ws_size, hipStream_t stream) {
    static int grid = 0;
    if (grid == 0) {
        if (n_in != 18 || in_sizes[0] != M * DM || out_size != M * DM || ws_size < WS_END) { fprintf(stderr, "kernel_launch: unexpected shapes (n_in %d, in0 %d, out %d, ws %zu); nothing launched\n", n_in, n_in > 0 ? in_sizes[0] : -1, out_size, ws_size); grid = -1; return; }
        int dev = 0, cus = 0, per_cu = 0;
        if (hipGetDevice(&dev) != hipSuccess || hipDeviceGetAttribute(&cus, hipDeviceAttributeMultiprocessorCount, dev) != hipSuccess) { grid = -1; return; }
        if (hipFuncSetAttribute((const void*)fwd, hipFuncAttributeMaxDynamicSharedMemorySize, LDS_BYTES) != hipSuccess) { fprintf(stderr, "kernel_launch: hipFuncSetAttribute failed\n"); grid = -1; return; }
        if (hipOccupancyMaxActiveBlocksPerMultiprocessor(&per_cu, (const void*)fwd, NWAVES * 64, LDS_BYTES) != hipSuccess || per_cu < 1) fprintf(stderr, "kernel_launch: occupancy query reports %d\n", per_cu);
        (void)hipGetLastError();
        grid = cus;
    }
    if (grid < 0) return;
    if (hipMemsetAsync((char*)d_ws + WS_CTL, 0, CTL_ZERO_BYTES, stream) != hipSuccess) return;
    Args a{};
    for (int i = 0; i < 18; ++i) a.in[i] = (const float*)d_in[i];
    a.out = (float*)d_out; a.ws = (unsigned char*)d_ws;
#if MK_MULTI
    for (int k = 0; k < N_PHASES; ++k) { if (k == 3 || k == 4) continue; a.ph_lo = k; a.ph_hi = k + 1; hipLaunchKernelGGL(fwd, dim3(grid), dim3(NWAVES * 64), LDS_BYTES, stream, a); }
#else
    a.ph_lo = 0; a.ph_hi = N_PHASES; hipLaunchKernelGGL(fwd, dim3(grid), dim3(NWAVES * 64), LDS_BYTES, stream, a);
#endif
}
```

```cpp
#include <hip/hip_runtime.h>
#include <cstdio>
#include <cstdint>
#ifndef REP_IN
#define REP_IN 1
#endif
#ifndef REP_GU
#define REP_GU 1
#endif
#ifndef REP_DSA12
#define REP_DSA12 1
#endif
#ifndef REP_DSA3
#define REP_DSA3 1
#endif
#ifndef REP_DSA1
#define REP_DSA1 1
#endif
#ifndef REP_DSA2
#define REP_DSA2 1
#endif
#ifndef REP_OUT
#define REP_OUT 1
#endif
#ifndef REP_DN
#define REP_DN 1
#endif
#ifndef REP_G3
#define REP_G3 1
#endif
#ifndef PROBE_PMODE
#define PROBE_PMODE 0
#endif
#ifndef WGM_GU
#define WGM_GU 2
#endif
#ifndef WGM_IN
#define WGM_IN 2
#endif
namespace pg8 {
#define PG8_LAS __attribute__((address_space(3)))
typedef unsigned short bf16_t;
typedef short bf16x8 __attribute__((ext_vector_type(8)));
typedef float f32x4 __attribute__((ext_vector_type(4)));
typedef unsigned u32x4 __attribute__((ext_vector_type(4)));
constexpr int BM = 256, BK = 64, HALF = 128, HTB = HALF * BK * 2  , STAGE_BYTES = 8 * HTB, NXCD = 8, WGM = 8;

__host__ __device__ __forceinline__ int lds_byte(int r, int c) { const int st = (r >> 4) * 2 + (c >> 5), rr = r & 15, cc = c & 31, ob = rr * 64 + cc * 2; return st * 1024 + (ob ^ (((ob >> 9) & 1) << 5)); }
__host__ __device__ __forceinline__ void stage_rc(int b, int& R, int& C) { const int st = b / 1024, sb = b % 1024, swz = sb ^ (((sb >> 9) & 1) << 5); R = (st >> 1) * 16 + swz / 64; C = (st & 1) * 32 + (swz % 64) / 2; }
__host__ __device__ __forceinline__ int perm32(int rho) { const int n = rho >> 4, i = rho & 15; return 8 * (i >> 2) + 4 * n + (i & 3); }

struct Unit { int pm, pn; };
struct Gemm { const bf16_t* A; const bf16_t* Bt; int M, N, K; };

struct StaticOrder {
    int nM, nN, nwg, G, c, wgm;
    __host__ __device__ void init(int M, int N, int G_, int c_, int wgm_ = WGM) { nM = M / BM; nN = N / BM; nwg = nM * nN; G = G_; c = c_; wgm = wgm_; }
    __host__ __device__ bool next(int i, Unit& u) const {
        const long L = (long)i * G + c; if (L >= nwg) return false;
        int wgid = (int)L; { const int q = nwg / NXCD, r = nwg % NXCD, xcd = wgid % NXCD, off = wgid / NXCD; wgid = (xcd < r ? xcd * (q + 1) : r * (q + 1) + (xcd - r) * q) + off; }
        const int nig = wgm * nN, gid = wgid / nig, fm = gid * wgm, gsz = (nM - fm) < wgm ? (nM - fm) : wgm;
        u.pm = fm + ((wgid % nig) % gsz); u.pn = (wgid % nig) / gsz; return true;
    }
    __device__ __forceinline__ void a_ready(const Unit&) const {}
    __device__ __forceinline__ void done(const Unit&) const {}
};

__device__ __forceinline__ unsigned cvt_pk_bf16(float lo, float hi) { unsigned r; asm volatile("v_cvt_pk_bf16_f32 %0, %1, %2" : "=v"(r) : "v"(lo), "v"(hi)); return r; }
typedef float f32x2 __attribute__((ext_vector_type(2)));
typedef unsigned u32x2 __attribute__((ext_vector_type(2)));
constexpr float RMS_EPS = 1e-6f;
struct EpiIn {
    static constexpr bool PERM = true, AFTER_DRAIN = false, PREF = true; static constexpr bool HS = false;
    bf16_t* O; int ldc; const float* ssq; const float* rope; int do_rope;
    __device__ __forceinline__ void pref(const Unit& u, int wr, int lane, float& p0, float& p1) const { const f32x4* s = (const f32x4*)(ssq + (size_t)(u.pm * BM + wr * 64 + lane) * 16);
        const f32x4 a0 = s[0], a1 = s[1], a2 = s[2], a3 = s[3], b0 = s[4 * HALF], b1 = s[4 * HALF + 1], b2 = s[4 * HALF + 2], b3 = s[4 * HALF + 3];
        const f32x4 sa = (a0 + a1) + (a2 + a3), sb = (b0 + b1) + (b2 + b3); p0 = (sa.x + sa.y) + (sa.z + sa.w); p1 = (sb.x + sb.y) + (sb.z + sb.w); }
    __device__ __forceinline__ void operator()(const f32x4 (&acc)[2][2][4][2], const Unit& u, int wr, int wc, int fr, int fq, float p0, float p1) const {
        const int row0 = u.pm * BM + wr * 64 + fr, cg0 = u.pn * BM + wc * 32;
#pragma unroll
        for (int ai = 0; ai < 2; ++ai)
#pragma unroll
            for (int m = 0; m < 4; ++m) {
                const int row = row0 + ai * HALF + m * 16;
                const float r = rsqrtf(__shfl(ai ? p1 : p0, fr + 16 * m) * (1.0f / 1024.0f) + RMS_EPS);
                bf16_t* rowp = O + (size_t)row * ldc + cg0 + 8 * fq;
                if (do_rope && u.pn < 4) {
                    float hh[8];
#pragma unroll
                    for (int n = 0; n < 2; ++n)
#pragma unroll
                        for (int e2 = 0; e2 < 4; ++e2) { const float a = acc[ai][0][m][n][e2] * r, g = acc[ai][1][m][n][e2] * r; hh[4 * n + e2] = a * __builtin_amdgcn_rcpf(1.0f + __expf(-g)); }
                    u32x4 w; w.x = cvt_pk_bf16(hh[0], hh[1]); w.y = cvt_pk_bf16(hh[2], hh[3]); w.z = cvt_pk_bf16(hh[4], hh[5]); w.w = cvt_pk_bf16(hh[6], hh[7]);
                    __builtin_nontemporal_store(w, (u32x4*)(O + (size_t)row * ldc + u.pn * HALF + wc * 32 + 8 * fq));
                    continue;
                }
#pragma unroll
                for (int bj = 0; bj < 2; ++bj) {
                    f32x4 v0 = acc[ai][bj][m][0] * r, v1 = acc[ai][bj][m][1] * r;
                    const int cg = cg0 + bj * HALF;
                    const bool rp = do_rope && ((cg & 63) == 0) && ((cg >= 1024 && cg < 1600) || (cg >= 1664 && cg < 2240));
                    if (rp) {
                        const float* cs = rope + (row & 2047) * 16;
                        const f32x4 c0 = *(const f32x4*)cs, c1 = *(const f32x4*)(cs + 4), s0 = *(const f32x4*)(cs + 8), s1 = *(const f32x4*)(cs + 12);
                        f32x4 p0, p1;
#pragma unroll
                        for (int e = 0; e < 4; ++e) { p0[e] = __shfl_xor(v0[e], 16); p1[e] = __shfl_xor(v1[e], 16); }
                        const float sg = (fq == 0) ? -1.0f : 1.0f;
                        if (fq < 2) { v0 = v0 * c0 + p0 * s0 * sg; v1 = v1 * c1 + p1 * s1 * sg; }
                    }
                    u32x4 w; w.x = cvt_pk_bf16(v0[0], v0[1]); w.y = cvt_pk_bf16(v0[2], v0[3]); w.z = cvt_pk_bf16(v1[0], v1[1]); w.w = cvt_pk_bf16(v1[2], v1[3]);
                    __builtin_nontemporal_store(w, (u32x4*)(rowp + bj * HALF));
                }
            }
    }
};
struct EpiRes {
    static constexpr bool PERM = true, AFTER_DRAIN = false, PREF = false; static constexpr bool HS = true;
    const bf16_t* hin; bf16_t* hb; float* ssq; int pmode;
    int hs_on;
    __device__ __forceinline__ void rescale(f32x4 (&acc)[2][2][4][2], int ui, int k) const {
        int t2 = threadIdx.x; asm volatile("" : "+v"(t2));
        const PG8_LAS float* T = (const PG8_LAS float*)(unsigned)(131072u + (unsigned)(((ui * 4 + k) * 256 + ((t2 >> 8) & 1) * 64 + (t2 & 15)) * 4));
#pragma unroll
        for (int ai = 0; ai < 2; ++ai)
#pragma unroll
            for (int m = 0; m < 4; ++m) { const float s = T[ai * HALF + m * 16];
#pragma unroll
                for (int bj = 0; bj < 2; ++bj)
#pragma unroll
                    for (int n = 0; n < 2; ++n) acc[ai][bj][m][n] = acc[ai][bj][m][n] * s; }
    }
    __device__ __forceinline__ void operator()(const f32x4 (&acc)[2][2][4][2], const Unit& u, int wr, int wc, int fr, int fq) const {
        const int row0 = u.pm * BM + wr * 64 + fr, col0 = u.pn * BM + wc * 32 + 8 * fq;
#pragma unroll
        for (int ai = 0; ai < 2; ++ai)
#pragma unroll
            for (int m = 0; m < 4; ++m) {
                const int row = row0 + ai * HALF + m * 16; const size_t ro = (size_t)row * 1024 + col0; float s = 0.f;
                u32x4 old[2];
#pragma unroll
                for (int bj = 0; bj < 2; ++bj) { if (pmode >= 1) old[bj] = (u32x4){0u, 0u, 0u, 0u}; else old[bj] = *(const u32x4*)(hin + ro + bj * HALF); }
#pragma unroll
                for (int bj = 0; bj < 2; ++bj) {
                    f32x4 v0 = acc[ai][bj][m][0], v1 = acc[ai][bj][m][1];
                    v0[0] += __builtin_bit_cast(float, old[bj].x << 16); v0[1] += __builtin_bit_cast(float, old[bj].x & 0xffff0000u);
                    v0[2] += __builtin_bit_cast(float, old[bj].y << 16); v0[3] += __builtin_bit_cast(float, old[bj].y & 0xffff0000u);
                    v1[0] += __builtin_bit_cast(float, old[bj].z << 16); v1[1] += __builtin_bit_cast(float, old[bj].z & 0xffff0000u);
                    v1[2] += __builtin_bit_cast(float, old[bj].w << 16); v1[3] += __builtin_bit_cast(float, old[bj].w & 0xffff0000u);
                    u32x4 w; w.x = cvt_pk_bf16(v0[0], v0[1]); w.y = cvt_pk_bf16(v0[2], v0[3]); w.z = cvt_pk_bf16(v1[0], v1[1]); w.w = cvt_pk_bf16(v1[2], v1[3]);
                    if (pmode < 3) __builtin_nontemporal_store(w, (u32x4*)(hb + ro + bj * HALF));
                    s += ((v0[0] * v0[0] + v0[1] * v0[1]) + (v0[2] * v0[2] + v0[3] * v0[3])) + ((v1[0] * v1[0] + v1[1] * v1[1]) + (v1[2] * v1[2] + v1[3] * v1[3]));
                }
                s += __shfl_xor(s, 16); s += __shfl_xor(s, 32);
                if (fq == 0 && pmode < 2) ssq[(size_t)row * 16 + u.pn * 4 + wc] = s;
                if (pmode >= 3 && s == 12345.678f) hb[ro] = 0;
                if (m & 1) asm volatile("" ::: "memory");
            }
    }
};
struct EpiGLU {
    static constexpr bool PERM = true, AFTER_DRAIN = false, PREF = true; static constexpr bool HS = false;
    bf16_t* O; const float* ssq; int pmode;
    __device__ __forceinline__ void pref(const Unit& u, int wr, int lane, float& p0, float& p1) const { const f32x4* s = (const f32x4*)(ssq + (size_t)(u.pm * BM + wr * 64 + lane) * 16);
        const f32x4 a0 = s[0], a1 = s[1], a2 = s[2], a3 = s[3], b0 = s[4 * HALF], b1 = s[4 * HALF + 1], b2 = s[4 * HALF + 2], b3 = s[4 * HALF + 3];
        const f32x4 sa = (a0 + a1) + (a2 + a3), sb = (b0 + b1) + (b2 + b3); p0 = (sa.x + sa.y) + (sa.z + sa.w); p1 = (sb.x + sb.y) + (sb.z + sb.w); }
    __device__ __forceinline__ void operator()(const f32x4 (&acc)[2][2][4][2], const Unit& u, int wr, int wc, int fr, int fq, float p0, float p1) const {
        const int row0 = u.pm * BM + wr * 64 + fr, col0 = u.pn * HALF + wc * 32 + 8 * fq;
#pragma unroll
        for (int ai = 0; ai < 2; ++ai)
#pragma unroll
            for (int m = 0; m < 4; ++m) {
                const int row = row0 + ai * HALF + m * 16;
                const float r = rsqrtf(__shfl(ai ? p1 : p0, fr + 16 * m) * (1.0f / 1024.0f) + RMS_EPS);
                float a[8];
#pragma unroll
                for (int n = 0; n < 2; ++n)
#pragma unroll
                    for (int e = 0; e < 4; ++e) { const float g = acc[ai][0][m][n][e] * r, up = acc[ai][1][m][n][e] * r;
                        a[4 * n + e] = (pmode >= 1) ? (g + up) : g * __builtin_amdgcn_rcpf(1.0f + __expf(-g)) * up; }
                u32x4 w; w.x = cvt_pk_bf16(a[0], a[1]); w.y = cvt_pk_bf16(a[2], a[3]); w.z = cvt_pk_bf16(a[4], a[5]); w.w = cvt_pk_bf16(a[6], a[7]);
                if (pmode < 2 || a[0] == 12345.678f) __builtin_nontemporal_store(w, (u32x4*)(O + (size_t)row * 2816 + col0));
            }
    }
};

template <class Epi, class Sched, bool ALIGN_EPI = false, bool SP2 = false>
__device__ __forceinline__ void gemm_phase(PG8_LAS unsigned char* lds, const Gemm g, const Sched& S, const Epi& E) {
    int tid_ = threadIdx.x; asm volatile("" : "+v"(tid_));
    const int tid = tid_, wid = __builtin_amdgcn_readfirstlane(tid >> 6), lane = tid & 63, wr = wid >> 2, wc = wid & 3, fr = lane & 15, fq = lane >> 4;
    const int K = g.K, nt = K / BK;
    unsigned voffA[2], voffB[2];
#pragma unroll
    for (int i = 0; i < 2; ++i) { int R, C; stage_rc(tid * 16 + i * 8192, R, C); const int Rb = Epi::PERM ? ((R & ~31) + perm32(R & 31)) : R;
        voffA[i] = (unsigned)(R * K + C) * 2u; voffB[i] = (unsigned)(Rb * K + C) * 2u; }
    const size_t kstep = (size_t)(BK * 2);
    const size_t hstep = (size_t)HALF * K * 2;
    const size_t tstep = 2 * hstep;
    const unsigned ldsw = (unsigned)wid * 1024u;
    const int aoff = lds_byte(wr * 64 + fr, fq * 8), boff = lds_byte(wc * 32 + fr, fq * 8);
#define PG8_SA(b, h) (((b) * 2 + (h)) * HTB)
#define PG8_SB(b, h) ((4 + (b) * 2 + (h)) * HTB)
#define PG8_STAGE(bufoff, gbase, voff) do { _Pragma("unroll") for (int _i = 0; _i < 2; ++_i) \
        __builtin_amdgcn_global_load_lds((const unsigned*)((const char*)(gbase) + (voff)[_i]), (PG8_LAS unsigned*)(lds + (bufoff) + ldsw + _i * 8192), 16, 0, 0); } while (0)
#define PG8_LDA(dst, b, h) do { _Pragma("unroll") for (int m = 0; m < 4; ++m) _Pragma("unroll") for (int k = 0; k < 2; ++k) dst[m][k] = *(const PG8_LAS bf16x8*)(lds + PG8_SA(b, h) + aoff + m * 2048 + k * 1024); } while (0)
#define PG8_LDB(dst, b, h) do { _Pragma("unroll") for (int n = 0; n < 2; ++n) _Pragma("unroll") for (int k = 0; k < 2; ++k) dst[n][k] = *(const PG8_LAS bf16x8*)(lds + PG8_SB(b, h) + boff + n * 2048 + k * 1024); } while (0)
#define PG8_MMA(ai, bj, At, Bt) do { __builtin_amdgcn_s_setprio(1); _Pragma("unroll") for (int m = 0; m < 4; ++m) _Pragma("unroll") for (int n = 0; n < 2; ++n) _Pragma("unroll") for (int k = 0; k < 2; ++k) \
        acc[ai][bj][m][n] = __builtin_amdgcn_mfma_f32_16x16x32_bf16(Bt[n][k], At[m][k], acc[ai][bj][m][n], 0, 0, 0); __builtin_amdgcn_s_setprio(0); } while (0)
#define PG8_WAIT_V(n) asm volatile("s_waitcnt vmcnt(" #n ")" ::: "memory")
#define PG8_WAIT_L(n) asm volatile("s_waitcnt lgkmcnt(" #n ")" ::: "memory")
#define PG8_BAR __builtin_amdgcn_s_barrier()
#define PG8_SCHED __builtin_amdgcn_sched_barrier(0)
    Unit cur, nxt; int ui = 0;
    if (!S.next(0, cur)) return;
    f32x4 acc[2][2][4][2];
#pragma unroll
    for (int a = 0; a < 2; ++a)
#pragma unroll
        for (int b = 0; b < 2; ++b)
#pragma unroll
            for (int m = 0; m < 4; ++m)
#pragma unroll
                for (int n = 0; n < 2; ++n) acc[a][b][m][n] = (f32x4){0.f, 0.f, 0.f, 0.f};
    bf16x8 At[4][2], B0[2][2], B1[2][2];
    const char* cA = (const char*)g.A + (size_t)cur.pm * tstep; const char* cB = (const char*)g.Bt + (size_t)cur.pn * tstep;
    float pf0 = 0.f, pf1 = 0.f;
    if constexpr (Epi::PREF) E.pref(cur, wr, lane, pf0, pf1);
    S.a_ready(cur);
    if constexpr (SP2) {
        PG8_STAGE(PG8_SB(0, 0), cB, voffB); PG8_STAGE(PG8_SB(0, 1), cB + hstep, voffB); PG8_STAGE(PG8_SA(0, 0), cA, voffA); PG8_STAGE(PG8_SA(0, 1), cA + hstep, voffA);
        if (wr == 1) PG8_BAR;
        PG8_WAIT_V(2); PG8_BAR;
        PG8_STAGE(PG8_SB(1, 0), cB + kstep, voffB); PG8_STAGE(PG8_SA(1, 0), cA + kstep, voffA); PG8_STAGE(PG8_SB(1, 1), cB + hstep + kstep, voffB);
        PG8_WAIT_V(6); PG8_BAR;
    } else {
        PG8_STAGE(PG8_SB(0, 0), cB, voffB); PG8_STAGE(PG8_SA(0, 0), cA, voffA); PG8_STAGE(PG8_SB(0, 1), cB + hstep, voffB); PG8_STAGE(PG8_SA(0, 1), cA + hstep, voffA);
        if (wr == 1) PG8_BAR;
        PG8_WAIT_V(4); PG8_BAR;
        PG8_STAGE(PG8_SB(1, 0), cB + kstep, voffB); PG8_STAGE(PG8_SA(1, 0), cA + kstep, voffA); PG8_STAGE(PG8_SB(1, 1), cB + hstep + kstep, voffB);
        PG8_WAIT_V(6); PG8_BAR;
    }
    for (;;) {
        const bool has_next = S.next(ui + 1, nxt);
        const char* nA = has_next ? (const char*)g.A + (size_t)nxt.pm * tstep : cA; const char* nB = has_next ? (const char*)g.Bt + (size_t)nxt.pn * tstep : cB;
        int tseg = nt; if constexpr (Epi::HS) { if (E.hs_on) tseg = 4; }
#pragma unroll 1
        for (int t0 = 0; t0 < nt; t0 += tseg) {
        if constexpr (Epi::HS) { if (t0 != 0) E.rescale(acc, ui & 3, (t0 >> 2) - 1); }
#pragma unroll 1
        for (int t = t0; t < t0 + tseg; t += 2) {
            const bool last = (t == nt - 2);
            const char* a1 = cA + (size_t)(t + 1) * kstep;
            const char* a2 = last ? nA : cA + (size_t)(t + 2) * kstep; const char* b2 = last ? nB : cB + (size_t)(t + 2) * kstep;
            const char* a3 = a2 + kstep; const char* b3 = b2 + kstep;
            if (last && has_next) S.a_ready(nxt);
            if constexpr (SP2) {
            PG8_LDB(B0, 0, 0); PG8_LDB(B1, 0, 1); PG8_SCHED; PG8_LDA(At, 0, 0); PG8_STAGE(PG8_SA(1, 1), a1 + hstep, voffA);
            PG8_WAIT_V(8); PG8_WAIT_L(0); PG8_BAR; PG8_MMA(0, 0, At, B0); PG8_MMA(0, 1, At, B1); PG8_BAR; PG8_SCHED;
            PG8_LDA(At, 0, 1); PG8_STAGE(PG8_SB(0, 0), b2, voffB); PG8_STAGE(PG8_SB(0, 1), b2 + hstep, voffB); PG8_STAGE(PG8_SA(0, 0), a2, voffA);
            PG8_WAIT_V(8); PG8_WAIT_L(0); PG8_BAR; PG8_MMA(1, 0, At, B0); PG8_MMA(1, 1, At, B1); PG8_BAR; PG8_SCHED;
            PG8_LDB(B0, 1, 0); PG8_LDB(B1, 1, 1); PG8_SCHED; PG8_LDA(At, 1, 0); PG8_STAGE(PG8_SA(0, 1), a2 + hstep, voffA);
            PG8_WAIT_V(8); PG8_WAIT_L(0); PG8_BAR; PG8_MMA(0, 0, At, B0); PG8_MMA(0, 1, At, B1); PG8_BAR; PG8_SCHED;
            PG8_LDA(At, 1, 1); PG8_STAGE(PG8_SB(1, 0), b3, voffB); PG8_STAGE(PG8_SB(1, 1), b3 + hstep, voffB); PG8_STAGE(PG8_SA(1, 0), a3, voffA);
            PG8_WAIT_V(8); PG8_WAIT_L(0); PG8_BAR; PG8_MMA(1, 0, At, B0); PG8_MMA(1, 1, At, B1); PG8_BAR; PG8_SCHED;
            } else {
            PG8_LDB(B0, 0, 0); PG8_SCHED; PG8_LDA(At, 0, 0); PG8_STAGE(PG8_SA(1, 1), a1 + hstep, voffA);
            PG8_WAIT_L(8); PG8_BAR; PG8_WAIT_L(0); PG8_MMA(0, 0, At, B0); PG8_BAR; PG8_SCHED;
            PG8_LDB(B1, 0, 1); PG8_STAGE(PG8_SB(0, 0), b2, voffB);
            PG8_BAR; PG8_WAIT_L(0); PG8_MMA(0, 1, At, B1); PG8_BAR;
            PG8_LDA(At, 0, 1); PG8_STAGE(PG8_SA(0, 0), a2, voffA);
            PG8_BAR; PG8_WAIT_L(0); PG8_MMA(1, 0, At, B0); PG8_BAR; PG8_SCHED;
            PG8_STAGE(PG8_SB(0, 1), b2 + hstep, voffB);
            PG8_WAIT_V(6); PG8_BAR; PG8_MMA(1, 1, At, B1); PG8_BAR;
            PG8_LDB(B0, 1, 0); PG8_SCHED; PG8_LDA(At, 1, 0); PG8_STAGE(PG8_SA(0, 1), a2 + hstep, voffA);
            PG8_WAIT_L(8); PG8_BAR; PG8_WAIT_L(0); PG8_MMA(0, 0, At, B0); PG8_BAR; PG8_SCHED;
            PG8_LDB(B1, 1, 1); PG8_STAGE(PG8_SB(1, 0), b3, voffB);
            PG8_BAR; PG8_WAIT_L(0); PG8_MMA(0, 1, At, B1); PG8_BAR;
            PG8_LDA(At, 1, 1); PG8_STAGE(PG8_SA(1, 0), a3, voffA);
            PG8_BAR; PG8_WAIT_L(0); PG8_MMA(1, 0, At, B0); PG8_BAR; PG8_SCHED;
            PG8_STAGE(PG8_SB(1, 1), b3 + hstep, voffB);
            PG8_WAIT_V(6); PG8_BAR; PG8_MMA(1, 1, At, B1); PG8_BAR;
            }
        }
        }
        if constexpr (ALIGN_EPI) { if (wr == 0) PG8_BAR; }
        if constexpr (Epi::HS) { if (E.hs_on) E.rescale(acc, ui & 3, 3); }
        if constexpr (!Epi::AFTER_DRAIN) { if constexpr (Epi::PREF) { E(acc, cur, wr, wc, fr, fq, pf0, pf1); if (has_next) E.pref(nxt, wr, lane, pf0, pf1); } else E(acc, cur, wr, wc, fr, fq); S.done(cur); }
        if (!has_next) break;
#pragma unroll
        for (int a = 0; a < 2; ++a)
#pragma unroll
            for (int b = 0; b < 2; ++b)
#pragma unroll
                for (int m = 0; m < 4; ++m)
#pragma unroll
                    for (int n = 0; n < 2; ++n) acc[a][b][m][n] = (f32x4){0.f, 0.f, 0.f, 0.f};
        cur = nxt; cA = nA; cB = nB; ++ui;
        if constexpr (ALIGN_EPI) { if (wr == 1) PG8_BAR; }
    }
    PG8_WAIT_V(0);
    if constexpr (!ALIGN_EPI) { if (wr == 0) PG8_BAR; }
    PG8_BAR;
    if constexpr (Epi::AFTER_DRAIN) { E.fused(acc, cur, wr, wc, fr, fq, lds, wid, lane); S.done(cur); }
#undef PG8_SA
#undef PG8_SB
#undef PG8_STAGE
#undef PG8_LDA
#undef PG8_LDB
#undef PG8_MMA
#undef PG8_WAIT_V
#undef PG8_WAIT_L
#undef PG8_BAR
#undef PG8_SCHED
}
}
constexpr int NWAVES = 8;
constexpr int NB = 16, SEQ = 2048, DM = 1024, M = NB * SEQ;
constexpr int ABN = 2248, ABP = 2304, CN = 3088, CP = 3328, DFF = 2816, GU = 2 * DFF;
constexpr int AB_G = 512, AB_Q = 1024, AB_K = 1536, AB_V = 1600, AB_IQ = 1664, AB_IK = 2176, AB_IW = 2240;
constexpr int C_K = 512, C_V = 1024, C_R = 2048, C_GL = 3072;
constexpr float EPS = 1e-6f;
constexpr size_t MiB = 1u << 20;
constexpr size_t WS_CTL = 0, CTL_ZERO_BYTES = 1 * MiB;
constexpr size_t WS_ROPE = 5 * MiB / 2, WS_DEC = 3 * MiB;
constexpr size_t WS_WIN0 = 4 * MiB, WS_WIN1 = WS_WIN0 + (size_t)ABP * DM * 2, WS_WOUT0 = WS_WIN1 + (size_t)CP * DM * 2, WS_WOUT1 = WS_WOUT0 + 2 * MiB;
constexpr size_t WS_WGU0 = WS_WOUT1 + 2 * MiB, WS_WGU1 = WS_WGU0 + (size_t)GU * DM * 2, WS_WDN0 = WS_WGU1 + (size_t)GU * DM * 2, WS_WDN1 = WS_WDN0 + (size_t)DM * DFF * 2;
constexpr size_t WS_HB = 52 * MiB, WS_U = 116 * MiB, WS_YC = 324 * MiB, WS_QT = 388 * MiB, WS_KT = 420 * MiB, WS_KTT = 452 * MiB, WS_SSQ = 484 * MiB, WS_GSSQ = 496 * MiB, WS_END = 504 * MiB;
static_assert(WS_WDN1 + (size_t)DM * DFF * 2 <= WS_HB && WS_HB + (size_t)M * DM * 2 <= WS_U && WS_U + (size_t)M * CP * 2 <= WS_YC && WS_YC + (size_t)M * DM * 2 <= WS_QT && WS_QT + (size_t)M * 512 * 2 <= WS_KT && WS_KT + (size_t)M * 512 * 2 <= WS_KTT && WS_KTT + (size_t)M * 512 * 2 <= WS_SSQ && WS_SSQ + (size_t)6 * M * 64 <= WS_GSSQ && WS_GSSQ + (size_t)M * 256 <= WS_END, "d_ws map");
constexpr int CW_BAR = 4096;
constexpr int SC_STRIDE = 2064;
constexpr int LDS_BM = 16 * SC_STRIDE * 4;
constexpr int LDS_CTL = LDS_BM + 16384;
constexpr int LDS_MT3 = LDS_CTL + 1024;
constexpr int LDS_BYTES = LDS_MT3 + 4096;
#define GAS __attribute__((address_space(1)))
#define LAS __attribute__((address_space(3)))
typedef unsigned short bf16;
typedef unsigned v4u __attribute__((ext_vector_type(4)));
typedef unsigned v2u __attribute__((ext_vector_type(2)));
typedef float f32x4 __attribute__((ext_vector_type(4)));
typedef float f32x16 __attribute__((ext_vector_type(16)));
typedef short bf16x8 __attribute__((ext_vector_type(8)));
#define LDS_WAIT() asm volatile("s_waitcnt lgkmcnt(0)" ::: "memory")
#define LDS_BARRIER() do { asm volatile("s_waitcnt lgkmcnt(0)" ::: "memory"); __builtin_amdgcn_s_barrier(); asm volatile("" ::: "memory"); } while (0)
typedef __bf16 bf16pair_t __attribute__((ext_vector_type(2)));
__device__ __forceinline__ unsigned pk2(float lo, float hi) { bf16pair_t v; v.x = (__bf16)lo; v.y = (__bf16)hi; return __builtin_bit_cast(unsigned, v); }
__device__ __forceinline__ unsigned f2bf(float f) { return pk2(f, 0.f) & 0xffffu; }
__device__ __forceinline__ float fexp2(float x) { return __builtin_amdgcn_exp2f(x); }
__device__ __forceinline__ float fexp(float x) { return __builtin_amdgcn_exp2f(x * 1.44269504089f); }
__device__ __forceinline__ float frcp(float x) { return __builtin_amdgcn_rcpf(x); }
__device__ __forceinline__ float fsilu(float x) { return x * __builtin_amdgcn_rcpf(1.0f + __builtin_amdgcn_exp2f(-1.44269504089f * x)); }
__device__ __forceinline__ float bf2f(unsigned b) { return __builtin_bit_cast(float, b << 16); }
__device__ __forceinline__ float wave_sum(float v) {
#pragma unroll
    for (int o = 1; o < 64; o <<= 1) v += __shfl_xor(v, o);
    return v;
}
__device__ __forceinline__ int wave_isum(int v) {
    v += __builtin_amdgcn_update_dpp(0, v, 0xB1, 0xf, 0xf, false);
    v += __builtin_amdgcn_update_dpp(0, v, 0x4E, 0xf, 0xf, false);
    v += __builtin_amdgcn_update_dpp(0, v, 0x141, 0xf, 0xf, false);
    v += __builtin_amdgcn_update_dpp(0, v, 0x140, 0xf, 0xf, false);
    v += __builtin_amdgcn_update_dpp(0, v, 0x142, 0xa, 0xf, false);
    v += __builtin_amdgcn_update_dpp(0, v, 0x143, 0xc, 0xf, false);
    return __builtin_amdgcn_readlane(v, 63);
}
__device__ __forceinline__ float wave_fsum(float v) {
#define DPPZ(v, ctl, rmask) __builtin_bit_cast(float, __builtin_amdgcn_update_dpp(0, __builtin_bit_cast(int, v), ctl, rmask, 0xf, false))
    v += DPPZ(v, 0xB1, 0xf); v += DPPZ(v, 0x4E, 0xf); v += DPPZ(v, 0x141, 0xf); v += DPPZ(v, 0x140, 0xf); v += DPPZ(v, 0x142, 0xa); v += DPPZ(v, 0x143, 0xc);
#undef DPPZ
    return __builtin_bit_cast(float, __builtin_amdgcn_readlane(__builtin_bit_cast(int, v), 63));
}
#define DPPF(v, ctl, rmask) __builtin_bit_cast(float, __builtin_amdgcn_update_dpp(__builtin_bit_cast(int, v), __builtin_bit_cast(int, v), ctl, rmask, 0xf, false))
__device__ __forceinline__ float wave_fmax(float v) {
    v = fmaxf(v, DPPF(v, 0xB1, 0xf)); v = fmaxf(v, DPPF(v, 0x4E, 0xf)); v = fmaxf(v, DPPF(v, 0x141, 0xf)); v = fmaxf(v, DPPF(v, 0x140, 0xf));
    v = fmaxf(v, DPPF(v, 0x142, 0xa)); v = fmaxf(v, DPPF(v, 0x143, 0xc));
    return __builtin_bit_cast(float, __builtin_amdgcn_readlane(__builtin_bit_cast(int, v), 63));
}
__device__ __forceinline__ float wave_fmin(float v) {
    v = fminf(v, DPPF(v, 0xB1, 0xf)); v = fminf(v, DPPF(v, 0x4E, 0xf)); v = fminf(v, DPPF(v, 0x141, 0xf)); v = fminf(v, DPPF(v, 0x140, 0xf));
    v = fminf(v, DPPF(v, 0x142, 0xa)); v = fminf(v, DPPF(v, 0x143, 0xc));
    return __builtin_bit_cast(float, __builtin_amdgcn_readlane(__builtin_bit_cast(int, v), 63));
}
__device__ __forceinline__ f32x4 mfma16(bf16x8 a, bf16x8 b, f32x4 c) { return __builtin_amdgcn_mfma_f32_16x16x32_bf16(a, b, c, 0, 0, 0); }
__device__ __forceinline__ f32x16 mfma32(bf16x8 a, bf16x8 b, f32x16 c) { return __builtin_amdgcn_mfma_f32_32x32x16_bf16(a, b, c, 0, 0, 0); }
__device__ __forceinline__ bf16x8 mk8(v2u lo, v2u hi) { v4u t; t.x = lo.x; t.y = lo.y; t.z = hi.x; t.w = hi.y; return __builtin_bit_cast(bf16x8, t); }
__device__ __forceinline__ bf16x8 pack8(float a0, float a1, float a2, float a3, float a4, float a5, float a6, float a7) {
    v4u t; t.x = pk2(a0, a1); t.y = pk2(a2, a3); t.z = pk2(a4, a5); t.w = pk2(a6, a7); return __builtin_bit_cast(bf16x8, t); }

#define XB_TMO      128
#define XB_XCNT(j)  (256  + 64 * (j))
#define XB_XSUB(j)  (1280 + 64 * (j))
#define XB_XGEN(j)  (2304 + 64 * (j))
#define XB_TOP      3328
#define XB_TOPGEN   3392
#define XCD_BAR_WORDS 3456
#define XB_SPIN_CAP (1u << 18)

__device__ __forceinline__ unsigned xb_ld(unsigned* p)              { return __hip_atomic_load(p, __ATOMIC_RELAXED, __HIP_MEMORY_SCOPE_AGENT); }
__device__ __forceinline__ unsigned xb_add(unsigned* p, unsigned v) { return __hip_atomic_fetch_add(p, v, __ATOMIC_RELAXED, __HIP_MEMORY_SCOPE_AGENT); }
__device__ __forceinline__ unsigned xb_xcc_id() { return (unsigned)__builtin_amdgcn_s_getreg((3 << 11) | 20) & 0xFu; }
#define XB_SPIN(cond, bar) do { unsigned _sp = 0; while (cond) { __builtin_amdgcn_s_sleep(1); \
    if ((++_sp & 255u) == 0u) { if (xb_ld(&(bar)[XB_TMO])) break; if (_sp > XB_SPIN_CAP) { atomicAdd(&(bar)[XB_TMO], 1u); break; } } } } while (0)

struct XcdBarrier {
    unsigned* bar; unsigned x;
    volatile LAS unsigned* st;
};

__device__ __forceinline__ XcdBarrier xcd_barrier_post(unsigned* bar, volatile LAS unsigned* st) {
    XcdBarrier b; b.bar = bar; b.x = xb_xcc_id(); b.st = st;
    if (threadIdx.x == 0) (void)xb_add(&bar[XB_XCNT(b.x)], 1u);
    return b;
}
__device__ __forceinline__ void xcd_barrier_complete(unsigned* bar, unsigned x, unsigned& nloc, unsigned& nx) {
    const unsigned G = gridDim.x * gridDim.y * gridDim.z;
    unsigned sum, cnt, mine, sp = 0u;
    for (;;) {
        sum = 0u; cnt = 0u; mine = 0u;
#pragma unroll
        for (unsigned j = 0; j < 16; ++j) { const unsigned c = xb_ld(&bar[XB_XCNT(j)]); sum += c; cnt += (c > 0u) ? 1u : 0u; mine = (j == x) ? c : mine; }
        if (sum == G) break;
        __builtin_amdgcn_s_sleep(1);
        if ((++sp & 255u) == 0u) { if (xb_ld(&bar[XB_TMO])) break; if (sp > XB_SPIN_CAP) { atomicAdd(&bar[XB_TMO], 1u); break; } }
    }
    nloc = mine > 0u ? mine : 1u; nx = cnt > 0u ? cnt : 1u;
}

__device__ __forceinline__ void xcd_barrier(const XcdBarrier& b) {
    asm volatile("s_waitcnt vmcnt(0)" ::: "memory");
    __syncthreads();
    if (threadIdx.x == 0) {
        unsigned* bar = b.bar;
        __builtin_amdgcn_s_waitcnt(0);
        unsigned nloc = b.st[0], nx = b.st[1];
        if (nloc == 0u) { xcd_barrier_complete(bar, b.x, nloc, nx); b.st[0] = nloc; b.st[1] = nx; }
        asm volatile("buffer_inv sc1" ::: "memory");
        const unsigned old = xb_add(&bar[XB_XSUB(b.x)], 1u);
        const unsigned gen = old / nloc;
        if (old + 1u == (gen + 1u) * nloc) {
            __builtin_amdgcn_fence(__ATOMIC_RELEASE, "agent");
            asm volatile("s_waitcnt vmcnt(0)" ::: "memory");
            const unsigned og = xb_add(&bar[XB_TOP], 1u);
            const unsigned tg = og / nx;
            if (og + 1u == (tg + 1u) * nx) xb_add(&bar[XB_TOPGEN], 1u);
            else XB_SPIN(xb_ld(&bar[XB_TOPGEN]) == tg, bar);
            asm volatile("s_waitcnt vmcnt(0)" ::: "memory");
            xb_add(&bar[XB_XGEN(b.x)], 1u);
            asm volatile("s_waitcnt vmcnt(0)" ::: "memory");
        } else {
            XB_SPIN(xb_ld(&bar[XB_XGEN(b.x)]) == gen, bar);
            asm volatile("s_waitcnt vmcnt(0)" ::: "memory");
            asm volatile("s_waitcnt vmcnt(0)" ::: "memory");
        }
    }
    __syncthreads();
}

#define GB_CNT(g, x) (3520 + 16 * (g) + (x))
#define GB_ARR(g)    (3712 + 64 * (g))
__device__ __forceinline__ void grp_barrier_post(unsigned* bar) { if (threadIdx.x == 0) (void)xb_add(&bar[GB_CNT(blockIdx.x & 7u, xb_xcc_id())], 1u); }
__device__ __forceinline__ void grp_barrier_mode(unsigned* bar, volatile LAS unsigned* st) {
    const unsigned t = threadIdx.x;
    if (t < 128u) {
        const bool full = xb_ld(&bar[GB_CNT(t >> 4, t & 15u)]) == 32u;
        const unsigned long long m = __ballot(full);
        const unsigned ok = ((m & 0xffffull) != 0ull) && (((m >> 16) & 0xffffull) != 0ull) && (((m >> 32) & 0xffffull) != 0ull) && (((m >> 48) & 0xffffull) != 0ull);
        if ((t & 63u) == 0u) st[1 + (t >> 6)] = ok;
    }
    __syncthreads();
    if (t == 0) st[0] = (gridDim.x == 256u && st[1] && st[2]) ? 1u : 0u;
    __syncthreads();
}
__device__ __forceinline__ void grp_barrier(unsigned* bar, volatile LAS unsigned* st) {
    asm volatile("s_waitcnt vmcnt(0)" ::: "memory");
    __syncthreads();
    if (threadIdx.x == 0) {
        __builtin_amdgcn_s_waitcnt(0);
        unsigned* a = &bar[GB_ARR(blockIdx.x & 7u)];
        asm volatile("buffer_inv sc1" ::: "memory");
        const unsigned gen = st[3]; st[3] = gen + 1u;
        const unsigned target = (gen + 1u) * 32u;
        (void)xb_add(a, 1u);
        XB_SPIN(xb_ld(a) < target, bar);
        asm volatile("s_waitcnt vmcnt(0)" ::: "memory");
    }
    __syncthreads();
}

#define GB_WD(l) (4352 + 64 * (l))
__device__ __forceinline__ void wconv_done(unsigned* bar, int l) {
    asm volatile("s_waitcnt vmcnt(0)" ::: "memory");
    __syncthreads();
    if (threadIdx.x == 0) { __builtin_amdgcn_fence(__ATOMIC_RELEASE, "agent"); asm volatile("s_waitcnt vmcnt(0)" ::: "memory"); (void)xb_add(&bar[GB_WD(l)], 1u); }
}
__device__ __forceinline__ void wconv_wait(unsigned* bar, int l, unsigned expected) {
    if (threadIdx.x == 0) { XB_SPIN(xb_ld(&bar[GB_WD(l)]) < expected, bar); }
    __syncthreads();
}

struct Frame { LAS unsigned char* lds; int tid, lane, wave, vcu, G; };
#define LAUNDER_TID() int tid_l_ = threadIdx.x; asm volatile("" : "+v"(tid_l_)); const int tid = tid_l_, lane = tid & 63; (void)tid; (void)lane

__device__ __forceinline__ void p0_item(const float* W, int K, int N, const float* gain, bf16* WT, int drow0, int k0, int n0, LAS float* scr, int lane) {
    const int n_ = n0 + (lane & 31), nc_ = n_ < N ? n_ : N - 1; const float keep_ = n_ < N ? 1.f : 0.f;
    {
        float v[32], gv[32];
#pragma unroll
        for (int i = 0; i < 32; ++i) v[i] = __builtin_nontemporal_load(W + (size_t)(k0 + 2 * i + (lane >> 5)) * N + nc_);
#pragma unroll
        for (int i = 0; i < 32; ++i) gv[i] = gain ? gain[k0 + 2 * i + (lane >> 5)] : 1.0f;
#pragma unroll
        for (int i = 0; i < 32; ++i) { const int kk = 2 * i + (lane >> 5); scr[kk * 33 + (lane & 31)] = v[i] * keep_ * gv[i]; }
    }
    LDS_WAIT(); asm volatile("" ::: "memory");
    const int c = lane & 7;
#pragma unroll
    for (int j = 0; j < 4; ++j) { const int n = (lane >> 3) + 8 * j; const LAS float* s = scr + (8 * c) * 33 + n;
        v4u o; o.x = pk2(s[0 * 33], s[1 * 33]); o.y = pk2(s[2 * 33], s[3 * 33]); o.z = pk2(s[4 * 33], s[5 * 33]); o.w = pk2(s[6 * 33], s[7 * 33]);
        *(v4u*)(WT + (size_t)(drow0 + n) * K + k0 + 8 * c) = o; }
    LDS_WAIT(); asm volatile("" ::: "memory");
}
struct P0Args { const float *x, *mix_g, *ab_w_in, *ab_w_out, *c_w_in, *c_w_out, *ffn_g, *w_gate, *w_up, *w_down; unsigned char* ws; };
__device__ __forceinline__ void p0_weights(const Frame& F, const P0Args& A, int it_lo, int it_hi, int gw, int NGW) {
    LAUNDER_TID();
    LAS float* scr = (LAS float*)(F.lds + F.wave * 16384);
    bf16* const win0 = (bf16*)(A.ws + WS_WIN0); bf16* const win1 = (bf16*)(A.ws + WS_WIN1); bf16* const wout0 = (bf16*)(A.ws + WS_WOUT0); bf16* const wout1 = (bf16*)(A.ws + WS_WOUT1);
    bf16* const wgu0 = (bf16*)(A.ws + WS_WGU0); bf16* const wgu1 = (bf16*)(A.ws + WS_WGU1); bf16* const wdn0 = (bf16*)(A.ws + WS_WDN0); bf16* const wdn1 = (bf16*)(A.ws + WS_WDN1);
    constexpr int I_IN0 = 16 * (ABP / 32), I_IN1 = 16 * (CP / 32), I_OUT = 16 * 32, I_GU = 16 * (DFF / 32), I_DN = (DFF / 64) * 32;
    constexpr int NITEMS = I_IN0 + I_IN1 + 2 * I_OUT + 4 * I_GU + 2 * I_DN;
    for (int it = it_lo + gw; it < (it_hi < NITEMS ? it_hi : NITEMS); it += NGW) {
        int r = it; const float* W = nullptr; const float* gain = nullptr; bf16* WT = nullptr; int K = 0, N = 0, Np = 0, mode = 0; bool found = false;
#define P0_MAT(Wp, Kv, Nv, Npv, gp, WTp, md, cnt) { if (!found) { if (r < (cnt)) { W = (Wp); K = (Kv); N = (Nv); Np = (Npv); gain = (gp); WT = (WTp); mode = (md); found = true; } else r -= (cnt); } }
        P0_MAT(A.ab_w_in, DM, ABN, ABP, A.mix_g, win0, 3, I_IN0)
        P0_MAT(A.c_w_in, DM, CN, CP, A.mix_g + DM, win1, 0, I_IN1)
        P0_MAT(A.w_gate, DM, DFF, DFF, A.ffn_g, wgu0, 1, I_GU)
        P0_MAT(A.w_gate + (size_t)DM * DFF, DM, DFF, DFF, A.ffn_g + DM, wgu1, 1, I_GU)
        P0_MAT(A.ab_w_out, DM, DM, DM, nullptr, wout0, 0, I_OUT)
        P0_MAT(A.w_up, DM, DFF, DFF, A.ffn_g, wgu0, 2, I_GU)
        P0_MAT(A.w_down, DFF, DM, DM, nullptr, wdn0, 0, I_DN)
        P0_MAT(A.c_w_out, DM, DM, DM, nullptr, wout1, 0, I_OUT)
        P0_MAT(A.w_up + (size_t)DM * DFF, DM, DFF, DFF, A.ffn_g + DM, wgu1, 2, I_GU)
        P0_MAT(A.w_down + (size_t)DFF * DM, DFF, DM, DM, nullptr, wdn1, 0, I_DN)
#undef P0_MAT
        const int nblk = Np / 32, kb = r / nblk, nb = r % nblk, n0 = 32 * nb;
        int drow0 = n0; if (mode == 1 || mode == 2) drow0 = 256 * (n0 >> 7) + (n0 & 127) + (mode == 2 ? 128 : 0);
        if (mode == 3 && n0 < 1024) { const int nn = n0 & 511; drow0 = 256 * (nn >> 7) + (nn & 127) + (n0 >= 512 ? 128 : 0); }
        p0_item(W, K, N, gain, WT, drow0, 64 * kb, n0, scr, lane);
    }
}
constexpr int P0_SET0 = 16 * (ABP / 32) + 16 * (CP / 32) + 2 * 16 * (DFF / 32), P0_SET1 = P0_SET0 + 16 * 32 + 16 * (DFF / 32) + (DFF / 64) * 32, P0_SET2 = P0_SET1 + 16 * 32 + 16 * (DFF / 32) + (DFF / 64) * 32;
__device__ __forceinline__ void p0_prologue(const Frame& F, const P0Args& A) {
    LAUNDER_TID();
    const int gw = F.vcu * NWAVES + F.wave, NGW = F.G * NWAVES;
    p0_weights(F, A, 0, P0_SET0, gw, NGW);
    bf16* HB = (bf16*)(A.ws + WS_HB); float* ssq0 = (float*)(A.ws + WS_SSQ);
    for (int m0 = gw * 4; m0 < M; m0 += NGW * 4) {
        f32x4 v[4][4];
#pragma unroll
        for (int q = 0; q < 4; ++q)
#pragma unroll
            for (int j = 0; j < 4; ++j) v[q][j] = __builtin_nontemporal_load((const f32x4*)(A.x + (size_t)(m0 + q) * DM) + lane + 64 * j);
#pragma unroll
        for (int q = 0; q < 4; ++q) { float s = 0.f;
#pragma unroll
            for (int j = 0; j < 4; ++j) s += (v[q][j].x * v[q][j].x + v[q][j].y * v[q][j].y) + (v[q][j].z * v[q][j].z + v[q][j].w * v[q][j].w);
            s = wave_fsum(s); if (lane < 4) *((f32x4*)(ssq0 + (size_t)(m0 + q) * 16) + lane) = (f32x4){lane == 0 ? s : 0.f, 0.f, 0.f, 0.f};
            v2u* o8 = (v2u*)(HB + (size_t)(m0 + q) * DM) + lane;
#pragma unroll
            for (int j = 0; j < 4; ++j) { v2u w; w.x = pk2(v[q][j].x, v[q][j].y); w.y = pk2(v[q][j].z, v[q][j].w); o8[64 * j] = w; } }
    }
    float* rope = (float*)(A.ws + WS_ROPE);
    for (int e = F.vcu * 512 + tid; e < SEQ * 8; e += F.G * 512) { const int t = e >> 3, i = e & 7;
        const float inv = powf(500000.0f, -(float)i * 0.125f); const float ang = (float)t * inv;
        rope[t * 16 + i] = cosf(ang); rope[t * 16 + 8 + i] = sinf(ang); }
}

__device__ __forceinline__ unsigned ordkey(float f) { const unsigned u = __builtin_bit_cast(unsigned, f); return (u & 0x80000000u) ? ~u : (u | 0x80000000u); }
#ifndef DSA_VALU_COUNT
#define DSA_VALU_COUNT 1
#endif
#define DSA_CNT8(ca, cb, cfs, b, PRE) do { unsigned long long m0_, m1_, m2_, m3_; \
    asm(PRE "v_cmp_le_f32_e64 %2, %6, %7\n\tv_cmp_le_f32_e64 %3, %6, %8\n\tv_cmp_le_f32_e64 %4, %6, %9\n\tv_cmp_le_f32_e64 %5, %6, %10\n\t" \
        "v_addc_co_u32_e64 %0, %2, 0, %0, %2\n\tv_cmp_le_f32_e64 %2, %6, %11\n\tv_addc_co_u32_e64 %1, %3, 0, %1, %3\n\tv_cmp_le_f32_e64 %3, %6, %12\n\t" \
        "v_addc_co_u32_e64 %0, %4, 0, %0, %4\n\tv_cmp_le_f32_e64 %4, %6, %13\n\tv_addc_co_u32_e64 %1, %5, 0, %1, %5\n\tv_cmp_le_f32_e64 %5, %6, %14\n\t" \
        "v_addc_co_u32_e64 %0, %2, 0, %0, %2\n\tv_addc_co_u32_e64 %1, %3, 0, %1, %3\n\tv_addc_co_u32_e64 %0, %4, 0, %0, %4\n\tv_addc_co_u32_e64 %1, %5, 0, %1, %5" \
        : "+v"(ca), "+v"(cb), "=&s"(m0_), "=&s"(m1_), "=&s"(m2_), "=&s"(m3_) : "s"(cfs), "v"(k[8 * (b) + 0]), "v"(k[8 * (b) + 1]), "v"(k[8 * (b) + 2]), "v"(k[8 * (b) + 3]), \
          "v"(k[8 * (b) + 4]), "v"(k[8 * (b) + 5]), "v"(k[8 * (b) + 6]), "v"(k[8 * (b) + 7])); } while (0)
template <int NB> __device__ __forceinline__ int dsa_count(const float (&k)[32], float cf) {
#if DSA_VALU_COUNT
    int ca = 0, cb = 0;
    DSA_CNT8(ca, cb, cf, 0, "s_nop 1\n\t");
    if (NB > 1) DSA_CNT8(ca, cb, cf, 1, "");
    if (NB > 2) DSA_CNT8(ca, cb, cf, 2, "");
    if (NB > 3) DSA_CNT8(ca, cb, cf, 3, "");
    return wave_isum(ca + cb);
#else
    int cnt = 0;
#pragma unroll
    for (int blk = 0; blk < NB; ++blk) { unsigned long long mm_[8];
#pragma unroll
        for (int i = 0; i < 8; ++i) mm_[i] = __ballot(k[8 * blk + i] >= cf);
        __builtin_amdgcn_sched_barrier(0);
#pragma unroll
        for (int i = 0; i < 8; ++i) cnt += __popcll(mm_[i]); }
    return cnt;
#endif
}
#undef DSA_CNT8
__device__ __forceinline__ float imgf(unsigned T) { return __builtin_bit_cast(float, (T & 0x80000000u) ? (T & 0x7fffffffu) : ~T); }
__device__ __forceinline__ float uni(float v) { return __builtin_bit_cast(float, __builtin_amdgcn_readfirstlane(__builtin_bit_cast(int, v))); }
template <int NB> __device__ __forceinline__ void dsa_select(const float (&k)[32], int lane, int t, unsigned& mlo, unsigned& mhi) {
    const int n = t + 1; const float nf = (float)n, inf = __builtin_inff();
    float s1 = 0.f, s2 = 0.f;
#pragma unroll
    for (int j = 0; j < 8; ++j) { const float v = k[NB * j]; const float vv = (v == -inf) ? 0.f : v; s1 += vv; s2 = __builtin_fmaf(vv, vv, s2); }
    s1 = wave_fsum(s1); s2 = wave_fsum(s2);
    const int qf = n / (64 * NB), rr = n - qf * (64 * NB); const int m = (qf >= 8) ? 512 : 64 * qf + (rr < 64 ? rr : 64);
    const float inv_m = frcp((float)m), mu = s1 * inv_m, sg = __builtin_sqrtf(fmaxf(s2 * inv_m - mu * mu, 1e-30f));
    const float zt = 0.4073f * (__builtin_amdgcn_logf(nf - 256.f) - 8.f);
    const float slope = sg * 4.3333f * frcp(nf);
    float g = uni(mu + zt * sg), lo_v = -inf, hi_v = inf, wl = 0.f, wh = 0.f, Tf = 0.f; bool exact = false, done = false; int last = 0;
#pragma unroll 1
    for (int probes = 0; ; ) {
        const int c = dsa_count<NB>(k, g);
        if (c == 256) { exact = true; Tf = g; break; }
        const float d = (float)(c - 256);
        if (c > 256) {
            lo_v = g; wl = d; if (last == 1) wh *= 0.5f; last = 1;
            if (c <= 258) {
#pragma unroll 1
                for (;;) { float a = inf;
#pragma unroll
                    for (int i = 0; i < 8 * NB; ++i) a = fminf(a, (k[i] > lo_v) ? k[i] : inf);
                    a = wave_fmin(a); const int ca = dsa_count<NB>(k, a);
                    if (ca == 256) { exact = true; Tf = a; break; }
                    if (ca < 256) { Tf = lo_v; break; }
                    lo_v = a; }
                done = true;
            }
        } else {
            hi_v = g; wh = -d; if (last == 2) wl *= 0.5f; last = 2;
            if (c >= 254) {
#pragma unroll 1
                for (;;) { float bmx = -inf;
#pragma unroll
                    for (int i = 0; i < 8 * NB; ++i) bmx = fmaxf(bmx, (k[i] < hi_v) ? k[i] : -inf);
                    bmx = wave_fmax(bmx); const int cb = dsa_count<NB>(k, bmx);
                    if (cb == 256) { exact = true; Tf = bmx; break; }
                    if (cb > 256) { Tf = bmx; break; }
                    hi_v = bmx; }
                done = true;
            }
        }
        if (done) break;
        ++probes;
        const float g2 = uni((last == 1 ? hi_v < inf : lo_v > -inf) ? lo_v + (hi_v - lo_v) * wl * frcp(wl + wh) : g + d * slope);
        if (!(g2 > lo_v && g2 < hi_v) || probes >= 16) {
            unsigned lo_i = ordkey(lo_v), hi_i = ordkey(hi_v);
#pragma unroll 1
            while (hi_i - lo_i > 1u) { const unsigned gi = __builtin_amdgcn_readfirstlane(lo_i + ((hi_i - lo_i) >> 1)); const float gf = imgf(gi); const int cc = dsa_count<NB>(k, gf);
                if (cc == 256) { exact = true; Tf = gf; break; }
                if (cc > 256) lo_i = gi; else hi_i = gi; }
            if (!exact) Tf = imgf(lo_i);
            break;
        }
        g = g2;
    }
    if (exact) {
#pragma unroll
        for (int i = 0; i < 8 * NB; ++i) { const unsigned long long mm = __ballot(k[i] >= Tf); if (lane == i) { mlo = (unsigned)mm; mhi = (unsigned)(mm >> 32); } }
    } else {
        int cgt = 0;
#pragma unroll
        for (int i = 0; i < 8 * NB; ++i) cgt += __popcll(__ballot(k[i] > Tf));
        const int need = 256 - cgt; int base = 0;
#pragma unroll
        for (int i = 0; i < 8 * NB; ++i) {
            const bool eq = (k[i] == Tf); const unsigned long long me = __ballot(eq);
            const int rank = base + (int)__builtin_amdgcn_mbcnt_hi((unsigned)(me >> 32), __builtin_amdgcn_mbcnt_lo((unsigned)me, 0u));
            const bool sel = (k[i] > Tf) || (eq && rank < need);
            const unsigned long long mm = __ballot(sel);
            if (lane == i) { mlo = (unsigned)mm; mhi = (unsigned)(mm >> 32); }
            base += __popcll(me);
        }
    }
}
constexpr int KSTR = 72, VSTR = 72;
__device__ __forceinline__ void dsa_unit(const Frame& F, const bf16* U, bf16* YC, int b, int j) {
    LAUNDER_TID(); const int wave = F.wave;
    if (wave >= 4) __builtin_amdgcn_s_setprio(1);
    const size_t rb = (size_t)b * SEQ;
    LAS float* SC = (LAS float*)F.lds;
    LAS unsigned* BM = (LAS unsigned*)(F.lds + LDS_BM);
#pragma unroll 1
    for (int rep12_ = 0; rep12_ < REP_DSA12; ++rep12_)
    {
        const f32x4 ninf = {-__builtin_inff(), -__builtin_inff(), -__builtin_inff(), -__builtin_inff()};
        for (int e = tid; e < 16 * SC_STRIDE / 4; e += 512) ((LAS f32x4*)SC)[e] = ninf;
        LDS_BARRIER();
    }
    {
    bf16x8 nbq[8][2]; v4u niw;
    { const bf16* qrow = U + (rb + 64 * j + (lane & 15)) * ABP;
#pragma unroll
      for (int h = 0; h < 8; ++h)
#pragma unroll
        for (int ks = 0; ks < 2; ++ks) nbq[h][ks] = *(const bf16x8*)(qrow + AB_IQ + h * 64 + ks * 32 + (lane >> 4) * 8);
      niw = *(const v4u*)(qrow + AB_IW); }
#pragma unroll 1
    for (int s = 0; s < 4; ++s) {
        const int t0 = 64 * j + 16 * s, nkt = (t0 >> 4) + 1;
        {
            const int c = lane & 15, g = lane >> 4;
            bf16x8 bq[8][2];
#pragma unroll
            for (int h = 0; h < 8; ++h)
#pragma unroll
                for (int ks = 0; ks < 2; ++ks) bq[h][ks] = nbq[h][ks];
            float iwv[8];
            { const v4u raw = niw; const float ws = 0.04419417382f;
              iwv[0] = bf2f(raw.x & 0xffffu) * ws; iwv[1] = bf2f(raw.x >> 16) * ws; iwv[2] = bf2f(raw.y & 0xffffu) * ws; iwv[3] = bf2f(raw.y >> 16) * ws;
              iwv[4] = bf2f(raw.z & 0xffffu) * ws; iwv[5] = bf2f(raw.z >> 16) * ws; iwv[6] = bf2f(raw.w & 0xffffu) * ws; iwv[7] = bf2f(raw.w >> 16) * ws; }
            bf16x8 nak[4][2];
#pragma unroll
            for (int u = 0; u < 4; ++u) { const int kt = wave + 8 * u;
                if (kt < nkt) { const bf16* krow = U + (rb + 16 * kt + c) * ABP + AB_IK + g * 8; nak[u][0] = *(const bf16x8*)krow; nak[u][1] = *(const bf16x8*)(krow + 32); } }
            for (int kt0 = wave; kt0 < nkt; kt0 += 32) {
                bf16x8 ak[4][2];
#pragma unroll
                for (int u = 0; u < 4; ++u) { ak[u][0] = nak[u][0]; ak[u][1] = nak[u][1]; }
#pragma unroll
                for (int u = 0; u < 4; ++u) { const int kt = kt0 + 32 + 8 * u;
                    if (kt < nkt) { const bf16* krow = U + (rb + 16 * kt + c) * ABP + AB_IK + g * 8; nak[u][0] = *(const bf16x8*)krow; nak[u][1] = *(const bf16x8*)(krow + 32); } }
#pragma unroll
                for (int u = 0; u < 4; ++u) { const int kt = kt0 + 8 * u;
                    if (kt < nkt) {
                        f32x4 acc[8]; const f32x4 z4 = {0.f, 0.f, 0.f, 0.f};
#pragma unroll
                        for (int h = 0; h < 8; ++h) acc[h] = mfma16(ak[u][0], bq[h][0], z4);
#pragma unroll
                        for (int h = 0; h < 8; ++h) acc[h] = mfma16(ak[u][1], bq[h][1], acc[h]);
                        __builtin_amdgcn_sched_barrier(0);
                        f32x4 sc = {0.f, 0.f, 0.f, 0.f};
#pragma unroll
                        for (int h = 0; h < 8; ++h)
#pragma unroll
                            for (int i = 0; i < 4; ++i) { const float av_ = acc[h][i]; const int rb_ = __builtin_bit_cast(int, av_); sc[i] = __builtin_fmaf(__builtin_bit_cast(float, rb_ > 0 ? rb_ : 0), iwv[h], sc[i]); }
#pragma unroll
                        for (int i = 0; i < 4; ++i) sc[i] = (kt < nkt - 1 || 16 * kt + 4 * g + i <= t0 + c) ? sc[i] : -__builtin_inff();
                        *(LAS f32x4*)(SC + c * SC_STRIDE + 16 * kt + 4 * g) = sc;
                    } }
            }
            if (s < 3) { const bf16* qrow = U + (rb + t0 + 16 + c) * ABP;
#pragma unroll
                for (int h = 0; h < 8; ++h)
#pragma unroll
                    for (int ks = 0; ks < 2; ++ks) nbq[h][ks] = *(const bf16x8*)(qrow + AB_IQ + h * 64 + ks * 32 + g * 8);
                niw = *(const v4u*)(qrow + AB_IW); }
        }
        LDS_BARRIER();
#pragma unroll 1
        for (int rep2_ = 0; rep2_ < REP_DSA2; ++rep2_)
        for (int qq = 0; qq < 2; ++qq) {
            const int q = 2 * wave + qq, t = t0 + q;
            float k[32];
#pragma unroll
            for (int i = 0; i < 32; ++i) k[i] = *(volatile LAS float*)(SC + q * SC_STRIDE + 64 * i + lane);
            unsigned mlo = 0u, mhi = 0u;
            if (t < 256) {
#pragma unroll
                for (int i = 0; i < 4; ++i) { const unsigned long long mm = __ballot((64 * i + lane) <= t); if (lane == i) { mlo = (unsigned)mm; mhi = (unsigned)(mm >> 32); } }
            } else if (t < 512) dsa_select<1>(k, lane, t, mlo, mhi);
            else if (t < 1024) dsa_select<2>(k, lane, t, mlo, mhi);
            else if (t < 1536) dsa_select<3>(k, lane, t, mlo, mhi);
            else dsa_select<4>(k, lane, t, mlo, mhi);
            if (lane < 32) { BM[(16 * s + q) * 64 + 2 * lane] = mlo; BM[(16 * s + q) * 64 + 2 * lane + 1] = mhi; }
        }
        LDS_BARRIER();
    }
    }
    __syncthreads();
    LAS bf16* Ks = (LAS bf16*)F.lds;
    LAS bf16* Vt = (LAS bf16*)(F.lds + 2 * 64 * KSTR * 2);
    const int c = lane & 31, hi = lane >> 5;
#pragma unroll 1
    for (int rep3_ = 0; rep3_ < REP_DSA3; ++rep3_) {
    LAS bf16x8* QF = (LAS bf16x8*)(F.lds + 4 * 64 * KSTR * 2) + wave * 512;
#pragma unroll
    for (int nt = 0; nt < 2; ++nt)
#pragma unroll
        for (int ks = 0; ks < 4; ++ks) QF[(nt * 4 + ks) * 64 + lane] = *(const bf16x8*)(U + (rb + 64 * j + 32 * nt + c) * ABP + AB_Q + wave * 64 + 16 * ks + 8 * hi);
    f32x16 O[2][2];
#pragma unroll
    for (int dt = 0; dt < 2; ++dt)
#pragma unroll
        for (int nt = 0; nt < 2; ++nt)
#pragma unroll
            for (int i = 0; i < 16; ++i) O[dt][nt][i] = 0.f;
    float mrow[2] = {-1e30f, -1e30f}, lrow[2] = {0.f, 0.f};
    const float sc2 = 0.125f * 1.44269504089f;
    constexpr float MASK_NEG = -1.0e9f;
    constexpr int MT_B0 = 4 * 64 * KSTR * 2 + 65536, MT_B1 = MT_B0 + 16384;
    static_assert(MT_B1 + 3 * 4096 <= LDS_BM, "mask tables");
#define DSA_MT_BASE(bf, blk) ((bf) ? ((blk) == 3 ? LDS_MT3 : MT_B1 + 4096 * (blk)) : MT_B0 + 4096 * (blk))
#define DSA_BUILD_MASK(kt_, bf) do { const int grp_ = wave & 3, mt_ = wave >> 2; \
        _Pragma("unroll") for (int nt_ = 0; nt_ < 2; ++nt_) { const unsigned w_ = BM[(32 * nt_ + c) * 64 + 2 * (kt_) + mt_] >> (8 * grp_ + 4 * hi); f32x4 v_; \
            v_.x = (w_ & 1u) ? 0.f : MASK_NEG; v_.y = (w_ & 2u) ? 0.f : MASK_NEG; v_.z = (w_ & 4u) ? 0.f : MASK_NEG; v_.w = (w_ & 8u) ? 0.f : MASK_NEG; \
            const int blk_ = 2 * nt_ + mt_; *(LAS f32x4*)(F.lds + ((bf) ? (blk_ == 3 ? LDS_MT3 : MT_B1 + 4096 * blk_) : MT_B0 + 4096 * blk_) + (grp_ * 64 + lane) * 16) = v_; } } while (0)
    const int krow_s = tid >> 3, kch_s = tid & 7, vkey_s = tid & 63, vch_s = tid >> 6;
    v4u kreg = *(const v4u*)(U + (rb + krow_s) * ABP + AB_K + 8 * kch_s);
    v4u vreg = *(const v4u*)(U + (rb + vkey_s) * ABP + AB_V + 8 * vch_s);
    {
        *(LAS v4u*)(Ks + krow_s * KSTR + 8 * kch_s) = kreg;
        const unsigned ve[4] = {vreg.x, vreg.y, vreg.z, vreg.w};
#pragma unroll
        for (int e = 0; e < 4; ++e) { Vt[(8 * vch_s + 2 * e) * VSTR + vkey_s] = (bf16)(ve[e] & 0xffffu); Vt[(8 * vch_s + 2 * e + 1) * VSTR + vkey_s] = (bf16)(ve[e] >> 16); }
    }
    DSA_BUILD_MASK(0, 0);
    __syncthreads();
    for (int kt = 0; kt <= j; ++kt) {
        const int buf = kt & 1;
        if (wave >= 4) __builtin_amdgcn_s_sleep(10);
        if (kt < j) {
            kreg = *(const v4u*)(U + (rb + 64 * (kt + 1) + krow_s) * ABP + AB_K + 8 * kch_s);
            vreg = *(const v4u*)(U + (rb + 64 * (kt + 1) + vkey_s) * ABP + AB_V + 8 * vch_s);
        }
        const LAS bf16* Kb = Ks + buf * 64 * KSTR; const LAS bf16* Vb = Vt + buf * 64 * VSTR;
        bf16x8 va[2][4];
#pragma unroll
        for (int dt = 0; dt < 2; ++dt)
#pragma unroll
            for (int kk = 0; kk < 4; ++kk) { const LAS bf16* vp = Vb + (32 * dt + c) * VSTR + 16 * kk + 4 * hi; va[dt][kk] = mk8(*(const LAS v2u*)vp, *(const LAS v2u*)(vp + 8)); }
#pragma unroll
        for (int nt = 0; nt < 2; ++nt) {
            f32x16 S[2];
            {
                bf16x8 ka[2][4], bq[4];
#pragma unroll
                for (int ks = 0; ks < 4; ++ks) bq[ks] = QF[(nt * 4 + ks) * 64 + lane];
#pragma unroll
                for (int mt = 0; mt < 2; ++mt)
#pragma unroll
                    for (int ks = 0; ks < 4; ++ks) ka[mt][ks] = *(const LAS bf16x8*)(Kb + (32 * mt + c) * KSTR + 16 * ks + 8 * hi);
#pragma unroll
                for (int mt = 0; mt < 2; ++mt) {
                    const LAS f32x4* tb = (const LAS f32x4*)(F.lds + DSA_MT_BASE(buf, 2 * nt + mt)) + lane;
#pragma unroll
                    for (int g4 = 0; g4 < 4; ++g4) { const f32x4 t4 = tb[64 * g4]; S[mt][4 * g4 + 0] = t4.x; S[mt][4 * g4 + 1] = t4.y; S[mt][4 * g4 + 2] = t4.z; S[mt][4 * g4 + 3] = t4.w; }
                }
#pragma unroll
                for (int mt = 0; mt < 2; ++mt)
#pragma unroll
                    for (int ks = 0; ks < 4; ++ks) S[mt] = mfma32(ka[mt][ks], bq[ks], S[mt]);
            }
            float mx = -1e30f;
#pragma unroll
            for (int mt = 0; mt < 2; ++mt)
#pragma unroll
                for (int i = 0; i < 16; ++i) mx = fmaxf(mx, S[mt][i]);
            mx = fmaxf(mx, __shfl_xor(mx, 32)) * sc2;
            if (!__all(mx <= mrow[nt] + 8.0f)) {
                const float mn = fmaxf(mrow[nt], mx), alpha = fexp2(mrow[nt] - mn);
                mrow[nt] = mn; lrow[nt] *= alpha;
#pragma unroll
                for (int dt = 0; dt < 2; ++dt)
#pragma unroll
                    for (int i = 0; i < 16; ++i) O[dt][nt][i] *= alpha;
            }
            const float mnew = mrow[nt];
#pragma unroll
            for (int mt = 0; mt < 2; ++mt) {
                float p[16];
#pragma unroll
                for (int i = 0; i < 16; ++i) { p[i] = fexp2(S[mt][i] * sc2 - mnew); lrow[nt] += p[i]; }
#pragma unroll
                for (int half = 0; half < 2; ++half) {
                    const bf16x8 pb = pack8(p[8 * half + 0], p[8 * half + 1], p[8 * half + 2], p[8 * half + 3], p[8 * half + 4], p[8 * half + 5], p[8 * half + 6], p[8 * half + 7]);
#pragma unroll
                    for (int dt = 0; dt < 2; ++dt) O[dt][nt] = mfma32(va[dt][2 * mt + half], pb, O[dt][nt]);
                }
            }
            __builtin_amdgcn_sched_barrier(0);
        }
        if (kt < j) {
            const int nb = buf ^ 1;
            DSA_BUILD_MASK(kt + 1, nb);
            *(LAS v4u*)(Ks + nb * 64 * KSTR + krow_s * KSTR + 8 * kch_s) = kreg;
            const unsigned ve[4] = {vreg.x, vreg.y, vreg.z, vreg.w};
#pragma unroll
            for (int e = 0; e < 4; ++e) { Vt[nb * 64 * VSTR + (8 * vch_s + 2 * e) * VSTR + vkey_s] = (bf16)(ve[e] & 0xffffu); Vt[nb * 64 * VSTR + (8 * vch_s + 2 * e + 1) * VSTR + vkey_s] = (bf16)(ve[e] >> 16); }
        }
        __syncthreads();
    }
#pragma unroll
    for (int nt = 0; nt < 2; ++nt) {
        const float l = lrow[nt] + __shfl_xor(lrow[nt], 32); const float inv = 1.0f / l;
        bf16* orow = YC + (rb + 64 * j + 32 * nt + c) * DM + 512 + wave * 64;
#pragma unroll
        for (int dt = 0; dt < 2; ++dt)
#pragma unroll
            for (int g4 = 0; g4 < 4; ++g4) {
                v2u w; w.x = pk2(O[dt][nt][4 * g4 + 0] * inv, O[dt][nt][4 * g4 + 1] * inv); w.y = pk2(O[dt][nt][4 * g4 + 2] * inv, O[dt][nt][4 * g4 + 3] * inv);
                *(v2u*)(orow + 32 * dt + 8 * g4 + 4 * hi) = w;
            }
    }
    __syncthreads();
    }
#undef DSA_BUILD_MASK
#undef DSA_MT_BASE
    __builtin_amdgcn_s_setprio(0);
}

__device__ __forceinline__ void conv_unit(const Frame& F, const bf16* U, bf16* YC, const float* conv_w, const float* conv_b, const float* ln_g, const float* ln_b, int tile) {
    LAUNDER_TID();
    const int b = tile >> 5, t0 = (tile & 31) * 64, c = tid;
    const size_t rb = (size_t)b * SEQ;
    LAS bf16* Hs = (LAS bf16*)F.lds;
    LAS float* O2 = (LAS float*)(F.lds + 94 * 512 * 2);
    LAS float* ST = (LAS float*)(F.lds + 94 * 512 * 2 + 8 * 512 * 4);
    float w[31];
#pragma unroll
    for (int jj = 0; jj < 31; ++jj) w[jj] = conv_w[jj * 512 + c];
    const float bias = conv_b[c], lg = ln_g[c], lb = ln_b[c];
    {
        v4u tmp[12];
#pragma unroll
        for (int k = 0; k < 12; ++k) { const int e = tid + 512 * k, r = e >> 6, ch = e & 63; int t = t0 - 30 + r; t = t < 0 ? 0 : t; t = t > SEQ - 1 ? SEQ - 1 : t;
            tmp[k] = *(const v4u*)(U + (rb + t) * ABP + 8 * ch); }
#pragma unroll
        for (int k = 0; k < 12; ++k) { const int e = tid + 512 * k, r = e >> 6, ch = e & 63; const bool z = (t0 - 30 + r) < 0; v4u x = tmp[k]; if (z) { x.x = 0u; x.y = 0u; x.z = 0u; x.w = 0u; }
            if (r < 94) *(LAS v4u*)(Hs + r * 512 + 8 * ch) = x; }
    }
    LDS_BARRIER();
    for (int grp = 0; grp < 8; ++grp) {
        float in[38];
#pragma unroll
        for (int r = 0; r < 38; ++r) in[r] = bf2f(Hs[(8 * grp + r) * 512 + c]);
        float o[8];
#pragma unroll
        for (int tl = 0; tl < 8; ++tl) { float acc = bias;
#pragma unroll
            for (int jj = 0; jj < 31; ++jj) acc += w[jj] * in[tl + jj];
            o[tl] = acc; O2[tl * 512 + c] = acc; }
        LDS_BARRIER();
        { float s = 0.f, s2 = 0.f;
#pragma unroll
          for (int e = 0; e < 8; ++e) { const float v = O2[F.wave * 512 + lane + 64 * e]; s += v; s2 += v * v; }
          s = wave_fsum(s); s2 = wave_fsum(s2);
          if (lane == 0) { const float mu = s * (1.0f / 512.0f), var = fmaxf(s2 * (1.0f / 512.0f) - mu * mu, 0.f); ST[2 * F.wave] = mu; ST[2 * F.wave + 1] = rsqrtf(var + EPS); } }
        LDS_BARRIER();
        f32x4 stv[4];
#pragma unroll
        for (int k4 = 0; k4 < 4; ++k4) stv[k4] = *(const LAS f32x4*)(ST + 4 * k4);
#pragma unroll
        for (int tl = 0; tl < 8; ++tl) { const float mu = (tl & 1) ? stv[tl >> 1].z : stv[tl >> 1].x, rs = (tl & 1) ? stv[tl >> 1].w : stv[tl >> 1].y; const float y = (o[tl] - mu) * rs * lg + lb; const float ya = fsilu(y);
            YC[(rb + t0 + 8 * grp + tl) * DM + c] = (bf16)f2bf(ya); }
    }
    LDS_BARRIER();
}

constexpr int XSTR = 520;
__device__ __forceinline__ void gla_prep_unit(const Frame& F, const bf16* U1, bf16* QT, bf16* KT, bf16* KTT, float* DEC, const float* g2_w, const float* g2_b, int unit) {
    LAUNDER_TID(); (void)KTT;
    const size_t r0 = (size_t)unit * 64;
    LAS bf16* XQ = (LAS bf16*)F.lds;
    LAS bf16* XK = XQ + 64 * XSTR;
    const int c = lane & 31, hi = lane >> 5, wv_ = F.wave;
    bf16x8 ga[2];
#pragma unroll
    for (int tb = 0; tb < 2; ++tb) ga[tb] = *(const bf16x8*)(U1 + (r0 + 32 * tb + c) * CP + C_GL + 8 * hi);
    float wf[2][8], bs[2];
#pragma unroll
    for (int cb = 0; cb < 2; ++cb) { bs[cb] = g2_b[64 * wv_ + 32 * cb + c];
#pragma unroll
        for (int e = 0; e < 8; ++e) wf[cb][e] = g2_w[(8 * hi + e) * 512 + 64 * wv_ + 32 * cb + c]; }
    {
        v4u tmp[16];
#pragma unroll
        for (int k = 0; k < 16; ++k) { const int e = tid + 512 * k; tmp[k] = *(const v4u*)(U1 + (r0 + (e >> 7)) * CP + 8 * (e & 127)); }
#pragma unroll
        for (int k = 0; k < 16; ++k) { const int e = tid + 512 * k, row = e >> 7, ch = e & 127;
            LAS bf16* dst = (ch < 64) ? (XQ + row * XSTR + 8 * ch) : (XK + row * XSTR + 8 * (ch - 64)); *(LAS v4u*)dst = tmp[k]; }
    }
    {
        LDS_BARRIER();
#pragma unroll
        for (int cb = 0; cb < 2; ++cb) {
            const int colc = 64 * wv_ + 32 * cb + c;
            v4u hb_, lb_;
            { unsigned hh[4], ll[4];
#pragma unroll
              for (int e2 = 0; e2 < 4; ++e2) { const unsigned h2 = pk2(wf[cb][2 * e2], wf[cb][2 * e2 + 1]); hh[e2] = h2;
                  ll[e2] = pk2(wf[cb][2 * e2] - bf2f(h2 & 0xffffu), wf[cb][2 * e2 + 1] - __builtin_bit_cast(float, h2 & 0xffff0000u)); }
              hb_.x = hh[0]; hb_.y = hh[1]; hb_.z = hh[2]; hb_.w = hh[3]; lb_.x = ll[0]; lb_.y = ll[1]; lb_.z = ll[2]; lb_.w = ll[3]; }
            const bf16x8 bh = __builtin_bit_cast(bf16x8, hb_), bl = __builtin_bit_cast(bf16x8, lb_);
            float p[2][16];
#pragma unroll
            for (int tb = 0; tb < 2; ++tb) {
                f32x16 D;
#pragma unroll
                for (int i = 0; i < 16; ++i) D[i] = 0.f;
                D = mfma32(ga[tb], bh, D); D = mfma32(ga[tb], bl, D);
#pragma unroll
                for (int i = 0; i < 16; ++i) { const float x = D[i] + bs[cb];
                    p[tb][i] = (fminf(x, 0.f) - 0.69314718056f * __builtin_amdgcn_logf(1.0f + fexp(-fabsf(x)))) * (1.0f / 16.0f); }
#pragma unroll
                for (int a = 0; a < 4; ++a) { p[tb][4 * a + 1] += p[tb][4 * a]; p[tb][4 * a + 2] += p[tb][4 * a + 1]; p[tb][4 * a + 3] += p[tb][4 * a + 2]; }
            }
            float run = 0.f;
#pragma unroll
            for (int tb = 0; tb < 2; ++tb)
#pragma unroll
                for (int a = 0; a < 4; ++a) {
                    const float gt = p[tb][4 * a + 3], pt = __shfl_xor(gt, 32);
                    const float off = run + (hi ? pt : 0.f); run += gt + pt;
#pragma unroll
                    for (int j = 0; j < 4; ++j) {
                        const float blg = (off + p[tb][4 * a + j]) * 1.44269504089f;
                        const int idx = (32 * tb + 8 * a + 4 * hi + j) * XSTR + colc;
                        const float qv = bf2f(XQ[idx]), kv = bf2f(XK[idx]);
                        XQ[idx] = (bf16)f2bf(qv * fexp2(blg) * 0.08838834764f);
                        XK[idx] = (bf16)f2bf(kv * fexp2(-blg));
                    }
                }
            if (hi == 0) DEC[(size_t)unit * 512 + colc] = fexp(run);
        }
    }
    LDS_BARRIER();
#pragma unroll
    for (int k = 0; k < 8; ++k) { const int e = tid + 512 * k, row = e >> 6, ch = e & 63;
        *(v4u*)(QT + (r0 + row) * 512 + 8 * ch) = *(const LAS v4u*)(XQ + row * XSTR + 8 * ch);
        *(v4u*)(KT + (r0 + row) * 512 + 8 * ch) = *(const LAS v4u*)(XK + row * XSTR + 8 * ch); }
    LDS_BARRIER();
}
constexpr int QSTR = 136, TSTR = 72;
constexpr int VNSTR = 96;
constexpr int G2_QS = 0, G2_KS = 64 * QSTR * 2, G2_KT = 2 * 64 * QSTR * 2, G2_VT = G2_KT + 128 * TSTR * 2, G2_DS = G2_VT + 64 * VNSTR * 2, G2_BUF = G2_DS + 512;
constexpr int G2_AS = G2_BUF, G2_PO = G2_AS + 64 * TSTR * 2;
static_assert(G2_PO + 65536 <= LDS_CTL, "GLA scan LDS map");
__device__ __forceinline__ void g2_step_body(const Frame& F, LAS unsigned char* bp, LAS bf16* As, LAS float* PO, f32x16& S, const bf16* QT, bf16* OB, float* GSSQ, int b, int h, int vq, int ch, int tid, int lane, const v2u rr0, const v2u rr1, const float (&gs)[8]) {
    const int wave = F.wave, c = lane & 31, hi = lane >> 5, vt = wave & 1, dt = wave >> 1; (void)tid; (void)QT;
        const size_t r0 = (size_t)b * SEQ + 64 * ch;
        const LAS bf16* Qs = (const LAS bf16*)(bp + G2_QS); const LAS bf16* Ks = (const LAS bf16*)(bp + G2_KS);
        const LAS float* Ds = (const LAS float*)(bp + G2_DS);
        for (int n = wave; n < 10; n += 8) {
            const int it = (n >= 6) ? 3 : (n >= 3) ? 2 : (n >= 1) ? 1 : 0, jt = n - (it * (it + 1)) / 2; const int r16 = lane & 15, g = lane >> 4;
            f32x4 acc = {0.f, 0.f, 0.f, 0.f};
#pragma unroll
            for (int ks = 0; ks < 4; ++ks) acc = mfma16(*(const LAS bf16x8*)(Ks + (16 * jt + r16) * QSTR + 32 * ks + 8 * g), *(const LAS bf16x8*)(Qs + (16 * it + r16) * QSTR + 32 * ks + 8 * g), acc);
            const int i = 16 * it + r16, j0 = 16 * jt + 4 * g;
            v2u w; w.x = pk2(j0 <= i ? acc[0] : 0.f, j0 + 1 <= i ? acc[1] : 0.f); w.y = pk2(j0 + 2 <= i ? acc[2] : 0.f, j0 + 3 <= i ? acc[3] : 0.f);
            *(LAS v2u*)(As + i * TSTR + j0) = w;
        }
        LDS_BARRIER();
        f32x16 OT[2];
#pragma unroll
        for (int it = 0; it < 2; ++it)
#pragma unroll
            for (int i = 0; i < 16; ++i) OT[it][i] = 0.f;
#pragma unroll
        for (int half = 0; half < 2; ++half) {
            const bf16x8 sa = pack8(S[8 * half + 0], S[8 * half + 1], S[8 * half + 2], S[8 * half + 3], S[8 * half + 4], S[8 * half + 5], S[8 * half + 6], S[8 * half + 7]);
#pragma unroll
            for (int it = 0; it < 2; ++it) { const LAS bf16* qp = Qs + (32 * it + c) * QSTR + 32 * dt + 16 * half + 4 * hi;
                OT[it] = mfma32(sa, mk8(*(const LAS v2u*)qp, *(const LAS v2u*)(qp + 8)), OT[it]); }
        }
        bf16x8 vf[4];
        {
            const unsigned va_ = (unsigned)(__UINTPTR_TYPE__)(bp + G2_VT) + (unsigned)((8 * hi + ((lane & 15) >> 2)) * (VNSTR * 2) + (32 * vt + 16 * ((lane >> 4) & 1) + 4 * (lane & 3)) * 2);
            v2u t0_, t1_, t2_, t3_, t4_, t5_, t6_, t7_;
            asm volatile("ds_read_b64_tr_b16 %0, %8\n\tds_read_b64_tr_b16 %1, %8 offset:768\n\tds_read_b64_tr_b16 %2, %8 offset:3072\n\tds_read_b64_tr_b16 %3, %8 offset:3840\n\t"
                         "ds_read_b64_tr_b16 %4, %8 offset:6144\n\tds_read_b64_tr_b16 %5, %8 offset:6912\n\tds_read_b64_tr_b16 %6, %8 offset:9216\n\tds_read_b64_tr_b16 %7, %8 offset:9984\n\t"
                         "s_waitcnt lgkmcnt(0)"
                         : "=&v"(t0_), "=&v"(t1_), "=&v"(t2_), "=&v"(t3_), "=&v"(t4_), "=&v"(t5_), "=&v"(t6_), "=&v"(t7_) : "v"(va_) : "memory");
            vf[0] = mk8(t0_, t1_); vf[1] = mk8(t2_, t3_); vf[2] = mk8(t4_, t5_); vf[3] = mk8(t6_, t7_);
        }
        {
            const bf16x8 va = (dt == 0) ? vf[0] : (dt == 1) ? vf[1] : (dt == 2) ? vf[2] : vf[3];
#pragma unroll
            for (int it = 0; it < 2; ++it) OT[it] = mfma32(va, *(const LAS bf16x8*)(As + (32 * it + c) * TSTR + 16 * dt + 8 * hi), OT[it]);
        }
#pragma unroll
        for (int it = 0; it < 2; ++it)
#pragma unroll
            for (int i = 0; i < 16; ++i) PO[(((dt * 2 + vt) * 2 + it) * 16 + i) * 64 + lane] = OT[it][i];
        LDS_BARRIER();
        {
            const int vt2 = wave & 1, it2 = (wave >> 1) & 1, q = wave >> 2;
            float o8[8];
#pragma unroll
            for (int jx = 0; jx < 8; ++jx) { float a = 0.f;
#pragma unroll
                for (int d4 = 0; d4 < 4; ++d4) a += PO[(((d4 * 2 + vt2) * 2 + it2) * 16 + 8 * q + jx) * 64 + lane];
                o8[jx] = a; }
            float ss = 0.f;
#pragma unroll
            for (int jx = 0; jx < 8; ++jx) ss += o8[jx] * o8[jx];
            ss += __shfl_xor(ss, 32);
            const size_t tok = r0 + 32 * it2 + c;
            bf16* orow = OB + tok * DM + h * 256 + 64 * vq + 32 * vt2 + 16 * q + 4 * hi;
            const float rvv[8] = {bf2f(rr0.x & 0xffffu), bf2f(rr0.x >> 16), bf2f(rr0.y & 0xffffu), bf2f(rr0.y >> 16), bf2f(rr1.x & 0xffffu), bf2f(rr1.x >> 16), bf2f(rr1.y & 0xffffu), bf2f(rr1.y >> 16)};
            float y8[8];
#pragma unroll
            for (int jx = 0; jx < 8; ++jx) y8[jx] = o8[jx] * gs[jx] * fsilu(rvv[jx]);
            v2u w0, w1; w0.x = pk2(y8[0], y8[1]); w0.y = pk2(y8[2], y8[3]); w1.x = pk2(y8[4], y8[5]); w1.y = pk2(y8[6], y8[7]);
            *(v2u*)orow = w0; *(v2u*)(orow + 8) = w1;
            if (hi == 0) GSSQ[(tok * 4 + h) * 16 + vq * 4 + vt2 * 2 + q] = ss;
        }
        {
            const unsigned ka_ = (unsigned)(__UINTPTR_TYPE__)(bp + G2_KS) + (unsigned)((8 * hi + ((lane & 15) >> 2)) * (QSTR * 2) + (32 * dt + 16 * ((lane >> 4) & 1) + 4 * (lane & 3)) * 2);
            v2u t0_, t1_, t2_, t3_, t4_, t5_, t6_, t7_;
            asm volatile("ds_read_b64_tr_b16 %0, %8\n\tds_read_b64_tr_b16 %1, %8 offset:1088\n\tds_read_b64_tr_b16 %2, %8 offset:4352\n\tds_read_b64_tr_b16 %3, %8 offset:5440\n\t"
                         "ds_read_b64_tr_b16 %4, %8 offset:8704\n\tds_read_b64_tr_b16 %5, %8 offset:9792\n\tds_read_b64_tr_b16 %6, %8 offset:13056\n\tds_read_b64_tr_b16 %7, %8 offset:14144\n\t"
                         "s_waitcnt lgkmcnt(0)"
                         : "=&v"(t0_), "=&v"(t1_), "=&v"(t2_), "=&v"(t3_), "=&v"(t4_), "=&v"(t5_), "=&v"(t6_), "=&v"(t7_) : "v"(ka_) : "memory");
            S = mfma32(mk8(t0_, t1_), vf[0], S); S = mfma32(mk8(t2_, t3_), vf[1], S); S = mfma32(mk8(t4_, t5_), vf[2], S); S = mfma32(mk8(t6_, t7_), vf[3], S);
        }
#pragma unroll
        for (int g4 = 0; g4 < 4; ++g4) { const f32x4 dv = *(const LAS f32x4*)(Ds + 32 * dt + 8 * g4 + 4 * hi);
            S[4 * g4 + 0] *= dv.x; S[4 * g4 + 1] *= dv.y; S[4 * g4 + 2] *= dv.z; S[4 * g4 + 3] *= dv.w; }
}
__device__ __forceinline__ void gla_scan_unit(const Frame& F, const bf16* U1, const bf16* QT, const bf16* KT, const bf16* KTT, const float* DEC, bf16* OB, float* GSSQ, const float* onorm_g, int b, int h, int vq) {
    LAUNDER_TID(); const int wave = F.wave, c = lane & 31, hi = lane >> 5, vt = wave & 1, dt = wave >> 1;
    const int ocol = h * 256 + 64 * vq + 32 * (wave & 1) + 16 * (wave >> 2) + 4 * hi;
    const bf16* RB = U1 + C_R + ocol; float gs[8];
    { const f32x4 g0 = *(const f32x4*)(onorm_g + ocol), g1 = *(const f32x4*)(onorm_g + ocol + 8); gs[0] = g0.x; gs[1] = g0.y; gs[2] = g0.z; gs[3] = g0.w; gs[4] = g1.x; gs[5] = g1.y; gs[6] = g1.z; gs[7] = g1.w; }
    LAS bf16* As = (LAS bf16*)(F.lds + G2_AS);
    LAS float* PO = (LAS float*)(F.lds + G2_PO);
    f32x16 S;
#pragma unroll
    for (int i = 0; i < 16; ++i) S[i] = 0.f;
    for (int e = tid; e < 64 * TSTR / 2; e += 512) ((LAS unsigned*)As)[e] = 0u;
    v4u pq0[2], pk0[2], pv0, pq1[2], pk1[2], pv1, pq2[2], pk2[2], pv2; v2u pr0a, pr0b, pr1a, pr1b, pr2a, pr2b;     f32x4 pd0 = {0.f, 0.f, 0.f, 0.f}, pd1 = pd0, pd2 = pd0;
    LAS unsigned char* const bp = F.lds;
#define G2_LOAD(cidx, X) do { const size_t r0_ = (size_t)b * SEQ + 64 * (cidx); const size_t u_ = (size_t)b * 32 + (cidx); \
        _Pragma("unroll") for (int k = 0; k < 2; ++k) { const int e = tid + 512 * k; \
            pq##X[k] = *(const v4u*)(QT + (r0_ + (e >> 4)) * 512 + h * 128 + 8 * (e & 15)); \
            pk##X[k] = *(const v4u*)(KT + (r0_ + (e >> 4)) * 512 + h * 128 + 8 * (e & 15)); \
 } \
        pv##X = *(const v4u*)(U1 + (r0_ + (tid >> 3)) * CP + C_V + h * 256 + 64 * vq + 8 * (tid & 7)); \
        pr##X##a = *(const v2u*)(RB + (r0_ + 32 * ((wave >> 1) & 1) + c) * CP); pr##X##b = *(const v2u*)(RB + (r0_ + 32 * ((wave >> 1) & 1) + c) * CP + 8); \
        if (tid < 32) pd##X = *(const f32x4*)(DEC + u_ * 512 + h * 128 + 4 * tid); } while (0)
#define G2_STORE(X) do { \
        _Pragma("unroll") for (int k = 0; k < 2; ++k) { const int e = tid + 512 * k; \
            *(LAS v4u*)((LAS bf16*)(bp + G2_QS) + (e >> 4) * QSTR + 8 * (e & 15)) = pq##X[k]; \
            *(LAS v4u*)((LAS bf16*)(bp + G2_KS) + (e >> 4) * QSTR + 8 * (e & 15)) = pk##X[k]; \
 } \
        *(LAS v4u*)((LAS bf16*)(bp + G2_VT) + (tid >> 3) * VNSTR + 8 * (tid & 7)) = pv##X; \
        if (tid < 32) *(LAS f32x4*)((LAS float*)(bp + G2_DS) + 4 * tid) = pd##X; } while (0)
    G2_LOAD(0, 0); G2_LOAD(1, 1); G2_LOAD(2, 2);
    G2_STORE(0);
    __syncthreads();
#define G2_STEP(CH, LX, SX) do { const int ch = (CH); if (ch < 32) { \
        const v2u rr0_ = pr##LX##a, rr1_ = pr##LX##b;                    \
        if (ch + 3 < 32) G2_LOAD(ch + 3, LX); \
        g2_step_body(F, bp, As, PO, S, QT, OB, GSSQ, b, h, vq, ch, tid, lane, rr0_, rr1_, gs); \
        LDS_BARRIER(); \
        if (ch + 1 < 32) G2_STORE(SX); \
        LDS_BARRIER(); } } while (0)
#pragma unroll 1
    for (int ch0 = 0; ch0 < 33; ch0 += 3) { G2_STEP(ch0, 0, 1); G2_STEP(ch0 + 1, 1, 2); G2_STEP(ch0 + 2, 2, 0); }
#undef G2_STEP
#undef G2_LOAD
#undef G2_STORE
    __syncthreads();
}
__device__ __forceinline__ void gla_norm_gate(const Frame& F, const bf16* U1, bf16* YO, const bf16* OB, const float* GSSQ, const float* onorm_g) {
    LAUNDER_TID();
    const int gw = F.vcu * NWAVES + F.wave, NGW = F.G * NWAVES;
    f32x4 gv[2][2];
#pragma unroll
    for (int jx = 0; jx < 2; ++jx) { gv[jx][0] = *((const f32x4*)onorm_g + 2 * (lane + 64 * jx)); gv[jx][1] = *((const f32x4*)onorm_g + 2 * (lane + 64 * jx) + 1); }
    for (int m0 = gw * 4; m0 < M; m0 += NGW * 4) {
        v4u ov[4][2], rv[4][2]; float rs[4][2];
#pragma unroll
        for (int q = 0; q < 4; ++q)
#pragma unroll
            for (int jx = 0; jx < 2; ++jx) {
                ov[q][jx] = *((const v4u*)(OB + (size_t)(m0 + q) * DM) + lane + 64 * jx);
                rv[q][jx] = *((const v4u*)(U1 + (size_t)(m0 + q) * CP + C_R) + lane + 64 * jx);
                rs[q][jx] = 0.f;
            }
#pragma unroll
        for (int q = 0; q < 4; ++q) {
            float ps = GSSQ[(size_t)(m0 + q) * 64 + lane];
            ps += __shfl_xor(ps, 1); ps += __shfl_xor(ps, 2); ps += __shfl_xor(ps, 4); ps += __shfl_xor(ps, 8);
#pragma unroll
            for (int jx = 0; jx < 2; ++jx) rs[q][jx] = rsqrtf(__shfl(ps, 16 * ((lane + 64 * jx) >> 5)) * (1.0f / 256.0f) + EPS);
        }
#pragma unroll
        for (int q = 0; q < 4; ++q)
#pragma unroll
            for (int jx = 0; jx < 2; ++jx) {
                const unsigned ow[4] = {ov[q][jx].x, ov[q][jx].y, ov[q][jx].z, ov[q][jx].w}, rw[4] = {rv[q][jx].x, rv[q][jx].y, rv[q][jx].z, rv[q][jx].w};
                const float gg[8] = {gv[jx][0].x, gv[jx][0].y, gv[jx][0].z, gv[jx][0].w, gv[jx][1].x, gv[jx][1].y, gv[jx][1].z, gv[jx][1].w};
                unsigned yw[4];
#pragma unroll
                for (int e = 0; e < 4; ++e) { const float o0 = bf2f(ow[e] & 0xffffu), o1 = bf2f(ow[e] >> 16), r0v = bf2f(rw[e] & 0xffffu), r1v = bf2f(rw[e] >> 16);
                    yw[e] = pk2(o0 * rs[q][jx] * gg[2 * e] * fsilu(r0v), o1 * rs[q][jx] * gg[2 * e + 1] * fsilu(r1v)); }
                v4u y; y.x = yw[0]; y.y = yw[1]; y.z = yw[2]; y.w = yw[3];
                *((v4u*)(YO + (size_t)(m0 + q) * DM) + lane + 64 * jx) = y;
            }
    }
}

__device__ __forceinline__ void hs_table_fill(const Frame& F, const pg8::StaticOrder& S, const float* gssq) {
    LAUNDER_TID();
    LAS float* T = (LAS float*)(F.lds + 131072); pg8::Unit u;
    for (int uu = tid >> 8; uu < 4; uu += 2)
    if (S.next(uu, u)) { const f32x4* gp = (const f32x4*)(gssq + ((size_t)u.pm * 256 + (tid & 255)) * 64); float rs[4];
#pragma unroll
        for (int hh = 0; hh < 4; ++hh) { const f32x4 a = (gp[4 * hh] + gp[4 * hh + 1]) + (gp[4 * hh + 2] + gp[4 * hh + 3]); rs[hh] = rsqrtf(((a.x + a.y) + (a.z + a.w)) * (1.0f / 256.0f) + EPS); }
        LAS float* Tu = T + uu * 1024 + (tid & 255);
        Tu[0] = rs[0] / rs[1]; Tu[256] = rs[1] / rs[2]; Tu[512] = rs[2] / rs[3]; Tu[768] = rs[3]; }
}
__device__ __forceinline__ void final_norm(const Frame& F, const bf16* hb, float* out, const float* ssq, const float* g) {
    LAUNDER_TID();
    const bool grp_ = (F.G == 256);
    const int gw = grp_ ? (F.vcu & 31) * NWAVES + F.wave : F.vcu * NWAVES + F.wave, NGW = grp_ ? 32 * NWAVES : F.G * NWAVES, mlo = grp_ ? (F.vcu >> 5) * 4096 : 0, mhi = grp_ ? mlo + 4096 : M;
    f32x4 gv[2][2];
#pragma unroll
    for (int jx = 0; jx < 2; ++jx) { gv[jx][0] = *((const f32x4*)g + 2 * (lane + 64 * jx)); gv[jx][1] = *((const f32x4*)g + 2 * (lane + 64 * jx) + 1); }
    for (int m0 = mlo + gw * 4; m0 < mhi; m0 += NGW * 4) {
        v4u hv[4][2]; float r[4];
#pragma unroll
        for (int q = 0; q < 4; ++q) { float ps = (lane < 16) ? ssq[(size_t)(m0 + q) * 16 + lane] : 0.f; ps = wave_fsum(ps); r[q] = rsqrtf(ps * (1.0f / 1024.0f) + EPS);
#pragma unroll
            for (int jx = 0; jx < 2; ++jx) hv[q][jx] = __builtin_nontemporal_load((const v4u*)(hb + (size_t)(m0 + q) * DM) + lane + 64 * jx); }
#pragma unroll
        for (int q = 0; q < 4; ++q)
#pragma unroll
            for (int jx = 0; jx < 2; ++jx) { const v4u w = hv[q][jx]; f32x4* o = (f32x4*)(out + (size_t)(m0 + q) * DM) + 2 * (lane + 64 * jx);
                f32x4 a, b; a.x = bf2f(w.x & 0xffffu); a.y = bf2f(w.x >> 16); a.z = bf2f(w.y & 0xffffu); a.w = bf2f(w.y >> 16); b.x = bf2f(w.z & 0xffffu); b.y = bf2f(w.z >> 16); b.z = bf2f(w.w & 0xffffu); b.w = bf2f(w.w >> 16);
                __builtin_nontemporal_store(a * r[q] * gv[jx][0], o); __builtin_nontemporal_store(b * r[q] * gv[jx][1], o + 1); }
    }
}

struct Args { const float* in[18]; float* out; unsigned char* ws; int ph_lo, ph_hi; };
constexpr int N_PHASES = 16;
#ifndef REP_P0
#define REP_P0 1
#endif
#ifndef REP_DSA
#define REP_DSA 1
#endif
#ifndef REP_CONV
#define REP_CONV 1
#endif
#ifndef REP_PREP
#define REP_PREP 1
#endif
#ifndef REP_SCAN
#define REP_SCAN 1
#endif
#ifndef MK_MULTI
#define MK_MULTI 0
#endif
__global__ void __launch_bounds__(NWAVES * 64, 2) fwd(Args args) {
    extern __shared__ __attribute__((aligned(16))) unsigned char lds_raw[];
    Frame F;
    F.lds = (LAS unsigned char*)lds_raw;
    F.tid = threadIdx.x; F.lane = F.tid & 63; F.wave = __builtin_amdgcn_readfirstlane(F.tid >> 6);
    F.G = gridDim.x; { const int bx = blockIdx.x; F.vcu = (F.G % 8 == 0) ? (bx % 8) * (F.G / 8) + bx / 8 : bx; }
    unsigned char* ws = args.ws;
    volatile LAS unsigned* MISC = (volatile LAS unsigned*)(F.lds + LDS_CTL);
    for (int u = F.tid; u < (LDS_MT3 - LDS_CTL) / 4; u += NWAVES * 64) ((LAS unsigned*)(F.lds + LDS_CTL))[u] = 0u;
    __syncthreads();
    unsigned* ctl = (unsigned*)(ws + WS_CTL);
    XcdBarrier bar = xcd_barrier_post(ctl + CW_BAR, MISC + 8);
    grp_barrier_post(ctl + CW_BAR);
    const int lo = args.ph_lo, hi = args.ph_hi;
#define IN(k) (lo <= (k) && (k) < hi)
#define SEAM(k) do { if (lo <= (k) && (k) + 1 < hi) xcd_barrier(bar); } while (0)
#define SEAMG(k) do { if (lo <= (k) && (k) + 1 < hi) { if (MISC[12]) grp_barrier(ctl + CW_BAR, MISC + 12); else xcd_barrier(bar); } } while (0)
    float* ssq = (float*)(ws + WS_SSQ);
    const float* rope = (const float*)(ws + WS_ROPE);
    bf16* HB = (bf16*)(ws + WS_HB); bf16* UB = (bf16*)(ws + WS_U); bf16* YC = (bf16*)(ws + WS_YC); bf16* QT = (bf16*)(ws + WS_QT); bf16* KT = (bf16*)(ws + WS_KT); bf16* KTT = (bf16*)(ws + WS_KTT);
    float* DEC = (float*)(ws + WS_DEC); float* gssq = (float*)(ws + WS_GSSQ);

    P0Args A; A.x = args.in[0]; A.mix_g = args.in[1]; A.ab_w_in = args.in[2]; A.ab_w_out = args.in[7]; A.c_w_in = args.in[8]; A.c_w_out = args.in[12];
    A.ffn_g = args.in[13]; A.w_gate = args.in[14]; A.w_up = args.in[15]; A.w_down = args.in[16]; A.ws = ws;
    if (IN(0)) {
#pragma unroll 1
        for (int rep_ = 0; rep_ < REP_P0; ++rep_) p0_prologue(F, A);
    }
    SEAM(0);
    if (lo == 0 && hi == N_PHASES) grp_barrier_mode(ctl + CW_BAR, MISC + 12);
#pragma unroll 1
    for (int L = 0; L < 2; ++L) {
        const int pb = 7 * L;
        if (IN(pb + 1)) {
            const int N = L ? CP : ABP;
            pg8::Gemm g{HB, (const bf16*)(ws + (L ? WS_WIN1 : WS_WIN0)), M, N, DM}; pg8::StaticOrder S; S.init(M, N, F.G, (int)blockIdx.x, WGM_IN);
            pg8::EpiIn E{UB, N, ssq + (size_t)(2 * L) * M * 16, rope, L == 0 ? 1 : 0};
#pragma unroll 1
            for (int rep_ = 0; rep_ < REP_IN; ++rep_) pg8::gemm_phase<pg8::EpiIn, pg8::StaticOrder, true, true>(F.lds, g, S, E);
            {
                const int lastr = (S.nwg - 1) / F.G, nlast = S.nwg - lastr * F.G, cb = (int)blockIdx.x, lo_ = L ? P0_SET1 : P0_SET0, hi_ = L ? P0_SET2 : P0_SET1;
                if (nlast == F.G) { p0_weights(F, A, lo_, hi_, cb * NWAVES + F.wave, F.G * NWAVES); wconv_done(ctl + CW_BAR, L); }
                else if (cb >= nlast) { p0_weights(F, A, lo_, hi_, (cb - nlast) * NWAVES + F.wave, (F.G - nlast) * NWAVES); wconv_done(ctl + CW_BAR, L); }
            }
        }
        SEAMG(pb + 1);
        if (L == 0) {
            if (IN(2)) {
#pragma unroll 1
                for (int pu = F.vcu; pu < 256; pu += F.G) {
                    const int b = pu >> 4, p = pu & 15;
#pragma unroll 1
                    for (int rep = 0; rep < 2 * REP_DSA; ++rep) dsa_unit(F, UB, YC, b, (rep & 1) ? p : 31 - p); }
#pragma unroll 1
                for (int rep_ = 0; rep_ < REP_CONV; ++rep_)
                if (F.G == 256) { for (int k2 = 0; k2 < 2; ++k2) conv_unit(F, UB, YC, args.in[3], args.in[4], args.in[5], args.in[6], ((2 * (F.vcu >> 5) + k2) << 5) | (F.vcu & 31)); }
                else for (int tile = F.vcu; tile < 512; tile += F.G) conv_unit(F, UB, YC, args.in[3], args.in[4], args.in[5], args.in[6], tile);
            }
            SEAMG(2);
        } else {
            if (IN(9)) {
#pragma unroll 1
                for (int rep_ = 0; rep_ < REP_PREP; ++rep_)
                if (F.G == 256) { for (int k2 = 0; k2 < 2; ++k2) gla_prep_unit(F, UB, QT, KT, KTT, DEC, args.in[9], args.in[10], ((2 * (F.vcu >> 5) + k2) << 5) | (F.vcu & 31)); }
                else for (int unit = F.vcu; unit < 512; unit += F.G) gla_prep_unit(F, UB, QT, KT, KTT, DEC, args.in[9], args.in[10], unit); }
            SEAMG(9);
            if (IN(10)) {
#pragma unroll 1
                for (int rep_ = 0; rep_ < REP_SCAN; ++rep_)
                for (int unit = F.vcu; unit < 256; unit += F.G) gla_scan_unit(F, UB, QT, KT, KTT, DEC, YC, rep_ + 1 < REP_SCAN ? (float*)args.out : gssq, args.in[11], unit >> 4, (unit >> 2) & 3, unit & 3);
            }
            SEAMG(10);
        }
        if (IN(pb + 5)) {
            {
                const int nwg_in = (M / 256) * ((L ? CP : ABP) / 256), lastr_ = (nwg_in - 1) / F.G, nlast_ = nwg_in - lastr_ * F.G;
                wconv_wait(ctl + CW_BAR, L, (unsigned)(nlast_ == F.G ? F.G : F.G - nlast_));
            }
            pg8::Gemm g{YC, (const bf16*)(ws + (L ? WS_WOUT1 : WS_WOUT0)), M, DM, DM}; pg8::StaticOrder S; S.init(M, DM, F.G, (int)blockIdx.x);
            pg8::EpiRes E{HB, HB, ssq + (size_t)(2 * L + 1) * M * 16, 0, L};
            if (L) { hs_table_fill(F, S, gssq); __syncthreads(); }
#if REP_OUT > 1
            { pg8::EpiRes EP{HB, QT, ssq + (size_t)5 * M * 16, PROBE_PMODE}; pg8::gemm_phase<pg8::EpiRes, pg8::StaticOrder, true, true>(F.lds, g, S, EP); }
#endif
            pg8::gemm_phase<pg8::EpiRes, pg8::StaticOrder, true, true>(F.lds, g, S, E);
        }
        SEAMG(pb + 5);
        if (IN(pb + 6)) {
            pg8::Gemm g{HB, (const bf16*)(ws + (L ? WS_WGU1 : WS_WGU0)), M, GU, DM}; pg8::StaticOrder S; S.init(M, GU, F.G, (int)blockIdx.x, WGM_GU);
            pg8::EpiGLU E{UB, ssq + (size_t)(2 * L + 1) * M * 16, 0};
#if REP_GU > 1
            { pg8::EpiGLU EP{UB, ssq + (size_t)(2 * L + 1) * M * 16, PROBE_PMODE}; pg8::gemm_phase<pg8::EpiGLU, pg8::StaticOrder, true, true>(F.lds, g, S, EP); }
#endif
            pg8::gemm_phase<pg8::EpiGLU, pg8::StaticOrder, true, true>(F.lds, g, S, E);
        }
        SEAMG(pb + 6);
        if (IN(pb + 7)) {
            pg8::Gemm g{UB, (const bf16*)(ws + (L ? WS_WDN1 : WS_WDN0)), M, DM, DFF}; pg8::StaticOrder S; S.init(M, DM, F.G, (int)blockIdx.x);
            pg8::EpiRes E{HB, HB, ssq + (size_t)(2 * L + 2) * M * 16, 0};
#if REP_DN > 1
            { pg8::EpiRes EP{HB, QT, ssq + (size_t)5 * M * 16, PROBE_PMODE}; pg8::gemm_phase<pg8::EpiRes, pg8::StaticOrder, true, true>(F.lds, g, S, EP); }
#endif
            pg8::gemm_phase<pg8::EpiRes, pg8::StaticOrder, true, true>(F.lds, g, S, E);
        }
        SEAMG(pb + 7);
    }
    if (IN(15)) final_norm(F, HB, args.out, ssq + (size_t)4 * M * 16, args.in[17]);
#undef IN
#undef SEAM
}

extern "C" void kernel_launch(void* const* d_in, const int* in_sizes, int n_in, void* d_out, int out_size, void* d_ws, size_t ws_size, hipStream_t stream) {
    static int grid = 0;
    if (grid == 0) {
        if (n_in != 18 || in_sizes[0] != M * DM || out_size != M * DM || ws_size < WS_END) { fprintf(stderr, "kernel_launch: unexpected shapes (n_in %d, in0 %d, out %d, ws %zu); nothing launched\n", n_in, n_in > 0 ? in_sizes[0] : -1, out_size, ws_size); grid = -1; return; }
        int dev = 0, cus = 0, per_cu = 0;
        if (hipGetDevice(&dev) != hipSuccess || hipDeviceGetAttribute(&cus, hipDeviceAttributeMultiprocessorCount, dev) != hipSuccess) { grid = -1; return; }
        if (hipFuncSetAttribute((const void*)fwd, hipFuncAttributeMaxDynamicSharedMemorySize, LDS_BYTES) != hipSuccess) { fprintf(stderr, "kernel_launch: hipFuncSetAttribute failed\n"); grid = -1; return; }
        if (hipOccupancyMaxActiveBlocksPerMultiprocessor(&per_cu, (const void*)fwd, NWAVES * 64, LDS_BYTES) != hipSuccess || per_cu < 1) fprintf(stderr, "kernel_launch: occupancy query reports %d\n", per_cu);
        (void)hipGetLastError();
        grid = cus;
    }
    if (grid < 0) return;
    if (hipMemsetAsync((char*)d_ws + WS_CTL, 0, CTL_ZERO_BYTES, stream) != hipSuccess) return;
    Args a{};
    for (int i = 0; i < 18; ++i) a.in[i] = (const float*)d_in[i];
    a.out = (float*)d_out; a.ws = (unsigned char*)d_ws;
#if MK_MULTI
    for (int k = 0; k < N_PHASES; ++k) { if (k == 3 || k == 4) continue; a.ph_lo = k; a.ph_hi = k + 1; hipLaunchKernelGGL(fwd, dim3(grid), dim3(NWAVES * 64), LDS_BYTES, stream, a); }
#else
    a.ph_lo = 0; a.ph_hi = N_PHASES; hipLaunchKernelGGL(fwd, dim3(grid), dim3(NWAVES * 64), LDS_BYTES, stream, a);
#endif
}
```
